# Optimizing an MI355X kernel written in HIP

```python
import math
import jax, jax.numpy as jnp
from jax import lax
import numpy as np

D_MODEL = 1024
BATCH = 32
SEQ = 2048
DEPTH = 1

D_MIX = D_MODEL
D_S5 = D_MIX // 2
D_ML = D_MIX - D_S5
S5_GROUP = 16
S5_NG = D_S5 // S5_GROUP
S5_P = 64
ML_HEADS = 4
ML_DH = D_ML // ML_HEADS
ML_CHUNK = 128
CONV_K = 5
N_GATES = 4
D_IN = D_S5 + 2 * D_ML + N_GATES * ML_HEADS
D_FF = 256 * math.ceil(8 * D_MODEL / 3 / 256)
EPS = 1e-6

kernel_name = "hybrid_s5_mlstm_bidir_block"


def rmsnorm(x, g):
    x32 = x.astype(jnp.float32)
    y = x32 * lax.rsqrt(jnp.mean(x32 * x32, axis=-1, keepdims=True) + EPS)
    return (y * g.astype(jnp.float32)).astype(x.dtype)


def s5_discretise(lam_re, lam_im, log_dt, b_re, b_im):
    f32 = jnp.float32
    lr, li = lam_re.astype(f32), lam_im.astype(f32)
    dt = jnp.exp(log_dt.astype(f32))[:, None]
    mag = jnp.exp(lr * dt)
    bar_re, bar_im = mag * jnp.cos(li * dt), mag * jnp.sin(li * dt)
    xr, xi = bar_re - 1.0, bar_im
    den = lr * lr + li * li
    fr = (xr * lr + xi * li) / den
    fi = (xi * lr - xr * li) / den
    br, bi = b_re.astype(f32), b_im.astype(f32)
    bb_re = fr[..., None] * br - fi[..., None] * bi
    bb_im = fr[..., None] * bi + fi[..., None] * br
    return bar_re, bar_im, bb_re, bb_im


def _linear_recurrence_combine(e1, e2):
    a1r, a1i, b1r, b1i = e1
    a2r, a2i, b2r, b2i = e2
    return (a2r * a1r - a2i * a1i,
            a2r * a1i + a2i * a1r,
            a2r * b1r - a2i * b1i + b2r,
            a2r * b1i + a2i * b1r + b2i)


def s5_scan(u, lam_re, lam_im, log_dt, b_re, b_im, reverse):
    bar_re, bar_im, bb_re, bb_im = s5_discretise(lam_re, lam_im, log_dt, b_re, b_im)
    bu_re = jnp.einsum('bsgc,gpc->bsgp', u, bb_re)
    bu_im = jnp.einsum('bsgc,gpc->bsgp', u, bb_im)
    a_re = jnp.broadcast_to(bar_re, bu_re.shape)
    a_im = jnp.broadcast_to(bar_im, bu_im.shape)
    _, _, s_re, s_im = lax.associative_scan(
        _linear_recurrence_combine, (a_re, a_im, bu_re, bu_im), axis=1, reverse=reverse)
    return s_re, s_im


def s5_group(u, lam_re, lam_im, log_dt, b_re, b_im, c_re, c_im, d, w_glu, b_glu):
    bsz, seq, _ = u.shape
    f32 = jnp.float32
    u32 = u.astype(f32)
    ug = u32.reshape(bsz, seq, S5_NG, S5_GROUP)
    sf_re, sf_im = s5_scan(ug, lam_re[0], lam_im[0], log_dt[0], b_re, b_im, False)
    sb_re, sb_im = s5_scan(ug, lam_re[1], lam_im[1], log_dt[1], b_re, b_im, True)
    s_re, s_im = sf_re + sb_re, sf_im + sb_im
    y = (jnp.einsum('bsgp,gcp->bsgc', s_re, c_re.astype(f32))
         - jnp.einsum('bsgp,gcp->bsgc', s_im, c_im.astype(f32)))
    y = y.reshape(bsz, seq, D_S5) + d.astype(f32) * u32
    y = jax.nn.gelu(y)
    out = y * jax.nn.sigmoid(y @ w_glu.astype(f32) + b_glu.astype(f32))
    return out.astype(u.dtype)


def _mlstm_chunk_step(carry, inp):
    c_state, n_state, m_state = carry
    q, k, v, li, lf = inp
    L = q.shape[2]
    b = jnp.cumsum(lf, axis=-1)
    a = b + m_state[..., None]
    lower_tri = jnp.tril(jnp.ones((L, L), dtype=bool))
    d = jnp.where(lower_tri, b[..., :, None] - b[..., None, :] + li[..., None, :], -jnp.inf)
    m_t = jnp.maximum(a, jnp.max(d, axis=-1))
    w_intra = jnp.exp(d - m_t[..., None])
    w_inter = jnp.exp(a - m_t)
    s = jnp.einsum('bhtd,bhsd->bhts', q, k) * w_intra
    num = (jnp.einsum('bhts,bhsd->bhtd', s, v)
           + w_inter[..., None] * jnp.einsum('bhvk,bhtk->bhtv', c_state, q))
    den = jnp.sum(s, axis=-1) + w_inter * jnp.einsum('bhk,bhtk->bht', n_state, q)
    h = num / jnp.maximum(jnp.abs(den), jnp.exp(-m_t))[..., None]
    b_last = b[..., -1]
    g = b_last[..., None] - b + li
    m_new = jnp.maximum(b_last + m_state, jnp.max(g, axis=-1))
    decay = jnp.exp(b_last + m_state - m_new)
    w_state = jnp.exp(g - m_new[..., None])
    c_new = decay[..., None, None] * c_state + jnp.einsum('bhs,bhsv,bhsk->bhvk', w_state, v, k)
    n_new = decay[..., None] * n_state + jnp.einsum('bhs,bhsk->bhk', w_state, k)
    return (c_new, n_new, m_new), h


def mlstm_chunkwise(q, k, v, i_pre, f_pre):
    bsz, nh, seq, dh = q.shape
    nc = seq // ML_CHUNK
    li = i_pre
    lf = jax.nn.log_sigmoid(f_pre)

    def to_chunks(t):
        return jnp.moveaxis(t.reshape(bsz, nh, nc, ML_CHUNK, *t.shape[3:]), 2, 0)

    xs = (to_chunks(q), to_chunks(k), to_chunks(v), to_chunks(li), to_chunks(lf))
    init = (jnp.zeros((bsz, nh, dh, dh), jnp.float32),
            jnp.zeros((bsz, nh, dh), jnp.float32),
            jnp.zeros((bsz, nh), jnp.float32))
    _, hs = lax.scan(_mlstm_chunk_step, init, xs)
    return jnp.moveaxis(hs, 0, 2).reshape(bsz, nh, seq, dh)


def _conv_centred(x, w, b):
    y = lax.conv_general_dilated(
        x, w[:, None, :].astype(x.dtype), window_strides=(1,),
        padding=[(CONV_K // 2, CONV_K // 2)],
        dimension_numbers=('NWC', 'WIO', 'NWC'),
        feature_group_count=x.shape[-1])
    return y + b.astype(x.dtype)


def mlstm_group(x_m, o_pre, gate_pre, gate_bias, conv_w, conv_b, wq, wk, wv, head_norm, skip):
    bsz, seq, _ = x_m.shape
    f32 = jnp.float32
    xc = jax.nn.silu(_conv_centred(x_m, conv_w, conv_b))
    xc_h = xc.astype(f32).reshape(bsz, seq, ML_HEADS, ML_DH)
    xm_h = x_m.astype(f32).reshape(bsz, seq, ML_HEADS, ML_DH)
    q = jnp.einsum('bshd,hde->bhse', xc_h, wq.astype(f32))
    k = jnp.einsum('bshd,hde->bhse', xc_h, wk.astype(f32)) * (ML_DH ** -0.5)
    v = jnp.einsum('bshd,hde->bhse', xm_h, wv.astype(f32))
    gp = jnp.transpose(gate_pre.astype(f32) + gate_bias.astype(f32), (2, 0, 3, 1))
    h_fwd = mlstm_chunkwise(q, k, v, gp[0], gp[2])
    flip = lambda t: jnp.flip(t, axis=2)
    h_bwd = flip(mlstm_chunkwise(flip(q), flip(k), flip(v), flip(gp[1]), flip(gp[3])))
    h = h_fwd + h_bwd
    mu = jnp.mean(h, axis=-1, keepdims=True)
    var = jnp.mean(jnp.square(h - mu), axis=-1, keepdims=True)
    hn = (h - mu) * lax.rsqrt(var + EPS)
    hn = jnp.transpose(hn, (0, 2, 1, 3)).reshape(bsz, seq, D_ML) * head_norm.astype(f32)
    out = jax.nn.sigmoid(o_pre.astype(f32)) * (hn + skip.astype(f32) * xc.astype(f32))
    return out.astype(x_m.dtype)


def hybrid_layer(x, norm_mix_pre, norm_mix_post, norm_ffn_pre, norm_ffn_post, w_in, ml_gate_bias,
                 s5_lam_re, s5_lam_im, s5_log_dt, s5_b_re, s5_b_im, s5_c_re, s5_c_im, s5_d,
                 s5_w_glu, s5_b_glu, ml_conv_w, ml_conv_b, ml_wq, ml_wk, ml_wv, ml_head_norm,
                 ml_skip, w_out, w_gate, w_up, w_down):
    bsz, seq, _ = x.shape
    h = rmsnorm(x, norm_mix_pre)
    proj = h @ w_in.astype(h.dtype)
    u_s5 = proj[..., :D_S5]
    x_m = proj[..., D_S5:D_S5 + D_ML]
    o_pre = proj[..., D_S5 + D_ML:D_S5 + 2 * D_ML]
    gate_pre = proj[..., D_S5 + 2 * D_ML:].reshape(bsz, seq, N_GATES, ML_HEADS)
    y_s5 = s5_group(u_s5, s5_lam_re, s5_lam_im, s5_log_dt, s5_b_re, s5_b_im,
                    s5_c_re, s5_c_im, s5_d, s5_w_glu, s5_b_glu)
    y_ml = mlstm_group(x_m, o_pre, gate_pre, ml_gate_bias, ml_conv_w, ml_conv_b,
                       ml_wq, ml_wk, ml_wv, ml_head_norm, ml_skip)
    y = jnp.concatenate([y_s5, y_ml], axis=-1) @ w_out.astype(x.dtype)
    x = x + rmsnorm(y, norm_mix_post)
    h = rmsnorm(x, norm_ffn_pre)
    f = (jax.nn.silu(h @ w_gate.astype(h.dtype)) * (h @ w_up.astype(h.dtype))) @ w_down.astype(h.dtype)
    return x + rmsnorm(f, norm_ffn_post)


def setup_inputs(seed: int = 0) -> dict:
    key = jax.random.key(seed)
    ks = jax.random.split(key, 32)
    f32 = jnp.float32
    nrm = lambda k, shape, scale: jax.random.normal(k, shape, f32) * scale
    gain = lambda k, n: 1.0 + 0.05 * jax.random.normal(k, (DEPTH, n), f32)
    x = jax.random.normal(ks[0], (BATCH, SEQ, D_MODEL), f32)
    gb_noise = 0.1 * jax.random.normal(ks[6], (DEPTH, N_GATES, ML_HEADS), f32)
    f_lin = jnp.linspace(3.0, 6.0, ML_HEADS, dtype=f32)
    gate_offset = jnp.stack([jnp.zeros_like(f_lin), jnp.zeros_like(f_lin), f_lin, f_lin], axis=0)
    ml_gate_bias = gb_noise + gate_offset[None]
    n_idx = jnp.arange(S5_P, dtype=f32)
    s5_lam_re = -0.5 + 0.01 * jax.random.normal(ks[7], (DEPTH, 2, S5_NG, S5_P), f32)
    s5_lam_im = math.pi * n_idx + 0.01 * jax.random.normal(ks[8], (DEPTH, 2, S5_NG, S5_P), f32)
    s5_log_dt = jax.random.uniform(ks[9], (DEPTH, 2, S5_NG), f32,
                                   minval=math.log(1e-3), maxval=math.log(1e-1))
    return {
        'x': x,
        'norm_mix_pre': gain(ks[1], D_MODEL),
        'norm_mix_post': gain(ks[2], D_MODEL),
        'norm_ffn_pre': gain(ks[3], D_MODEL),
        'norm_ffn_post': gain(ks[4], D_MODEL),
        'w_in': nrm(ks[5], (DEPTH, D_MODEL, D_IN), D_MODEL ** -0.5),
        'ml_gate_bias': ml_gate_bias,
        's5_lam_re': s5_lam_re,
        's5_lam_im': s5_lam_im,
        's5_log_dt': s5_log_dt,
        's5_b_re': nrm(ks[10], (DEPTH, S5_NG, S5_P, S5_GROUP), (2 * S5_GROUP) ** -0.5),
        's5_b_im': nrm(ks[11], (DEPTH, S5_NG, S5_P, S5_GROUP), (2 * S5_GROUP) ** -0.5),
        's5_c_re': nrm(ks[12], (DEPTH, S5_NG, S5_GROUP, S5_P), (2 * S5_P) ** -0.5),
        's5_c_im': nrm(ks[13], (DEPTH, S5_NG, S5_GROUP, S5_P), (2 * S5_P) ** -0.5),
        's5_d': nrm(ks[14], (DEPTH, D_S5), 1.0),
        's5_w_glu': nrm(ks[15], (DEPTH, D_S5, D_S5), D_S5 ** -0.5),
        's5_b_glu': nrm(ks[16], (DEPTH, D_S5), 0.02),
        'ml_conv_w': nrm(ks[17], (DEPTH, CONV_K, D_ML), CONV_K ** -0.5),
        'ml_conv_b': nrm(ks[18], (DEPTH, D_ML), 0.02),
        'ml_wq': nrm(ks[19], (DEPTH, ML_HEADS, ML_DH, ML_DH), ML_DH ** -0.5),
        'ml_wk': nrm(ks[20], (DEPTH, ML_HEADS, ML_DH, ML_DH), ML_DH ** -0.5),
        'ml_wv': nrm(ks[21], (DEPTH, ML_HEADS, ML_DH, ML_DH), ML_DH ** -0.5),
        'ml_head_norm': gain(ks[22], D_ML),
        'ml_skip': 1.0 + 0.05 * jax.random.normal(ks[23], (DEPTH, D_ML), f32),
        'w_out': nrm(ks[24], (DEPTH, D_MIX, D_MODEL), D_MIX ** -0.5),
        'w_gate': nrm(ks[25], (DEPTH, D_MODEL, D_FF), D_MODEL ** -0.5),
        'w_up': nrm(ks[26], (DEPTH, D_MODEL, D_FF), D_MODEL ** -0.5),
        'w_down': nrm(ks[27], (DEPTH, D_FF, D_MODEL), D_FF ** -0.5),
    }


def reference(x, norm_mix_pre, norm_mix_post, norm_ffn_pre, norm_ffn_post, w_in, ml_gate_bias,
              s5_lam_re, s5_lam_im, s5_log_dt, s5_b_re, s5_b_im, s5_c_re, s5_c_im, s5_d,
              s5_w_glu, s5_b_glu, ml_conv_w, ml_conv_b, ml_wq, ml_wk, ml_wv, ml_head_norm,
              ml_skip, w_out, w_gate, w_up, w_down):
    for l in range(DEPTH):
        x = hybrid_layer(
            x, norm_mix_pre[l], norm_mix_post[l], norm_ffn_pre[l], norm_ffn_post[l], w_in[l],
            ml_gate_bias[l], s5_lam_re[l], s5_lam_im[l], s5_log_dt[l], s5_b_re[l], s5_b_im[l],
            s5_c_re[l], s5_c_im[l], s5_d[l], s5_w_glu[l], s5_b_glu[l], ml_conv_w[l], ml_conv_b[l],
            ml_wq[l], ml_wk[l], ml_wv[l], ml_head_norm[l], ml_skip[l], w_out[l], w_gate[l],
            w_up[l], w_down[l])
    return x
```

```cpp
#include <hip/hip_runtime.h>
#include <cstdio>
#include <cstdint>


#define GAS __attribute__((address_space(1)))
#define LAS __attribute__((address_space(3)))
typedef unsigned short bf16;
typedef short bf16x8 __attribute__((ext_vector_type(8)));
typedef float f32x4 __attribute__((ext_vector_type(4)));
typedef float f32x2 __attribute__((ext_vector_type(2)));
typedef unsigned u32x4 __attribute__((ext_vector_type(4)));
typedef unsigned u32x2 __attribute__((ext_vector_type(2)));
typedef __bf16 bf16x2_t __attribute__((ext_vector_type(2)));
typedef GAS unsigned gu32;

constexpr int BATCH = 32, SEQ = 2048, DM = 1024, MTOK = BATCH * SEQ;
constexpr int D_S5 = 512, D_ML = 512, NG = 32, GC = 16, SP = 64, NH = 4, DH = 128, D_IN = 1552, DFF = 2816, NPROJ = 1536;
constexpr int S5L = 16, S5NCH = SEQ / S5L, S5ROWS = BATCH * S5NCH;
constexpr float EPS = 1e-6f;
constexpr int NWAVES = 8, NTHREADS = 512;
constexpr int N_PHASES = 11;

constexpr size_t MiB = 1u << 20;
constexpr size_t WS_CTL = 0, CTL_ZERO_BYTES = 1 * MiB;
constexpr size_t WS_WIN = 1 * MiB;
constexpr size_t WS_WGLU = 4 * MiB;
constexpr size_t WS_WQKV = 5 * MiB;
constexpr size_t WS_WOUT = 6 * MiB;
constexpr size_t WS_WGU = 8 * MiB;
constexpr size_t WS_WDN = 19 * MiB;
constexpr size_t WS_MZ = 25 * MiB;
constexpr size_t WS_TMY = 29 * MiB;
constexpr size_t WS_RS1 = 37 * MiB;
constexpr size_t WS_RS2 = 48 * MiB;
constexpr size_t WS_GATES = 38 * MiB;
constexpr size_t WS_XS = 42 * MiB;
constexpr size_t WS_XB = 64 * MiB;
constexpr size_t WS_UX = 192 * MiB;
constexpr size_t WS_XM = 320 * MiB;
constexpr size_t WS_OP = 384 * MiB;
constexpr size_t WS_ZB = 448 * MiB;
constexpr size_t WS_YACT = 512 * MiB;
constexpr size_t WS_HF = 576 * MiB;
constexpr size_t WS_HB = 640 * MiB;
constexpr size_t WS_YCAT = 704 * MiB;
constexpr size_t WS_ACT = 192 * MiB;
constexpr size_t WS_XC = 832 * MiB;
constexpr size_t WS_GS = 896 * MiB;
constexpr size_t WS_END = 960 * MiB;
constexpr int CW_TMO = 0, CW_BAR = 4096;
constexpr int CW_PANEL = 16384, PANEL_BANK = 256 * 64;

constexpr int MISC_OFF = 162816;
constexpr int LDS_BYTES = 163840;

__device__ __forceinline__ unsigned pk2(float lo, float hi) { f32x2 v = {lo, hi}; bf16x2_t b = __builtin_convertvector(v, bf16x2_t); return __builtin_bit_cast(unsigned, b); }
__device__ __forceinline__ float bflo(unsigned u) { return __builtin_bit_cast(float, u << 16); }
__device__ __forceinline__ float bfhi(unsigned u) { return __builtin_bit_cast(float, u & 0xffff0000u); }
__device__ __forceinline__ float bf2f(bf16 h) { return __builtin_bit_cast(float, (unsigned)h << 16); }
__device__ __forceinline__ float fexp(float x) { return __expf(x); }
__device__ __forceinline__ float frcp(float x) { return __builtin_amdgcn_rcpf(x); }
__device__ __forceinline__ float sigmoidf_(float z) { return frcp(1.f + fexp(-z)); }
__device__ __forceinline__ float siluf_(float z) { return z * frcp(1.f + fexp(-z)); }
__device__ __forceinline__ float gelu_tanh(float y) { const float t = 1.5957691216057308f * (y + 0.044715f * y * y * y); return y * frcp(1.f + fexp(-t)); }
__device__ __forceinline__ float wave_sum(float v) {
#pragma unroll
    for (int o = 1; o < 64; o <<= 1) v += __shfl_xor(v, o);
    return v;
}
#define LDS_WAIT() asm volatile("s_waitcnt lgkmcnt(0)" ::: "memory")
#define VM_WAIT() asm volatile("s_waitcnt vmcnt(0)" ::: "memory")

namespace pg8 {
constexpr int BM = 256, BK = 64, HALF = 128, HTB = HALF * BK * 2, STAGE_BYTES = 8 * HTB, NXCD = 8, WGM = 4;
__host__ __device__ __forceinline__ int lds_byte(int r, int c) { const int st = (r >> 4) * 2 + (c >> 5), rr = r & 15, cc = c & 31, ob = rr * 64 + cc * 2; return st * 1024 + (ob ^ (((ob >> 9) & 1) << 5)); }
__host__ __device__ __forceinline__ void stage_rc(int b, int& R, int& C) { const int st = b / 1024, sb = b % 1024, swz = sb ^ (((sb >> 9) & 1) << 5); R = (st >> 1) * 16 + swz / 64; C = (st & 1) * 32 + (swz % 64) / 2; }
__host__ __device__ __forceinline__ int perm32(int rho) { const int n = rho >> 4, i = rho & 15; return 8 * (i >> 2) + 4 * n + (i & 3); }

struct Unit { int pm, pn; };
struct Gemm { const bf16* A; const bf16* Bt; int lda, ldb, K; };

struct StaticOrder {
    int nig, nwg, G, qq, rr; int gid, rem, L;
    __device__ void init(int M, int N, int G_, int c_) {
        const int nN = N / BM; nwg = (M / BM) * nN; G = G_; nig = WGM * nN;
        const int w0 = (c_ % NXCD) * (nwg / NXCD) + c_ / NXCD, st = G_ / NXCD; gid = w0 / nig; rem = w0 % nig; qq = st / nig; rr = st % nig; L = c_; }
    __device__ __forceinline__ bool next(int, Unit& u) {
        if (L >= nwg) return false;
        u.pm = gid * WGM + (rem & (WGM - 1)); u.pn = rem / WGM; L += G; gid += qq; rem += rr; if (rem >= nig) { rem -= nig; ++gid; } return true; }
    __device__ __forceinline__ void a_ready(const Unit&) const {}
    __device__ __forceinline__ void done(const Unit&) const {}
};
struct PassOrder {
    StaticOrder so; int M, G, c, p, pn0;
    __device__ static __forceinline__ int nn(int p) { return p < 2 ? 6 : 5; }
    __device__ void init(int M_, int G_, int c_) { M = M_; G = G_; c = c_; p = 0; pn0 = 0; so.init(M, nn(0) * BM, G, c); }
    __device__ __forceinline__ bool next(int i, Unit& u) {
        if (!so.next(i, u)) { if (p == 3) return false; pn0 += nn(p); ++p; so.init(M, nn(p) * BM, G, c); (void)so.next(0, u); }
        u.pn += pn0; return true; }
    __device__ __forceinline__ void a_ready(const Unit&) const {}
    __device__ __forceinline__ void done(const Unit&) const {}
};
struct S5Order {
    int G, c;
    __device__ __forceinline__ bool next(int i, Unit& u) const { const int L = i * G + c; if (L >= NG * 16) return false; u.pm = L; u.pn = L >> 4; return true; }
    __device__ __forceinline__ void a_ready(const Unit&) const {}
    __device__ __forceinline__ void done(const Unit&) const {}
};

__device__ __forceinline__ u32x4 pack8(f32x4 v0, f32x4 v1) { u32x4 w; w.x = pk2(v0[0], v0[1]); w.y = pk2(v0[2], v0[3]); w.z = pk2(v1[0], v1[1]); w.w = pk2(v1[2], v1[3]); return w; }

struct EpiP1 {
    static constexpr bool PEEL = true, PERM = true, AFTER_DRAIN = false; static constexpr int NS = 16;
    const float* rs1; bf16* UX; bf16* XM; bf16* OP;
    __device__ __forceinline__ void pre(const Unit& u, LAS unsigned char* xlds, int tid) const {
        if (tid < 64) __builtin_amdgcn_global_load_lds((const unsigned*)(rs1 + (size_t)u.pm * BM + tid * 4), (LAS unsigned*)xlds, 16, 0, 0); }
    __device__ __forceinline__ void operator()(const f32x4 (&acc)[2][2][4][2], const Unit& u, int wr, int wc, int fr, int fq, const LAS unsigned char* xlds) const {
#pragma unroll
        for (int ai = 0; ai < 2; ++ai)
#pragma unroll
            for (int m = 0; m < 4; ++m) {
                const int row = u.pm * BM + ai * HALF + wr * 64 + m * 16 + fr; const float s = ((const LAS float*)xlds)[ai * HALF + wr * 64 + m * 16 + fr];
#pragma unroll
                for (int bj = 0; bj < 2; ++bj) {
                    const int col = u.pn * BM + bj * HALF + wc * 32 + 8 * fq;
                    const u32x4 w = pack8(acc[ai][bj][m][0] * s, acc[ai][bj][m][1] * s);
                    bf16* dst;
                    if (u.pn < 2) { const int g = col >> 4, c0 = col & 15, b = row >> 11, si = row & 2047, k = si >> 4, t = si & 15;
                        dst = UX + ((size_t)(g * S5ROWS + b * S5NCH + k) * 512 + t * 16 + c0); }
                    else if (u.pn < 4) dst = XM + (size_t)row * 512 + (col - 512);
                    else dst = OP + (size_t)row * 512 + (col - 1024);
                    *(u32x4*)dst = w;
                }
            }
    }
};
struct EpiZ {
    __device__ __forceinline__ void pre(const Unit&, LAS unsigned char*, int) const {}
    static constexpr bool PEEL = false, PERM = true, AFTER_DRAIN = false; static constexpr int NS = 16;
    bf16* Z;
    __device__ __forceinline__ void operator()(const f32x4 (&acc)[2][2][4][2], const Unit& u, int wr, int wc, int fr, int fq, const LAS unsigned char* xlds) const {
#pragma unroll
        for (int ai = 0; ai < 2; ++ai)
#pragma unroll
            for (int m = 0; m < 4; ++m) {
                const size_t row = (size_t)u.pm * BM + ai * HALF + wr * 64 + m * 16 + fr;
#pragma unroll
                for (int bj = 0; bj < 2; ++bj) { const int col = bj * HALF + wc * 32 + 8 * fq; *(u32x4*)(Z + row * 256 + col) = pack8(acc[ai][bj][m][0], acc[ai][bj][m][1]); }
            }
    }
};
constexpr int ZLP = 528;
struct EpiZL {
    __device__ __forceinline__ void pre(const Unit&, LAS unsigned char*, int) const {}
    static constexpr bool PEEL = false, PERM = true, AFTER_DRAIN = false; static constexpr int NS = 0;
    __device__ __forceinline__ void operator()(const f32x4 (&acc)[2][2][4][2], const Unit& u, int wr, int wc, int fr, int fq, const LAS unsigned char* xlds) const {
        LAS unsigned char* zl = const_cast<LAS unsigned char*>(xlds) - STAGE_BYTES;
#pragma unroll
        for (int ai = 0; ai < 2; ++ai)
#pragma unroll
            for (int m = 0; m < 4; ++m) { const int row = ai * HALF + wr * 64 + m * 16 + fr;
#pragma unroll
                for (int bj = 0; bj < 2; ++bj) { const int col = bj * HALF + wc * 32 + 8 * fq; *(LAS u32x4*)(zl + row * ZLP + col * 2) = pack8(acc[ai][bj][m][0], acc[ai][bj][m][1]); } }
    }
};
struct S5One {
    int L;
    __device__ __forceinline__ bool next(int i, Unit& u) const { if (i != 0) return false; u.pm = L; u.pn = L >> 4; return true; }
    __device__ __forceinline__ void a_ready(const Unit&) const {}
    __device__ __forceinline__ void done(const Unit&) const {}
};
struct EpiY {
    __device__ __forceinline__ void pre(const Unit&, LAS unsigned char*, int) const {}
    static constexpr bool PEEL = true, PERM = true, AFTER_DRAIN = false; static constexpr int NS = 16;
    bf16* YACT;
    __device__ __forceinline__ void operator()(const f32x4 (&acc)[2][2][4][2], const Unit& u, int wr, int wc, int fr, int fq, const LAS unsigned char* xlds) const {
        const int g = u.pm >> 4;
#pragma unroll
        for (int ai = 0; ai < 2; ++ai)
#pragma unroll
            for (int m = 0; m < 4; ++m) {
                const int R = u.pm * BM + ai * HALF + wr * 64 + m * 16 + fr, rr = R & (S5ROWS - 1), b = rr >> 7, k = rr & 127;
#pragma unroll
                for (int bj = 0; bj < 2; ++bj) { const int colt = bj * HALF + wc * 32 + 8 * fq, t = colt >> 4, c0 = colt & 15;
                    const size_t token = (size_t)b * SEQ + k * S5L + t;
                    f32x4 v0 = acc[ai][bj][m][0], v1 = acc[ai][bj][m][1];
#pragma unroll
                    for (int e = 0; e < 4; ++e) { v0[e] = gelu_tanh(v0[e]); v1[e] = gelu_tanh(v1[e]); }
                    *(u32x4*)(YACT + token * 512 + g * 16 + c0) = pack8(v0, v1); }
            }
    }
};
struct EpiGLU {
    __device__ __forceinline__ void pre(const Unit&, LAS unsigned char*, int) const {}
    static constexpr bool PEEL = true, PERM = true, AFTER_DRAIN = false; static constexpr int NS = 16;
    const bf16* YACT; const float* bglu; bf16* YCAT;
    __device__ __forceinline__ void operator()(const f32x4 (&acc)[2][2][4][2], const Unit& u, int wr, int wc, int fr, int fq, const LAS unsigned char* xlds) const {
        u32x4 ya[2][2][4]; f32x4 bb[2][2];
        const size_t row0 = (size_t)u.pm * BM + wr * 64 + fr; const int col0 = u.pn * BM + wc * 32 + 8 * fq;
#pragma unroll
        for (int bj = 0; bj < 2; ++bj) { bb[bj][0] = *(const f32x4*)(bglu + col0 + bj * HALF); bb[bj][1] = *(const f32x4*)(bglu + col0 + bj * HALF + 4);
#pragma unroll
            for (int ai = 0; ai < 2; ++ai)
#pragma unroll
                for (int m = 0; m < 4; ++m) ya[bj][ai][m] = *(const u32x4*)(YACT + (row0 + ai * HALF + m * 16) * 512 + col0 + bj * HALF); }
#pragma unroll
        for (int bj = 0; bj < 2; ++bj)
#pragma unroll
            for (int ai = 0; ai < 2; ++ai)
#pragma unroll
                for (int m = 0; m < 4; ++m) {
                    const u32x4 y = ya[bj][ai][m];
                    const f32x4 z0 = acc[ai][bj][m][0] + bb[bj][0], z1 = acc[ai][bj][m][1] + bb[bj][1]; f32x4 o0, o1;
                    o0[0] = bflo(y.x) * sigmoidf_(z0[0]); o0[1] = bfhi(y.x) * sigmoidf_(z0[1]); o0[2] = bflo(y.y) * sigmoidf_(z0[2]); o0[3] = bfhi(y.y) * sigmoidf_(z0[3]);
                    o1[0] = bflo(y.z) * sigmoidf_(z1[0]); o1[1] = bfhi(y.z) * sigmoidf_(z1[1]); o1[2] = bflo(y.w) * sigmoidf_(z1[2]); o1[3] = bfhi(y.w) * sigmoidf_(z1[3]);
                    *(u32x4*)(YCAT + (row0 + ai * HALF + m * 16) * 1024 + col0 + bj * HALF) = pack8(o0, o1);
                }
    }
};
struct EpiPlain {
    __device__ __forceinline__ void pre(const Unit&, LAS unsigned char*, int) const {}
    static constexpr bool PEEL = false, PERM = true, AFTER_DRAIN = false; static constexpr int NS = 16;
    bf16* O; int ldc;
    __device__ __forceinline__ void operator()(const f32x4 (&acc)[2][2][4][2], const Unit& u, int wr, int wc, int fr, int fq, const LAS unsigned char* xlds) const {
#pragma unroll
        for (int ai = 0; ai < 2; ++ai)
#pragma unroll
            for (int m = 0; m < 4; ++m) {
                const size_t row = (size_t)u.pm * BM + ai * HALF + wr * 64 + m * 16 + fr;
#pragma unroll
                for (int bj = 0; bj < 2; ++bj) { const int col = u.pn * BM + bj * HALF + wc * 32 + 8 * fq; *(u32x4*)(O + row * ldc + col) = pack8(acc[ai][bj][m][0], acc[ai][bj][m][1]); }
            }
    }
};
struct EpiNull {
    __device__ __forceinline__ void pre(const Unit&, LAS unsigned char*, int) const {}
    static constexpr bool PEEL = false, PERM = true, AFTER_DRAIN = false; static constexpr int NS = 0;
    __device__ __forceinline__ void operator()(const f32x4 (&acc)[2][2][4][2], const Unit& u, int wr, int wc, int fr, int fq, const LAS unsigned char* xlds) const {
#pragma unroll
        for (int ai = 0; ai < 2; ++ai)
#pragma unroll
            for (int bj = 0; bj < 2; ++bj)
#pragma unroll
                for (int m = 0; m < 4; ++m)
#pragma unroll
                    for (int n = 0; n < 2; ++n) asm volatile("" :: "v"(acc[ai][bj][m][n]));
    }
};
struct PanelSS {
    unsigned long long* slots;
    unsigned* tmo;
    template <class F> __device__ __forceinline__ bool run(const f32x4 (&v)[2][2][4][2], const Unit& u, int wr, int wc, int fr, int fq, LAS unsigned char* xl, F mid) const {
        LAS float* P = (LAS float*)(xl + 4096); LAS float* S = (LAS float*)(xl + 8192);
        const int wid = wr * 4 + wc, lane = fq * 16 + fr;
#pragma unroll
        for (int ai = 0; ai < 2; ++ai)
#pragma unroll
            for (int m = 0; m < 4; ++m) {
                float q = 0.f;
#pragma unroll
                for (int bj = 0; bj < 2; ++bj)
#pragma unroll
                    for (int n = 0; n < 2; ++n) { const f32x4 x = v[ai][bj][m][n]; q += (x[0] * x[0] + x[1] * x[1]) + (x[2] * x[2] + x[3] * x[3]); }
                q += __shfl_xor(q, 16); q += __shfl_xor(q, 32);
                P[(ai * HALF + wr * 64 + m * 16 + fr) * 4 + wc] = q;
            }
        asm volatile("s_waitcnt lgkmcnt(0)" ::: "memory"); __builtin_amdgcn_s_barrier(); asm volatile("" ::: "memory");
        const int row = wid * 32 + (lane & 31);
        unsigned long long* sl = slots + (size_t)u.pm * BM + row;
        if (lane < 32) {
            const f32x4 p = *(const LAS f32x4*)(P + row * 4);
            __hip_atomic_store(sl + (size_t)u.pn * MTOK, (1ull << 32) | (unsigned long long)__builtin_bit_cast(unsigned, (p[0] + p[1]) + (p[2] + p[3])), __ATOMIC_RELAXED, __HIP_MEMORY_SCOPE_AGENT);
        }
        mid();
        float tot = 0.f; bool ok = true; unsigned spins = 0u;
        for (;;) {
            ok = true; tot = 0.f;
            if (lane < 32) {
#pragma unroll
                for (int t = 0; t < 4; ++t) { const unsigned long long x = __hip_atomic_load(sl + (size_t)t * MTOK, __ATOMIC_RELAXED, __HIP_MEMORY_SCOPE_AGENT); ok = ok && ((unsigned)(x >> 32) == 1u); tot += __builtin_bit_cast(float, (unsigned)x); }
            }
            if (__all(ok)) break;
            if (++spins > (1u << 15)) { if (lane == 0) __hip_atomic_store(tmo, 1u, __ATOMIC_RELAXED, __HIP_MEMORY_SCOPE_AGENT); break; }
            __builtin_amdgcn_s_sleep(1);
        }
        const bool good = __all(ok);
        if (lane < 32) S[row] = good ? __builtin_amdgcn_rsqf(tot * (1.f / 1024.f) + EPS) : __builtin_nanf("");
        asm volatile("s_waitcnt lgkmcnt(0)" ::: "memory"); __builtin_amdgcn_s_barrier(); asm volatile("" ::: "memory");
        return false;
    }
};
struct EpiMid {
    __device__ __forceinline__ void pre(const Unit&, LAS unsigned char*, int) const {}
    static constexpr bool PEEL = false, PERM = true, AFTER_DRAIN = false; static constexpr int NS = 0;
    bf16* XB; const float* gpost; float* RS2P; PanelSS st1;
    __device__ __forceinline__ void operator()(const f32x4 (&acc_)[2][2][4][2], const Unit& u, int wr, int wc, int fr, int fq, const LAS unsigned char* xlds) const {
        f32x4 (&acc)[2][2][4][2] = const_cast<f32x4 (&)[2][2][4][2]>(acc_);
        LAS unsigned char* xl = const_cast<LAS unsigned char*>(xlds);
        LAS float* P = (LAS float*)(xl + 4096); const LAS float* S = (const LAS float*)(xl + 8192);
        const bf16* xb0 = XB + (size_t)(u.pm * BM + wr * 64 + fr) * DM + u.pn * BM + wc * 32 + 8 * fq;
        u32x4 r0[4][2];
#pragma unroll
        for (int m = 0; m < 4; ++m)
#pragma unroll
            for (int bj = 0; bj < 2; ++bj) r0[m][bj] = *(const u32x4*)(xb0 + (size_t)(m * 16) * DM + bj * HALF);
        f32x4 g[2][2];
#pragma unroll
        for (int bj = 0; bj < 2; ++bj) { const int col = u.pn * BM + bj * HALF + wc * 32 + 8 * fq; g[bj][0] = *(const f32x4*)(gpost + col); g[bj][1] = *(const f32x4*)(gpost + col + 4); }
        u32x4 r1[4][2];
        (void)st1.run(acc, u, wr, wc, fr, fq, xl, [&]() {
#pragma unroll
            for (int m = 0; m < 4; ++m)
#pragma unroll
                for (int bj = 0; bj < 2; ++bj) r1[m][bj] = *(const u32x4*)(xb0 + (size_t)(HALF + m * 16) * DM + bj * HALF); });
#pragma unroll
        for (int ai = 0; ai < 2; ++ai)
#pragma unroll
            for (int m = 0; m < 4; ++m) { const int r = ai * HALF + wr * 64 + m * 16 + fr; const float rsy = S[r]; const size_t row = (size_t)u.pm * BM + r; float q = 0.f;
#pragma unroll
                for (int bj = 0; bj < 2; ++bj) { const int col = u.pn * BM + bj * HALF + wc * 32 + 8 * fq;
                    const u32x4 xv = ai == 0 ? r0[m][bj] : r1[m][bj];
                    const f32x4 a0 = acc[ai][bj][m][0], a1 = acc[ai][bj][m][1]; f32x4 o0, o1;
                    o0[0] = bflo(xv.x) + g[bj][0][0] * a0[0] * rsy; o0[1] = bfhi(xv.x) + g[bj][0][1] * a0[1] * rsy; o0[2] = bflo(xv.y) + g[bj][0][2] * a0[2] * rsy; o0[3] = bfhi(xv.y) + g[bj][0][3] * a0[3] * rsy;
                    o1[0] = bflo(xv.z) + g[bj][1][0] * a1[0] * rsy; o1[1] = bfhi(xv.z) + g[bj][1][1] * a1[1] * rsy; o1[2] = bflo(xv.w) + g[bj][1][2] * a1[2] * rsy; o1[3] = bfhi(xv.w) + g[bj][1][3] * a1[3] * rsy;
                    q += (o0[0] * o0[0] + o0[1] * o0[1]) + (o0[2] * o0[2] + o0[3] * o0[3]) + (o1[0] * o1[0] + o1[1] * o1[1]) + (o1[2] * o1[2] + o1[3] * o1[3]);
                    *(u32x4*)(XB + row * DM + col) = pack8(o0, o1); }
                q += __shfl_xor(q, 16); q += __shfl_xor(q, 32);
                P[r * 4 + wc] = q;
            }
        asm volatile("s_waitcnt lgkmcnt(0)" ::: "memory"); __builtin_amdgcn_s_barrier(); asm volatile("" ::: "memory");
        { const int wid = wr * 4 + wc, lane = fq * 16 + fr, row = wid * 32 + (lane & 31);
          if (lane < 32) { const f32x4 p = *(const LAS f32x4*)(P + row * 4); RS2P[((size_t)u.pm * BM + row) * 4 + u.pn] = (p[0] + p[1]) + (p[2] + p[3]); } }
        asm volatile("s_waitcnt lgkmcnt(0)" ::: "memory"); __builtin_amdgcn_s_barrier(); asm volatile("" ::: "memory");
    }
};
struct EpiOut {
    __device__ __forceinline__ void pre(const Unit&, LAS unsigned char*, int) const {}
    static constexpr bool PEEL = true, PERM = false, AFTER_DRAIN = false; static constexpr int NS = 0;
    const bf16* XB; const float* gpost; float* out; PanelSS st;
    __device__ __forceinline__ void operator()(const f32x4 (&acc)[2][2][4][2], const Unit& u, int wr, int wc, int fr, int fq, const LAS unsigned char* xlds) const {
        LAS unsigned char* xl = const_cast<LAS unsigned char*>(xlds);
        const LAS float* S = (const LAS float*)(xl + 8192);
        const size_t off0 = (size_t)(u.pm * BM + wr * 64 + fr) * DM + u.pn * BM + wc * 32 + 4 * fq;
        const bf16* xb0 = XB + off0; float* o0p = out + off0;
        u32x2 r0[4][2][2];
#pragma unroll
        for (int m = 0; m < 4; ++m)
#pragma unroll
            for (int bj = 0; bj < 2; ++bj)
#pragma unroll
                for (int n = 0; n < 2; ++n) r0[m][bj][n] = *(const u32x2*)(xb0 + (size_t)(m * 16) * DM + bj * HALF + 16 * n);
        f32x4 g[2][2];
#pragma unroll
        for (int bj = 0; bj < 2; ++bj)
#pragma unroll
            for (int n = 0; n < 2; ++n) g[bj][n] = *(const f32x4*)(gpost + u.pn * BM + bj * HALF + wc * 32 + 16 * n + 4 * fq);
        u32x2 r1[4][2][2];
        (void)st.run(acc, u, wr, wc, fr, fq, xl, [&]() {
#pragma unroll
            for (int m = 0; m < 4; ++m)
#pragma unroll
                for (int bj = 0; bj < 2; ++bj)
#pragma unroll
                    for (int n = 0; n < 2; ++n) r1[m][bj][n] = *(const u32x2*)(xb0 + (size_t)(HALF + m * 16) * DM + bj * HALF + 16 * n); });
#pragma unroll
        for (int ai = 0; ai < 2; ++ai)
#pragma unroll
            for (int m = 0; m < 4; ++m) { const int r = ai * HALF + wr * 64 + m * 16 + fr; const float rsf = S[r];
#pragma unroll
                for (int bj = 0; bj < 2; ++bj)
#pragma unroll
                    for (int n = 0; n < 2; ++n) {
                        const u32x2 xv = ai == 0 ? r0[m][bj][n] : r1[m][bj][n]; const f32x4 a0 = acc[ai][bj][m][n]; f32x4 o;
                        o[0] = bflo(xv.x) + g[bj][n][0] * a0[0] * rsf; o[1] = bfhi(xv.x) + g[bj][n][1] * a0[1] * rsf; o[2] = bflo(xv.y) + g[bj][n][2] * a0[2] * rsf; o[3] = bfhi(xv.y) + g[bj][n][3] * a0[3] * rsf;
                        *(f32x4*)(o0p + (size_t)(ai * HALF + m * 16) * DM + bj * HALF + 16 * n) = o; }
            }
    }
};
struct EpiGU {
    static constexpr bool PEEL = true, PERM = true, AFTER_DRAIN = false; static constexpr int NS = 8;
    const float* rs2p; bf16* ACT; int pn0;
    __device__ __forceinline__ void pre(const Unit& u, LAS unsigned char* xlds, int tid) const {
        if (tid < 64) {
#pragma unroll
            for (int i = 0; i < 4; ++i) __builtin_amdgcn_global_load_lds((const unsigned*)(rs2p + ((size_t)u.pm * BM + i * 64 + tid) * 4), (LAS unsigned*)(xlds + i * 1024), 16, 0, 0); }
    }
    __device__ __forceinline__ void operator()(const f32x4 (&acc)[2][2][4][2], const Unit& u, int wr, int wc, int fr, int fq, const LAS unsigned char* xlds) const {
        const int hid = (u.pn + pn0) * HALF + wc * 32 + 8 * fq;
        float vv[8], sll[8];
#pragma unroll
        for (int i = 0; i < 8; ++i) { const f32x4 pq = *(const LAS f32x4*)(xlds + ((i >> 2) * HALF + wr * 64 + (i & 3) * 16 + fr) * 16);
            vv[i] = ((pq[0] + pq[1]) + (pq[2] + pq[3])) * (1.f / 1024.f) + EPS; }
#pragma unroll
        for (int i = 0; i < 8; ++i) sll[i] = __builtin_amdgcn_rsqf(vv[i]) * -1.4426950408889634f;
#pragma unroll
        for (int ai = 0; ai < 2; ++ai)
#pragma unroll
            for (int m = 0; m < 4; ++m) {
                const size_t row = (size_t)u.pm * BM + ai * HALF + wr * 64 + m * 16 + fr; const float v = vv[ai * 4 + m], sl = sll[ai * 4 + m];
                const f32x2 v2 = {v, v}, sl2 = {sl, sl};
                f32x4 o[2];
#pragma unroll
                for (int n = 0; n < 2; ++n)
#pragma unroll
                    for (int p = 0; p < 2; ++p) {
                        const f32x2 g2 = {acc[ai][0][m][n][2 * p], acc[ai][0][m][n][2 * p + 1]}, u2 = {acc[ai][1][m][n][2 * p], acc[ai][1][m][n][2 * p + 1]};
                        const f32x2 t = g2 * sl2; f32x2 e = {__builtin_amdgcn_exp2f(t[0]), __builtin_amdgcn_exp2f(t[1])};
                        e = __builtin_elementwise_fma(e, v2, v2); const f32x2 r = {frcp(e[0]), frcp(e[1])}, q = (g2 * u2) * r;
                        o[n][2 * p] = q[0]; o[n][2 * p + 1] = q[1]; }
                *(u32x4*)(ACT + row * DFF + hid) = pack8(o[0], o[1]);
            }
    }
};

template <class Epi, class Sched, bool ALIGN_EPI = true, bool NOWRAP = false>
__device__ __forceinline__ void gemm_phase(LAS unsigned char* lds, const Gemm g, Sched S, const Epi& E) {
    int tid = threadIdx.x; asm volatile("" : "+v"(tid));
    const int wid = __builtin_amdgcn_readfirstlane(tid >> 6), lane = tid & 63, wr = wid >> 2, wc = wid & 3, fr = lane & 15, fq = lane >> 4;
    const int K = g.K, nt = K / BK;
    unsigned voffA[2], voffB[2];
#pragma unroll
    for (int i = 0; i < 2; ++i) { int R, C; stage_rc(tid * 16 + i * 8192, R, C); const int Rb = Epi::PERM ? ((R & ~31) + perm32(R & 31)) : R;
        voffA[i] = (unsigned)(R * g.lda + C) * 2u; voffB[i] = (unsigned)(Rb * g.ldb + C) * 2u; }
    const size_t kstep = (size_t)(BK * 2);
    const size_t hstepA = (size_t)HALF * g.lda * 2, hstepB = (size_t)HALF * g.ldb * 2;
    const size_t tstepA = 2 * hstepA, tstepB = 2 * hstepB;
    const unsigned ldsw = (unsigned)wid * 1024u;
    const int aoff = lds_byte(wr * 64 + fr, fq * 8), boff = lds_byte(wc * 32 + fr, fq * 8);
#define PG8_SA(b, h) (((b) * 2 + (h)) * HTB)
#define PG8_SB(b, h) ((4 + (b) * 2 + (h)) * HTB)
#define PG8_STAGE(bufoff, gbase, voff) do { _Pragma("unroll") for (int _i = 0; _i < 2; ++_i) \
        __builtin_amdgcn_global_load_lds((const unsigned*)((const char*)(gbase) + (voff)[_i]), (LAS unsigned*)(lds + (bufoff) + ldsw + _i * 8192), 16, 0, 0); } while (0)
#define PG8_LDA(dst, b, h) do { _Pragma("unroll") for (int m = 0; m < 4; ++m) _Pragma("unroll") for (int k = 0; k < 2; ++k) dst[m][k] = *(const LAS bf16x8*)(lds + PG8_SA(b, h) + aoff + m * 2048 + k * 1024); } while (0)
#define PG8_LDB(dst, b, h) do { _Pragma("unroll") for (int n = 0; n < 2; ++n) _Pragma("unroll") for (int k = 0; k < 2; ++k) dst[n][k] = *(const LAS bf16x8*)(lds + PG8_SB(b, h) + boff + n * 2048 + k * 1024); } while (0)
#define PG8_MMA(ai, bj, At, Bt) do { __builtin_amdgcn_s_setprio(1); _Pragma("unroll") for (int m = 0; m < 4; ++m) _Pragma("unroll") for (int n = 0; n < 2; ++n) _Pragma("unroll") for (int k = 0; k < 2; ++k) \
        acc[ai][bj][m][n] = __builtin_amdgcn_mfma_f32_16x16x32_bf16(Bt[n][k], At[m][k], acc[ai][bj][m][n], 0, 0, 0); __builtin_amdgcn_s_setprio(0); } while (0)
#define PG8_MMAZ(ai, bj, At, Bt) do { __builtin_amdgcn_s_setprio(1); _Pragma("unroll") for (int m = 0; m < 4; ++m) _Pragma("unroll") for (int n = 0; n < 2; ++n) { \
        acc[ai][bj][m][n] = __builtin_amdgcn_mfma_f32_16x16x32_bf16(Bt[n][0], At[m][0], (f32x4){0.f, 0.f, 0.f, 0.f}, 0, 0, 0); \
        acc[ai][bj][m][n] = __builtin_amdgcn_mfma_f32_16x16x32_bf16(Bt[n][1], At[m][1], acc[ai][bj][m][n], 0, 0, 0); } __builtin_amdgcn_s_setprio(0); } while (0)
#define PG8_WAIT_V(n) asm volatile("s_waitcnt vmcnt(" #n ")" ::: "memory")
#define PG8_WAIT_L(n) asm volatile("s_waitcnt lgkmcnt(" #n ")" ::: "memory")
#define PG8_WAIT_VF PG8_WAIT_V(8)
#define PG8_BAR __builtin_amdgcn_s_barrier()
#define PG8_SCHED __builtin_amdgcn_sched_barrier(0)
    Unit cur, nxt; int ui = 0;
    if (!S.next(0, cur)) return;
    f32x4 acc[2][2][4][2];
    bf16x8 At[4][2], B0[2][2], B1[2][2];
    const char* cA = (const char*)g.A + (size_t)cur.pm * tstepA; const char* cB = (const char*)g.Bt + (size_t)cur.pn * tstepB;
    S.a_ready(cur);
    PG8_STAGE(PG8_SB(0, 0), cB, voffB); PG8_STAGE(PG8_SB(0, 1), cB + hstepB, voffB); PG8_STAGE(PG8_SA(0, 0), cA, voffA); PG8_STAGE(PG8_SA(0, 1), cA + hstepA, voffA);
    if (wr == 1) PG8_BAR;
    PG8_WAIT_V(2); PG8_BAR;
    PG8_STAGE(PG8_SB(1, 0), cB + kstep, voffB); PG8_STAGE(PG8_SA(1, 0), cA + kstep, voffA); PG8_STAGE(PG8_SB(1, 1), cB + hstepB + kstep, voffB);
    PG8_WAIT_V(6); PG8_BAR;
    for (;;) {
        const bool has_next = S.next(ui + 1, nxt);
        const char* nA = has_next ? (const char*)g.A + (size_t)nxt.pm * tstepA : cA; const char* nB = has_next ? (const char*)g.Bt + (size_t)nxt.pn * tstepB : cB;
#define PG8_KBODY(MM, LAST) { \
            const bool last = (LAST); \
            const char* a1 = cA + (size_t)(t + 1) * kstep; \
            const char* a2 = last ? nA : cA + (size_t)(t + 2) * kstep; const char* b2 = last ? nB : cB + (size_t)(t + 2) * kstep; \
            const char* a3 = a2 + kstep; const char* b3 = b2 + kstep; \
            if (last && has_next) S.a_ready(nxt); \
            if (last) { int tp = tid; asm volatile("" : "+v"(tp)); E.pre(cur, lds + STAGE_BYTES, tp); }     \
              \
            PG8_LDB(B0, 0, 0); PG8_LDB(B1, 0, 1); PG8_SCHED; PG8_LDA(At, 0, 0); PG8_STAGE(PG8_SA(1, 1), a1 + hstepA, voffA); \
            PG8_WAIT_VF; PG8_WAIT_L(0); PG8_BAR; MM(0, 0, At, B0); MM(0, 1, At, B1); PG8_BAR; PG8_SCHED; \
            const bool nw = NOWRAP && last;     \
              \
            PG8_LDA(At, 0, 1); if (!nw) { PG8_STAGE(PG8_SB(0, 0), b2, voffB); PG8_STAGE(PG8_SB(0, 1), b2 + hstepB, voffB); PG8_STAGE(PG8_SA(0, 0), a2, voffA); } \
            if (nw) PG8_WAIT_V(2); else PG8_WAIT_VF; PG8_WAIT_L(0); PG8_BAR; MM(1, 0, At, B0); MM(1, 1, At, B1); PG8_BAR; PG8_SCHED; \
              \
            PG8_LDB(B0, 1, 0); PG8_LDB(B1, 1, 1); PG8_SCHED; PG8_LDA(At, 1, 0); if (!nw) PG8_STAGE(PG8_SA(0, 1), a2 + hstepA, voffA); \
            if (nw) PG8_WAIT_V(0); else PG8_WAIT_V(8); PG8_WAIT_L(0); PG8_BAR; PG8_MMA(0, 0, At, B0); PG8_MMA(0, 1, At, B1); PG8_BAR; PG8_SCHED; \
              \
            PG8_LDA(At, 1, 1); if (!nw) { PG8_STAGE(PG8_SB(1, 0), b3, voffB); PG8_STAGE(PG8_SB(1, 1), b3 + hstepB, voffB); PG8_STAGE(PG8_SA(1, 0), a3, voffA); } \
            if (nw) PG8_WAIT_V(0); else PG8_WAIT_V(8); PG8_WAIT_L(0); PG8_BAR; PG8_MMA(1, 0, At, B0); PG8_MMA(1, 1, At, B1); PG8_BAR; PG8_SCHED; }
        if constexpr (Epi::PEEL) { int t = 0; asm volatile("" : "+s"(t)); PG8_KBODY(PG8_MMAZ, false) } else { _Pragma("unroll") for (int a_ = 0; a_ < 2; ++a_) _Pragma("unroll") for (int b_ = 0; b_ < 2; ++b_) _Pragma("unroll") for (int m_ = 0; m_ < 4; ++m_) _Pragma("unroll") for (int n_ = 0; n_ < 2; ++n_) acc[a_][b_][m_][n_] = (f32x4){0.f, 0.f, 0.f, 0.f}; }
#pragma unroll 1
        for (int t = Epi::PEEL ? 2 : 0; t < nt; t += 2) PG8_KBODY(PG8_MMA, t == nt - 2)
#undef PG8_KBODY
        if constexpr (ALIGN_EPI) { if (wr == 0) PG8_BAR; }
        { int tv = tid; asm volatile("" : "+v"(tv)); const int frv = tv & 15, fqv = (tv >> 4) & 3;
          E(acc, cur, wr, wc, frv, fqv, lds + STAGE_BYTES); } S.done(cur);
        if (!has_next) break;
        cur = nxt; cA = nA; cB = nB; ++ui;
        if constexpr (ALIGN_EPI) { if (wr == 1) PG8_BAR; }
    }
    PG8_WAIT_V(0);
    if constexpr (!ALIGN_EPI) { if (wr == 0) PG8_BAR; }
    PG8_BAR;
#undef PG8_SA
#undef PG8_SB
#undef PG8_STAGE
#undef PG8_LDA
#undef PG8_LDB
#undef PG8_MMA
#undef PG8_MMAZ
#undef PG8_WAIT_V
#undef PG8_WAIT_L
#undef PG8_WAIT_VF
#undef PG8_BAR
#undef PG8_SCHED
}
}

#define XB_TMO      128
#define XB_XCNT(j)  (256  + 64 * (j))
#define XB_XSUB(j)  (1280 + 64 * (j))
#define XB_XGEN(j)  (2304 + 64 * (j))
#define XB_TOP      3328
#define XB_TOPGEN   3392
#define XCD_BAR_WORDS 3456
#define XB_SPIN_CAP (1u << 20)
__device__ __forceinline__ unsigned xb_ld(unsigned* p)              { return __hip_atomic_load(p, __ATOMIC_RELAXED, __HIP_MEMORY_SCOPE_AGENT); }
__device__ __forceinline__ unsigned xb_add(unsigned* p, unsigned v) { return __hip_atomic_fetch_add(p, v, __ATOMIC_RELAXED, __HIP_MEMORY_SCOPE_AGENT); }
__device__ __forceinline__ unsigned xb_xcc_id() { return (unsigned)__builtin_amdgcn_s_getreg((3 << 11) | 20) & 0xFu; }
#define XB_SPIN(cond, bar) do { unsigned _sp = 0; while (cond) { __builtin_amdgcn_s_sleep(1); \
    if ((++_sp & 255u) == 0u) { if (xb_ld(&(bar)[XB_TMO])) break; if (_sp > XB_SPIN_CAP) { atomicAdd(&(bar)[XB_TMO], 1u); break; } } } } while (0)
struct XcdBarrier { unsigned* bar; unsigned x; volatile LAS unsigned* st; };
__device__ __forceinline__ XcdBarrier xcd_barrier_post(unsigned* bar, volatile LAS unsigned* st) {
    XcdBarrier b; b.bar = bar; b.x = xb_xcc_id(); b.st = st;
    if (threadIdx.x == 0) (void)xb_add(&bar[XB_XCNT(b.x)], 1u);
    return b;
}
__device__ __forceinline__ void xcd_barrier_complete(unsigned* bar, unsigned x, unsigned& nloc, unsigned& nx) {
    const unsigned G = gridDim.x * gridDim.y * gridDim.z;
    unsigned sum, cnt, mine, sp = 0u;
    for (;;) {
        sum = 0u; cnt = 0u; mine = 0u;
#pragma unroll
        for (unsigned j = 0; j < 16; ++j) { const unsigned c = xb_ld(&bar[XB_XCNT(j)]); sum += c; cnt += (c > 0u) ? 1u : 0u; mine = (j == x) ? c : mine; }
        if (sum == G) break;
        __builtin_amdgcn_s_sleep(1);
        if ((++sp & 255u) == 0u) { if (xb_ld(&bar[XB_TMO])) break; if (sp > XB_SPIN_CAP) { atomicAdd(&bar[XB_TMO], 1u); break; } }
    }
    nloc = mine > 0u ? mine : 1u; nx = cnt > 0u ? cnt : 1u;
}
__device__ __forceinline__ void xcd_barrier(const XcdBarrier& b) {
    asm volatile("s_waitcnt vmcnt(0)" ::: "memory");
    __syncthreads();
    if (threadIdx.x == 0) {
        unsigned* bar = b.bar;
        __builtin_amdgcn_s_waitcnt(0);
        unsigned nloc = b.st[0], nx = b.st[1];
        if (nloc == 0u) { xcd_barrier_complete(bar, b.x, nloc, nx); b.st[0] = nloc; b.st[1] = nx; }
        const unsigned old = xb_add(&bar[XB_XSUB(b.x)], 1u);
        const unsigned gen = old / nloc;
        if (old + 1u == (gen + 1u) * nloc) {
            __builtin_amdgcn_fence(__ATOMIC_RELEASE, "agent");
            asm volatile("s_waitcnt vmcnt(0)" ::: "memory");
            const unsigned og = xb_add(&bar[XB_TOP], 1u);
            const unsigned tg = og / nx;
            if (og + 1u == (tg + 1u) * nx) xb_add(&bar[XB_TOPGEN], 1u);
            else XB_SPIN(xb_ld(&bar[XB_TOPGEN]) == tg, bar);
            __builtin_amdgcn_fence(__ATOMIC_ACQUIRE, "agent");
            xb_add(&bar[XB_XGEN(b.x)], 1u);
            asm volatile("s_waitcnt vmcnt(0)" ::: "memory");
        } else {
            XB_SPIN(xb_ld(&bar[XB_XGEN(b.x)]) == gen, bar);
            __builtin_amdgcn_fence(__ATOMIC_ACQUIRE, "agent");
            asm volatile("s_waitcnt vmcnt(0)" ::: "memory");
        }
    }
    __syncthreads();
}

struct Args {
    const float* in[28]; float* out; unsigned char* ws; int ph_lo, ph_hi, pad0, pad1;
};
enum { I_X = 0, I_NMPRE, I_NMPOST, I_NFPRE, I_NFPOST, I_WIN, I_GBIAS, I_LRE, I_LIM, I_LDT, I_BRE, I_BIM, I_CRE, I_CIM, I_S5D, I_WGLU, I_BGLU,
       I_CONVW, I_CONVB, I_WQ, I_WK, I_WV, I_HNORM, I_SKIP, I_WOUT, I_WGATE, I_WUP, I_WDOWN };


__device__ __forceinline__ void p0_s5_unit(const Args& a, unsigned char* ws, LAS unsigned char* lds, int u, int tid) {
    const int g = u >> 3, part = u & 7;
    LAS float* pwr = (LAS float*)lds; LAS float* pwi = pwr + 2176; LAS float* bbr = pwi + 2176; LAS float* bbi = bbr + 2048;
    LAS float* cr = bbi + 2048; LAS float* ci = cr + 1024; LAS float* kl = ci + 1024; LAS float* fac = kl + 8192;
    for (int idx = tid; idx < 2176; idx += NTHREADS) {
        const int dir = idx / 1088, rem = idx - dir * 1088, e = rem >> 6, p = rem & 63;
        const float lr = a.in[I_LRE][(dir * NG + g) * 64 + p], li = a.in[I_LIM][(dir * NG + g) * 64 + p], dt = expf(a.in[I_LDT][dir * NG + g]);
        const float mag = expf(lr * dt * (float)e); float sn, cs; sincosf(li * dt * (float)e, &sn, &cs);
        pwr[idx] = mag * cs; pwi[idx] = mag * sn;
        if (e == 1) { const float xr = expm1f(lr * dt) * cs - 2.f * sinf(0.5f * li * dt) * sinf(0.5f * li * dt), xi = mag * sn, den = lr * lr + li * li;
            fac[(dir * 64 + p) * 2] = (xr * lr + xi * li) / den; fac[(dir * 64 + p) * 2 + 1] = (xi * lr - xr * li) / den; }
    }
    for (int i = tid; i < 1024; i += NTHREADS) { const int c = i >> 6, p = i & 63; cr[p * 16 + c] = a.in[I_CRE][g * 1024 + i]; ci[p * 16 + c] = a.in[I_CIM][g * 1024 + i]; }
    __syncthreads();
    for (int idx = tid; idx < 2048; idx += NTHREADS) { const int dir = idx >> 10, p = (idx >> 4) & 63, c = idx & 15;
        const float fr = fac[(dir * 64 + p) * 2], fi = fac[(dir * 64 + p) * 2 + 1], b_r = a.in[I_BRE][(g * 64 + p) * 16 + c], b_i = a.in[I_BIM][(g * 64 + p) * 16 + c];
        bbr[idx] = fr * b_r - fi * b_i; bbi[idx] = fr * b_i + fi * b_r; }
    __syncthreads();
    {
        const int dir = tid >> 8, lsel = (tid >> 7) & 1, c = (tid >> 3) & 15, c2p = tid & 7, lag = 2 * part + lsel;
        float s0 = 0.f, s1 = 0.f;
        for (int p = 0; p < 64; ++p) {
            const float pr = pwr[(dir * 17 + lag) * 64 + p], pi = pwi[(dir * 17 + lag) * 64 + p], c_r = cr[p * 16 + c], c_i = ci[p * 16 + c];
            const float x_r = c_r * pr - c_i * pi, x_i = c_r * pi + c_i * pr;
            const f32x2 b_r = *(const LAS f32x2*)(bbr + (dir * 64 + p) * 16 + 2 * c2p), b_i = *(const LAS f32x2*)(bbi + (dir * 64 + p) * 16 + 2 * c2p);
            s0 += x_r * b_r[0] - x_i * b_i[0]; s1 += x_r * b_r[1] - x_i * b_i[1];
        }
        *(LAS f32x2*)(kl + ((dir * 2 + lsel) * 16 + c) * 16 + 2 * c2p) = (f32x2){s0, s1};
    }
    __syncthreads();
    bf16* MZ = (bf16*)(ws + WS_MZ) + (size_t)g * 256 * 256; bf16* TMY = (bf16*)(ws + WS_TMY) + (size_t)g * 256 * 512;
    for (int v = part * 1024 + tid; v < (part + 1) * 1024; v += NTHREADS) {
        const int n = v >> 5, k0 = (v & 31) * 8, dir = n >> 7, ri = (n >> 6) & 1, p = n & 63, j = k0 >> 4, c0 = k0 & 15, e = dir ? j : 15 - j;
        const float pr = pwr[(dir * 17 + e) * 64 + p], pi = pwi[(dir * 17 + e) * 64 + p]; float o[8];
#pragma unroll
        for (int cc = 0; cc < 8; ++cc) { const float b_r = bbr[(dir * 64 + p) * 16 + c0 + cc], b_i = bbi[(dir * 64 + p) * 16 + c0 + cc]; o[cc] = ri ? (pr * b_i + pi * b_r) : (pr * b_r - pi * b_i); }
        u32x4 w; w.x = pk2(o[0], o[1]); w.y = pk2(o[2], o[3]); w.z = pk2(o[4], o[5]); w.w = pk2(o[6], o[7]);
        *(u32x4*)(MZ + (size_t)n * 256 + k0) = w;
    }
    for (int v = tid; v < 2048; v += NTHREADS) {
        const int dir = v >> 10, lsel = (v >> 9) & 1, t = (v >> 5) & 15, c = (v >> 1) & 15, hf = v & 1, lag = 2 * part + lsel;
        const int j = dir ? t + lag : t - lag;
        if (j < 0 || j > 15 || (lag == 0 && dir == 1)) continue;
        float o[8];
#pragma unroll
        for (int cc = 0; cc < 8; ++cc) { const int c2 = 8 * hf + cc; float sv = kl[((dir * 2 + lsel) * 16 + c) * 16 + c2];
            if (lag == 0) { sv += kl[((1 * 2 + lsel) * 16 + c) * 16 + c2]; if (c2 == c) sv += a.in[I_S5D][g * 16 + c]; }
            o[cc] = sv; }
        u32x4 w; w.x = pk2(o[0], o[1]); w.y = pk2(o[2], o[3]); w.z = pk2(o[4], o[5]); w.w = pk2(o[6], o[7]);
        *(u32x4*)(TMY + (size_t)(t * 16 + c) * 512 + j * 16 + 8 * hf) = w;
    }
    for (int v = part * 1024 + tid; v < (part + 1) * 1024; v += NTHREADS) {
        const int n = v >> 5, k0 = 256 + (v & 31) * 8, t = n >> 4, c = n & 15; float o[8];
        const int s0 = k0 - 256, dir = s0 >> 7, ri = (s0 >> 6) & 1, e = dir ? 16 - t : t + 1;
#pragma unroll
        for (int cc = 0; cc < 8; ++cc) { const int p = (s0 & 63) + cc; const float pr = pwr[(dir * 17 + e) * 64 + p], pi = pwi[(dir * 17 + e) * 64 + p], c_r = cr[p * 16 + c], c_i = ci[p * 16 + c];
            o[cc] = ri ? -(c_r * pi + c_i * pr) : (c_r * pr - c_i * pi); }
        u32x4 w; w.x = pk2(o[0], o[1]); w.y = pk2(o[2], o[3]); w.z = pk2(o[4], o[5]); w.w = pk2(o[6], o[7]);
        *(u32x4*)(TMY + (size_t)n * 512 + k0) = w;
    }
    __syncthreads();
}
struct TrItem { const float* s0; const float* s1; const float* rs; bf16* dst; int ld, c0, c1, nh, k0, K; float cs; };
__device__ __forceinline__ void tr_load(const TrItem& t, f32x4 (&v)[2][4], float (&sc)[4], int tid) {
#pragma unroll
    for (int i = 0; i < 4; ++i) { const int idx = tid + NTHREADS * i, row = idx >> 5, c4 = idx & 31;
        sc[i] = t.rs ? t.rs[t.k0 + row] * t.cs : t.cs;
#pragma unroll
        for (int hf = 0; hf < 2; ++hf) { v[hf][i] = (f32x4){0.f, 0.f, 0.f, 0.f};
            if (hf < t.nh) v[hf][i] = *(const f32x4*)((hf ? t.s1 : t.s0) + (size_t)(t.k0 + row) * t.ld + (hf ? t.c1 : t.c0) + 4 * c4); } }
}
__device__ __forceinline__ void tr_finish(const TrItem& t, const f32x4 (&v)[2][4], const float (&sc)[4], LAS float* T, int tid) {
#pragma unroll
    for (int hf = 0; hf < 2; ++hf)
#pragma unroll
        for (int i = 0; i < 4; ++i) { const int idx = tid + NTHREADS * i, row = idx >> 5, c4 = idx & 31;
            LAS float* p = T + row * 257 + 128 * hf + 4 * c4; p[0] = v[hf][i][0] * sc[i]; p[1] = v[hf][i][1] * sc[i]; p[2] = v[hf][i][2] * sc[i]; p[3] = v[hf][i][3] * sc[i]; }
    __syncthreads();
#pragma unroll
    for (int i = 0; i < 4; ++i) { const int idx = tid + NTHREADS * i, n = idx >> 3, kc = idx & 7;
        if (n < 128 * t.nh) { const LAS float* p = T + (8 * kc) * 257 + n;
            u32x4 o; o.x = pk2(p[0], p[257]); o.y = pk2(p[2 * 257], p[3 * 257]); o.z = pk2(p[4 * 257], p[5 * 257]); o.w = pk2(p[6 * 257], p[7 * 257]);
            *(u32x4*)(t.dst + (size_t)n * t.K + t.k0 + 8 * kc) = o; } }
    __syncthreads();
}
constexpr int TR_J0 = 16 * 6, TR_J1 = 8 * 2, TR_J2 = 12 * 2, TR_J3 = 16 * 4, TR_J4 = 16 * 22, TR_J5 = 44 * 4, TR_NJ = TR_J0 + TR_J1 + TR_J2 + TR_J3 + TR_J4 + TR_J5;
__device__ __forceinline__ TrItem tr_decode(const Args& a, unsigned char* ws, int r) {
    if (r < TR_J0) { const int kb = r / 6, nb = r % 6; return TrItem{a.in[I_WIN], a.in[I_WIN], a.in[I_NMPRE], (bf16*)(ws + WS_WIN) + (size_t)(256 * nb) * 1024, D_IN, 256 * nb, 256 * nb + 128, 2, 64 * kb, 1024, 1.f}; } r -= TR_J0;
    if (r < TR_J1) { const int kb = r / 2, nb = r % 2; return TrItem{a.in[I_WGLU], a.in[I_WGLU], nullptr, (bf16*)(ws + WS_WGLU) + (size_t)(256 * nb) * 512, 512, 256 * nb, 256 * nb + 128, 2, 64 * kb, 512, 1.f}; } r -= TR_J1;
    if (r < TR_J2) { const int mh = r >> 1, kb = r & 1, mat = mh >> 2; const float* sp = (mat == 0 ? a.in[I_WQ] : mat == 1 ? a.in[I_WK] : a.in[I_WV]) + (size_t)(mh & 3) * 16384;
        return TrItem{sp, sp, nullptr, (bf16*)(ws + WS_WQKV) + (size_t)(mh * 128) * 128, 128, 0, 0, 1, 64 * kb, 128, mat == 1 ? 0.08838834764831845f : 1.f}; } r -= TR_J2;
    if (r < TR_J3) { const int kb = r / 4, nb = r % 4; return TrItem{a.in[I_WOUT], a.in[I_WOUT], nullptr, (bf16*)(ws + WS_WOUT) + (size_t)(256 * nb) * 1024, 1024, 256 * nb, 256 * nb + 128, 2, 64 * kb, 1024, 1.f}; } r -= TR_J3;
    if (r < TR_J4) { const int kb = r / 22, nb = r % 22; return TrItem{a.in[I_WGATE], a.in[I_WUP], a.in[I_NFPRE], (bf16*)(ws + WS_WGU) + (size_t)(256 * nb) * 1024, DFF, 128 * nb, 128 * nb, 2, 64 * kb, 1024, 1.f}; } r -= TR_J4;
    { const int kb = r / 4, nb = r % 4; return TrItem{a.in[I_WDOWN], a.in[I_WDOWN], nullptr, (bf16*)(ws + WS_WDN) + (size_t)(256 * nb) * DFF, 1024, 256 * nb, 256 * nb + 128, 2, 64 * kb, DFF, 1.f}; }
}
__device__ __forceinline__ void p0_prologue(const Args& a, unsigned char* ws, LAS unsigned char* lds, int tid, int wave, int lane, int vcu, int G) {
    for (int i = blockIdx.x * NTHREADS + tid; i < (int)(6 * MiB / 16); i += G * NTHREADS) *(u32x4*)(ws + WS_XS + (size_t)i * 16) = (u32x4){0u, 0u, 0u, 0u};
    const int gw = vcu * NWAVES + wave, NGW = G * NWAVES;
    {   LAS float* T = (LAS float*)lds;
        int it = vcu; bool have = it < TR_NJ; TrItem cur = tr_decode(a, ws, have ? it : 0); f32x4 v[2][4]; float sc[4];
        if (have) tr_load(cur, v, sc, tid);
        for (int u = blockIdx.x; u < NG * 8; u += G) p0_s5_unit(a, ws, lds, u, tid);
        while (have) {
            const int nx = it + G; const bool hn = nx < TR_NJ; const TrItem nxt = tr_decode(a, ws, hn ? nx : 0); f32x4 w[2][4]; float sn[4];
#pragma unroll
            for (int i = 0; i < 4; ++i) { sn[i] = 0.f; w[0][i] = (f32x4){0.f, 0.f, 0.f, 0.f}; w[1][i] = w[0][i]; }
            if (hn) tr_load(nxt, w, sn, tid);
            tr_finish(cur, v, sc, T, tid);
            cur = nxt; it = nx; have = hn;
#pragma unroll
            for (int i = 0; i < 4; ++i) { sc[i] = sn[i]; v[0][i] = w[0][i]; v[1][i] = w[1][i]; }
        }
    }
    __syncthreads();
    for (int idx = tid; idx < 32 * 64; idx += NTHREADS) {
        const int f = idx >> 6, l = idx & 63, n = l & 15, q = l >> 4, k0 = 64 * (f >> 1) + 16 * q + 8 * (f & 1); float o[8];
#pragma unroll
        for (int j = 0; j < 8; ++j) o[j] = a.in[I_NMPRE][k0 + j] * a.in[I_WIN][(size_t)(k0 + j) * D_IN + NPROJ + n];
        u32x4 w; w.x = pk2(o[0], o[1]); w.y = pk2(o[2], o[3]); w.z = pk2(o[4], o[5]); w.w = pk2(o[6], o[7]);
        *(LAS u32x4*)(lds + idx * 16) = w;
    }
    __syncthreads();
    const int r16 = lane & 15, q4 = lane >> 4;
    const float gbias = a.in[I_GBIAS][r16];
    float* RS1 = (float*)(ws + WS_RS1); float* GT = (float*)(ws + WS_GATES);
    for (int grp = gw; grp < MTOK / 16; grp += NGW) {
        const int row0 = grp * 16;
        const float* xr = a.in[I_X] + (size_t)(row0 + r16) * DM + 16 * q4;
        bf16* xo = (bf16*)(ws + WS_XB) + (size_t)(row0 + r16) * DM + 16 * q4;
        f32x4 acc = {0.f, 0.f, 0.f, 0.f}; float ss = 0.f;
#pragma unroll 1
        for (int half = 0; half < 4; ++half) {
            f32x4 v[4][4];
#pragma unroll
            for (int s8 = 0; s8 < 4; ++s8)
#pragma unroll
                for (int j = 0; j < 4; ++j) v[s8][j] = *(const f32x4*)(xr + 64 * (4 * half + s8) + 4 * j);
#pragma unroll
            for (int s8 = 0; s8 < 4; ++s8) {
                const int s = 4 * half + s8; const f32x4 v0 = v[s8][0], v1 = v[s8][1], v2 = v[s8][2], v3 = v[s8][3];
                ss += (v0[0] * v0[0] + v0[1] * v0[1]) + (v0[2] * v0[2] + v0[3] * v0[3]) + (v1[0] * v1[0] + v1[1] * v1[1]) + (v1[2] * v1[2] + v1[3] * v1[3])
                    + (v2[0] * v2[0] + v2[1] * v2[1]) + (v2[2] * v2[2] + v2[3] * v2[3]) + (v3[0] * v3[0] + v3[1] * v3[1]) + (v3[2] * v3[2] + v3[3] * v3[3]);
                u32x4 a0, a1; a0.x = pk2(v0[0], v0[1]); a0.y = pk2(v0[2], v0[3]); a0.z = pk2(v1[0], v1[1]); a0.w = pk2(v1[2], v1[3]);
                a1.x = pk2(v2[0], v2[1]); a1.y = pk2(v2[2], v2[3]); a1.z = pk2(v3[0], v3[1]); a1.w = pk2(v3[2], v3[3]);
                *(u32x4*)(xo + 64 * s) = a0; *(u32x4*)(xo + 64 * s + 8) = a1;
                const bf16x8 b0 = *(const LAS bf16x8*)(lds + ((2 * s) * 64 + lane) * 16), b1 = *(const LAS bf16x8*)(lds + ((2 * s + 1) * 64 + lane) * 16);
                acc = __builtin_amdgcn_mfma_f32_16x16x32_bf16(__builtin_bit_cast(bf16x8, a0), b0, acc, 0, 0, 0);
                acc = __builtin_amdgcn_mfma_f32_16x16x32_bf16(__builtin_bit_cast(bf16x8, a1), b1, acc, 0, 0, 0);
            }
        }
        ss += __shfl_xor(ss, 16); ss += __shfl_xor(ss, 32);
        const float rs = __builtin_amdgcn_rsqf(ss * (1.f / DM) + EPS);
        if (q4 == 0) RS1[row0 + r16] = rs;
#pragma unroll
        for (int reg = 0; reg < 4; ++reg) { const float rsr = __shfl(rs, 4 * q4 + reg); GT[(size_t)(row0 + 4 * q4 + reg) * 16 + r16] = acc[reg] * rsr + gbias; }
    }
    __syncthreads();
}

__device__ __forceinline__ void s5_scan_lds(const Args& a, unsigned char* ws, const LAS unsigned char* zl, int L, int tid) {
    if (tid < 256) {
        bf16* UX = (bf16*)(ws + WS_UX);
        const int g = L >> 4, bl = (tid >> 7) & 1, b = 2 * (L & 15) + bl, dir = (tid >> 6) & 1, p = tid & 63;
        const float lr = a.in[I_LRE][(dir * NG + g) * 64 + p], li = a.in[I_LIM][(dir * NG + g) * 64 + p], dt = expf(a.in[I_LDT][dir * NG + g]);
        const float mag = expf(lr * dt * 16.f); float sn, cs; sincosf(li * dt * 16.f, &sn, &cs);
        const float ar = mag * cs, ai = mag * sn;
        const LAS bf16* z = (const LAS bf16*)(zl + (size_t)(bl * S5NCH) * pg8::ZLP) + dir * 128 + p;
        bf16* o = UX + (size_t)(g * S5ROWS + b * S5NCH) * 512 + 256 + dir * 128 + p;
        float sr = 0.f, si = 0.f;
#pragma unroll 1
        for (int kb = 0; kb < S5NCH / 16; ++kb) {
            float zr[16], zi[16];
#pragma unroll
            for (int j = 0; j < 16; ++j) { const int kk = kb * 16 + j, k = dir ? (S5NCH - 1 - kk) : kk; zr[j] = bf2f(z[k * (pg8::ZLP / 2)]); zi[j] = bf2f(z[k * (pg8::ZLP / 2) + 64]); }
#pragma unroll
            for (int j = 0; j < 16; ++j) { const int kk = kb * 16 + j, k = dir ? (S5NCH - 1 - kk) : kk;
                o[(size_t)k * 512] = (bf16)(pk2(sr, 0.f) & 0xffffu); o[(size_t)k * 512 + 64] = (bf16)(pk2(si, 0.f) & 0xffffu);
                const float nr = ar * sr - ai * si + zr[j], ni = ar * si + ai * sr + zi[j]; sr = nr; si = ni; }
        }
    }
}

__device__ __forceinline__ void s5_scan(const Args& a, unsigned char* ws, int tid, int G) {
    const bf16* ZB = (const bf16*)(ws + WS_ZB); bf16* UX = (bf16*)(ws + WS_UX);
    for (int base = 0; base * G < NG * 16; base += 2) {
        const int L = (base + (tid >> 8)) * G + (int)blockIdx.x;
        if (L < NG * 16) {
            const int g = L >> 4, b = 2 * (L & 15) + ((tid >> 7) & 1), dir = (tid >> 6) & 1, p = tid & 63;
            const float lr = a.in[I_LRE][(dir * NG + g) * 64 + p], li = a.in[I_LIM][(dir * NG + g) * 64 + p], dt = expf(a.in[I_LDT][dir * NG + g]);
            const float mag = expf(lr * dt * 16.f); float sn, cs; sincosf(li * dt * 16.f, &sn, &cs);
            const float ar = mag * cs, ai = mag * sn;
            const bf16* z = ZB + (size_t)(g * S5ROWS + b * S5NCH) * 256 + dir * 128 + p;
            bf16* o = UX + (size_t)(g * S5ROWS + b * S5NCH) * 512 + 256 + dir * 128 + p;
            float sr = 0.f, si = 0.f;
#pragma unroll 1
            for (int kb = 0; kb < S5NCH / 16; ++kb) {
                float zr[16], zi[16];
#pragma unroll
                for (int j = 0; j < 16; ++j) { const int kk = kb * 16 + j, k = dir ? (S5NCH - 1 - kk) : kk; zr[j] = bf2f(z[(size_t)k * 256]); zi[j] = bf2f(z[(size_t)k * 256 + 64]); }
#pragma unroll
                for (int j = 0; j < 16; ++j) { const int kk = kb * 16 + j, k = dir ? (S5NCH - 1 - kk) : kk;
                    o[(size_t)k * 512] = (bf16)(pk2(sr, 0.f) & 0xffffu); o[(size_t)k * 512 + 64] = (bf16)(pk2(si, 0.f) & 0xffffu);
                    const float nr = ar * sr - ai * si + zr[j], ni = ar * si + ai * sr + zi[j]; sr = nr; si = ni; }
            }
        }
    }
}

__device__ __forceinline__ void ml_pre(const Args& a, unsigned char* ws, LAS unsigned char* lds, int gw, int NGW, int wave, int lane, int G) {
    const float* GT = (const float*)(ws + WS_GATES);
    LAS float* sm = (LAS float*)lds;
    const int w4 = __builtin_amdgcn_readfirstlane(wave) * 4;
    for (int cid = blockIdx.x; cid < BATCH * NH * 2; cid += G) {
        const int b = cid >> 3, h = (cid >> 1) & 3, dir = cid & 1;
        float* GS = (float*)(ws + WS_GS) + (size_t)cid * SEQ * 8;
        float gi[4], gf[4], rr[4], bs[4], Rm[4];
#pragma unroll
        for (int j = 0; j < 4; ++j) { const int lp = (w4 + j) * 64 + lane, pos = dir ? (SEQ - 1 - lp) : lp; const float* gp = GT + (size_t)(b * SEQ + pos) * 16;
            gi[j] = gp[(dir ? 4 : 0) + h]; gf[j] = gp[(dir ? 12 : 8) + h]; }
#pragma unroll
        for (int j = 0; j < 4; ++j) {
            const float lf = fminf(gf[j], 0.f) - log1pf(expf(-fabsf(gf[j])));
            float bsum = lf;
#pragma unroll
            for (int o = 1; o < 64; o <<= 1) { const float v = __shfl_up(bsum, o); if (lane >= o) bsum += v; }
            const float r = gi[j] - bsum; float R = r;
#pragma unroll
            for (int o = 1; o < 64; o <<= 1) { const float v = __shfl_up(R, o); if (lane >= o) R = fmaxf(R, v); }
            rr[j] = r; bs[j] = bsum; Rm[j] = R;
            if (lane == 63) *(LAS f32x2*)(sm + (w4 + j) * 2) = (f32x2){bsum, R};
        }
        __syncthreads();
        float ms = 0.f;
#pragma unroll
        for (int c = 0; c < 28; ++c) if (c < w4) { const f32x2 e = *(const LAS f32x2*)(sm + c * 2); ms = e[0] + fmaxf(ms, e[1]); }
#pragma unroll
        for (int j = 0; j < 4; ++j) { const int lp = (w4 + j) * 64 + lane;
            const float mu = fmaxf(ms, Rm[j]), mu_last = __shfl(mu, 63), b_last = __shfl(bs[j], 63);
            *(f32x4*)(GS + (size_t)lp * 8) = (f32x4){rr[j], mu, expf(ms - mu), expf(-(bs[j] + mu))};
            *(f32x2*)(GS + (size_t)lp * 8 + 4) = (f32x2){expf(rr[j] - mu_last), expf(ms - mu_last)};
            ms = b_last + mu_last; }
        __syncthreads();
    }
    const bf16* XMg = (const bf16*)(ws + WS_XM); bf16* XCg = (bf16*)(ws + WS_XC);
    const int col = 8 * lane;
    float cw[5][8], cb[8];
#pragma unroll
    for (int e = 0; e < 8; ++e) { cb[e] = a.in[I_CONVB][col + e];
#pragma unroll
        for (int j = 0; j < 5; ++j) cw[j][e] = a.in[I_CONVW][j * 512 + col + e]; }
    for (int grp = gw; grp < MTOK / 8; grp += NGW) {
        const int row0 = grp * 8, s0 = row0 & (SEQ - 1);
        u32x4 xv[12];
#pragma unroll
        for (int i = 0; i < 12; ++i) { const int sp = s0 + i - 2; xv[i] = (u32x4){0u, 0u, 0u, 0u}; if (sp >= 0 && sp < SEQ) xv[i] = *(const u32x4*)(XMg + (size_t)(row0 + i - 2) * 512 + col); }
#pragma unroll
        for (int r = 0; r < 8; ++r) { float z[8];
#pragma unroll
            for (int e = 0; e < 8; ++e) z[e] = cb[e];
#pragma unroll
            for (int j = 0; j < 5; ++j) { const u32x4 x = xv[r + j];
                z[0] += cw[j][0] * bflo(x.x); z[1] += cw[j][1] * bfhi(x.x); z[2] += cw[j][2] * bflo(x.y); z[3] += cw[j][3] * bfhi(x.y);
                z[4] += cw[j][4] * bflo(x.z); z[5] += cw[j][5] * bfhi(x.z); z[6] += cw[j][6] * bflo(x.w); z[7] += cw[j][7] * bfhi(x.w); }
            u32x4 o; o.x = pk2(siluf_(z[0]), siluf_(z[1])); o.y = pk2(siluf_(z[2]), siluf_(z[3])); o.z = pk2(siluf_(z[4]), siluf_(z[5])); o.w = pk2(siluf_(z[6]), siluf_(z[7]));
            *(u32x4*)(XCg + (size_t)(row0 + r) * 512 + col) = o; }
    }
}

constexpr int ML_XM = 0, ML_XC = 16384, ML_QS = 32768, ML_KS = 51200, ML_VT = 69632, ML_KT = 88064, ML_P = 108544, ML_CB = 118784, ML_SC = 153600;
constexpr int RPQ = 288, RQ = 160, RPC = 272, RQV = 144;
__device__ __forceinline__ int sw128(int row, int off) { return row * 256 + ((((off) >> 4) ^ (row & 15)) << 4) + (off & 15); }
__device__ __forceinline__ int sw64(int row, int off) { return row * 128 + ((((off) >> 4) ^ ((row >> 1) & 7)) << 4) + (off & 15); }
__device__ __forceinline__ int xsw(int row, int chunk) { return row * 256 + ((chunk ^ (row & 15)) << 4); }
constexpr int SC_R = 0, SC_MU = 64, SC_WI = 128, SC_ME = 192, SC_WS = 256, SC_DEN = 320, SC_NQ = 384, SC_DEC = 448, SC_BUF = 512, SC_N = 1024, SC_NB = 1152;
static_assert(ML_SC + (SC_NB + 64) * 4 <= MISC_OFF, "mLSTM LDS map");
typedef __bf16 bf16x2v __attribute__((ext_vector_type(2)));
__device__ __forceinline__ float dot2bf(unsigned a, unsigned b, float c) { return __builtin_amdgcn_fdot2_f32_bf16(__builtin_bit_cast(bf16x2v, a), __builtin_bit_cast(bf16x2v, b), c, false); }
#define MFMA16(a, b, c) __builtin_amdgcn_mfma_f32_16x16x32_bf16((a), (b), (c), 0, 0, 0)
__device__ __forceinline__ void mlstm_chain(const Args& a, unsigned char* ws, LAS unsigned char* lds, int cid, int tid, int wave, int lane) {
    const int b = cid >> 3, h = (cid >> 1) & 3, dir = cid & 1;
    const bf16* XMg = (const bf16*)(ws + WS_XM) + (size_t)b * SEQ * 512 + h * 128; const bf16* XCg = (const bf16*)(ws + WS_XC) + (size_t)b * SEQ * 512 + h * 128;
    const float* GS = (const float*)(ws + WS_GS) + (size_t)cid * SEQ * 8; bf16* HO = (bf16*)(ws + (dir ? WS_HB : WS_HF)) + (size_t)b * SEQ * 512 + h * 128;
    const bf16* WQ = (const bf16*)(ws + WS_WQKV) + (size_t)(0 * 4 + h) * 16384; const bf16* WK = (const bf16*)(ws + WS_WQKV) + (size_t)(1 * 4 + h) * 16384; const bf16* WV = (const bf16*)(ws + WS_WQKV) + (size_t)(2 * 4 + h) * 16384;
    LAS float* sc = (LAS float*)(lds + ML_SC);
    for (int i = tid; i < (ML_SC - ML_P) / 16; i += NTHREADS) *(LAS u32x4*)(lds + ML_P + i * 16) = (u32x4){0u, 0u, 0u, 0u};
    if (tid < 128) sc[SC_N + tid] = 0.f;
    if (tid < 64) sc[SC_NB + tid] = 0.f;
    for (int i = tid; i < 64 * 16; i += NTHREADS) { const int lr = i >> 4, cc = i & 15, pos = dir ? (SEQ - 1 - lr) : lr;
        *(LAS u32x4*)(lds + ML_XM + xsw(lr, cc)) = *(const u32x4*)(XMg + (size_t)pos * 512 + cc * 8);
        *(LAS u32x4*)(lds + ML_XC + xsw(lr, cc)) = *(const u32x4*)(XCg + (size_t)pos * 512 + cc * 8); }
    if (wave == 0) { const f32x4 g0 = *(const f32x4*)(GS + (size_t)lane * 8); const f32x2 g1 = *(const f32x2*)(GS + (size_t)lane * 8 + 4);
        sc[SC_R + lane] = g0[0]; sc[SC_MU + lane] = g0[1]; sc[SC_WI + lane] = g0[2]; sc[SC_ME + lane] = g0[3]; sc[SC_WS + lane] = g1[0]; sc[SC_DEN + lane] = 0.f; if (lane == 0) sc[SC_DEC] = g1[1]; }
    bf16x8 bq[4], bk[4], bv[4];
#pragma unroll
    for (int ks = 0; ks < 4; ++ks) { const size_t o = (size_t)(16 * wave + (lane & 15)) * 128 + 32 * ks + 8 * (lane >> 4); bq[ks] = *(const bf16x8*)(WQ + o); bk[ks] = *(const bf16x8*)(WK + o); bv[ks] = *(const bf16x8*)(WV + o); }
#pragma unroll
    for (int ks = 0; ks < 4; ++ks) asm volatile("" : "+v"(bq[ks]), "+v"(bk[ks]), "+v"(bv[ks]));
    f32x4 accC[8];
#pragma unroll
    for (int nt = 0; nt < 8; ++nt) accC[nt] = (f32x4){0.f, 0.f, 0.f, 0.f};
    __syncthreads();
#pragma unroll 1
    for (int ci = 0; ci < SEQ / 64; ++ci) {
        const int p0 = ci * 64;
        int tidv = tid; asm volatile("" : "+v"(tidv));
        const int lanev = tidv & 63, r16 = lanev & 15, q4 = lanev >> 4;
        LAS float* scc = sc + (ci & 1) * SC_BUF; LAS float* scn = sc + ((ci & 1) ^ 1) * SC_BUF;
        u32x4 pxm[2], pxc[2]; f32x4 pg0 = {0.f, 0.f, 0.f, 0.f}; f32x2 pg1 = {0.f, 0.f};
        const bool more = (ci + 1 < SEQ / 64);
#pragma unroll
        for (int i = 0; i < 2; ++i) { const int idx = tidv + NTHREADS * i, lr = idx >> 4, cc = idx & 15, lp = p0 + 64 + lr, pos = dir ? (SEQ - 1 - lp) : lp;
            pxm[i] = (u32x4){0u, 0u, 0u, 0u}; pxc[i] = pxm[i];
            if (more) { pxm[i] = *(const u32x4*)(XMg + (size_t)pos * 512 + cc * 8); pxc[i] = *(const u32x4*)(XCg + (size_t)pos * 512 + cc * 8); } }
        if (wave == 0 && more) { pg0 = *(const f32x4*)(GS + (size_t)(p0 + 64 + lanev) * 8); pg1 = *(const f32x2*)(GS + (size_t)(p0 + 64 + lanev) * 8 + 4); }
        {
            f32x4 aq[4], ak[4], av[4];
#pragma unroll
            for (int mt = 0; mt < 4; ++mt) { aq[mt] = (f32x4){0.f, 0.f, 0.f, 0.f}; ak[mt] = aq[mt]; av[mt] = aq[mt]; }
            bf16x8 xa0[4], xv0[4], xa1[4], xv1[4];
#define ML_LDX(XA, XV, MT) _Pragma("unroll") for (int ks = 0; ks < 4; ++ks) { XA[ks] = *(const LAS bf16x8*)(lds + ML_XC + xsw(16 * (MT) + r16, 4 * ks + q4)); XV[ks] = *(const LAS bf16x8*)(lds + ML_XM + xsw(16 * (MT) + r16, 4 * ks + q4)); }
#define ML_MMX(XA, XV, MT) _Pragma("unroll") for (int ks = 0; ks < 4; ++ks) { aq[MT] = MFMA16(bq[ks], XA[ks], aq[MT]); ak[MT] = MFMA16(XA[ks], bk[ks], ak[MT]); av[MT] = MFMA16(XV[ks], bv[ks], av[MT]); }
            ML_LDX(xa0, xv0, 0)
            ML_LDX(xa1, xv1, 1)
            __builtin_amdgcn_sched_barrier(0);
            ML_MMX(xa0, xv0, 0)
            ML_LDX(xa0, xv0, 2)
            __builtin_amdgcn_sched_barrier(0);
            ML_MMX(xa1, xv1, 1)
            ML_LDX(xa1, xv1, 3)
            __builtin_amdgcn_sched_barrier(0);
            ML_MMX(xa0, xv0, 2)
            __builtin_amdgcn_sched_barrier(0);
            ML_MMX(xa1, xv1, 3)
#undef ML_LDX
#undef ML_MMX
#pragma unroll
            for (int mt = 0; mt < 4; ++mt) {
                u32x2 w2; w2.x = pk2(aq[mt][0], aq[mt][1]); w2.y = pk2(aq[mt][2], aq[mt][3]);
                *(LAS u32x2*)(lds + ML_QS + sw128(16 * mt + r16, (16 * wave + 4 * q4) * 2)) = w2;
                const f32x4 ws4 = *(const LAS f32x4*)(scc + SC_WS + 16 * mt + 4 * q4);
                w2.x = pk2(ak[mt][0] * ws4[0], ak[mt][1] * ws4[1]); w2.y = pk2(ak[mt][2] * ws4[2], ak[mt][3] * ws4[3]);
                *(LAS u32x2*)(lds + ML_KT + sw64(16 * wave + r16, (16 * mt + 4 * q4) * 2)) = w2;
                {
                  float y0 = ak[mt][0], y1 = ak[mt][1], y2 = ak[mt][2], y3 = ak[mt][3]; const bool o1 = (r16 & 1) != 0, o2 = (r16 & 2) != 0;
#define ML_XCH(A, B, ODD, CTRL) { const float s_ = (ODD) ? A : B; const float r_ = __builtin_bit_cast(float, __builtin_amdgcn_mov_dpp(__builtin_bit_cast(int, s_), CTRL, 0xf, 0xf, true)); if (ODD) A = r_; else B = r_; }
                  ML_XCH(y0, y1, o1, 0xB1) ML_XCH(y2, y3, o1, 0xB1)
                  ML_XCH(y0, y2, o2, 0x4E) ML_XCH(y1, y3, o2, 0x4E)
#undef ML_XCH
                  u32x2 kw; kw.x = pk2(y0, y1); kw.y = pk2(y2, y3);
                  *(LAS u32x2*)(lds + ML_KS + (16 * mt + 4 * q4 + (r16 & 3)) * RPQ + (16 * wave + (r16 & ~3)) * 2) = kw; }
                w2.x = pk2(av[mt][0], av[mt][1]); w2.y = pk2(av[mt][2], av[mt][3]);
                *(LAS u32x2*)(lds + ML_VT + sw64(16 * wave + r16, (16 * mt + 4 * q4) * 2)) = w2;
            }
        }
        __syncthreads();
        f32x4 num[4];
        {
            bf16x8 cb[4], qa0[4], qa1[4], sa[4], sb[4];
            const int mt1 = wave >= 6 ? 3 : wave >= 3 ? 2 : wave >= 1 ? 1 : 0, nt1 = wave - (mt1 * (mt1 + 1)) / 2;
#define ML_LDQ(Q, MT) _Pragma("unroll") for (int ks = 0; ks < 4; ++ks) { const u32x2 lo_ = *(const LAS u32x2*)(lds + ML_QS + sw128(16 * (MT) + r16, (32 * ks + 4 * q4) * 2)), hi_ = *(const LAS u32x2*)(lds + ML_QS + sw128(16 * (MT) + r16, (32 * ks + 16 + 4 * q4) * 2)); \
        Q[ks] = __builtin_bit_cast(bf16x8, (u32x4){lo_.x, lo_.y, hi_.x, hi_.y}); }
#define ML_MMQ(Q, MT) _Pragma("unroll") for (int ks = 0; ks < 4; ++ks) num[MT] = MFMA16(cb[ks], Q[ks], num[MT]);
#define ML_LDS_(MT, NT) _Pragma("unroll") for (int ks = 0; ks < 4; ++ks) { sa[ks] = *(const LAS bf16x8*)(lds + ML_QS + sw128(16 * (MT) + r16, (32 * ks + 8 * q4) * 2)); sb[ks] = *(const LAS bf16x8*)(lds + ML_KS + (16 * (NT) + r16) * RPQ + (32 * ks + 8 * q4) * 2); }
#define ML_STILE(MT, NT, MU, R4) { f32x4 s = {0.f, 0.f, 0.f, 0.f}; \
                _Pragma("unroll") for (int ks = 0; ks < 4; ++ks) s = MFMA16(sb[ks], sa[ks], s);     \
                const int t = 16 * (MT) + r16; float p[4], psum = 0.f; \
                _Pragma("unroll") for (int reg = 0; reg < 4; ++reg) { const int sidx = 16 * (NT) + 4 * q4 + reg; const float w = (sidx <= t) ? fexp(fminf(R4[reg] - MU, 0.f)) : 0.f; p[reg] = s[reg] * w; psum += p[reg]; } \
                u32x2 w2; w2.x = pk2(p[0], p[1]); w2.y = pk2(p[2], p[3]); \
                *(LAS u32x2*)(lds + ML_P + sw64(t, (16 * (NT) + 4 * q4) * 2)) = w2; \
                psum += __shfl_xor(psum, 16); psum += __shfl_xor(psum, 32); \
                if (q4 == 0) atomicAdd((float*)(scc + SC_DEN + t), psum); }
#pragma unroll
            for (int ks = 0; ks < 4; ++ks) cb[ks] = __builtin_bit_cast(bf16x8, pg8::pack8(accC[2 * ks], accC[2 * ks + 1]));
            ML_LDQ(qa0, 0)
            ML_LDQ(qa1, 1)
            ML_LDS_(mt1, nt1)
            const float mu1 = scc[SC_MU + 16 * mt1 + r16]; const f32x4 r41 = *(const LAS f32x4*)(scc + SC_R + 16 * nt1 + 4 * q4);
#pragma unroll
            for (int mt = 0; mt < 4; ++mt) num[mt] = (f32x4){0.f, 0.f, 0.f, 0.f};
            __builtin_amdgcn_sched_barrier(0);
            ML_MMQ(qa0, 0)
            ML_LDQ(qa0, 2)
            __builtin_amdgcn_sched_barrier(0);
            ML_MMQ(qa1, 1)
            ML_LDQ(qa1, 3)
            __builtin_amdgcn_sched_barrier(0);
            ML_STILE(mt1, nt1, mu1, r41)
            ML_MMQ(qa0, 2)
            __builtin_amdgcn_sched_barrier(0);
            ML_MMQ(qa1, 3)
            if (wave < 2) {
                ML_LDS_(3, 2 + wave)
                const float mu2 = scc[SC_MU + 48 + r16]; const f32x4 r42 = *(const LAS f32x4*)(scc + SC_R + 16 * (2 + wave) + 4 * q4);
                ML_STILE(3, 2 + wave, mu2, r42)
            }
#undef ML_LDQ
#undef ML_MMQ
#undef ML_LDS_
#undef ML_STILE
            { const int t = tidv >> 3, part = tidv & 7; float s = 0.f;
              const u32x4 qa = *(const LAS u32x4*)(lds + ML_QS + sw128(t, part * 32)), qb = *(const LAS u32x4*)(lds + ML_QS + sw128(t, part * 32 + 16));
              const u32x4 na = *(const LAS u32x4*)((const LAS unsigned char*)(sc + SC_NB) + part * 32), nb = *(const LAS u32x4*)((const LAS unsigned char*)(sc + SC_NB) + part * 32 + 16);
              s = dot2bf(qa.x, na.x, s); s = dot2bf(qa.y, na.y, s); s = dot2bf(qa.z, na.z, s); s = dot2bf(qa.w, na.w, s);
              s = dot2bf(qb.x, nb.x, s); s = dot2bf(qb.y, nb.y, s); s = dot2bf(qb.z, nb.z, s); s = dot2bf(qb.w, nb.w, s);
              s += __shfl_xor(s, 1); s += __shfl_xor(s, 2); s += __shfl_xor(s, 4);
              if (part == 0) scc[SC_NQ + t] = s; }
        }
        __syncthreads();
        {
            bf16x8 vt[2], pf[4][2], kt0[4][2], kt1[4][2]; float wi[4], dn[4], nqv[4], me[4];
#pragma unroll
            for (int ks = 0; ks < 2; ++ks) vt[ks] = *(const LAS bf16x8*)(lds + ML_VT + sw64(16 * wave + r16, (32 * ks + 8 * q4) * 2));
#pragma unroll
            for (int mt = 0; mt < 4; ++mt) {
#pragma unroll
                for (int ks = 0; ks < 2; ++ks) pf[mt][ks] = *(const LAS bf16x8*)(lds + ML_P + sw64(16 * mt + r16, (32 * ks + 8 * q4) * 2));
                const int t = 16 * mt + r16; wi[mt] = scc[SC_WI + t]; dn[mt] = scc[SC_DEN + t]; nqv[mt] = scc[SC_NQ + t]; me[mt] = scc[SC_ME + t]; }
            const float decay = scc[SC_DEC];
#pragma unroll
            for (int nt = 0; nt < 4; ++nt)
#pragma unroll
                for (int ks = 0; ks < 2; ++ks) kt0[nt][ks] = *(const LAS bf16x8*)(lds + ML_KT + sw64(16 * nt + r16, (32 * ks + 8 * q4) * 2));
            __builtin_amdgcn_sched_barrier(0);
#pragma unroll
            for (int mt = 0; mt < 4; ++mt) {
                const int t = 16 * mt + r16;
                num[mt] = num[mt] * wi[mt];
#pragma unroll
                for (int ks = 0; ks < 2; ++ks) num[mt] = MFMA16(vt[ks], pf[mt][ks], num[mt]);
                const float den = dn[mt] + wi[mt] * nqv[mt], inv = frcp(fmaxf(fabsf(den), me[mt]));
                const int lp = p0 + t, pos = dir ? (SEQ - 1 - lp) : lp;
                u32x2 w2; w2.x = pk2(num[mt][0] * inv, num[mt][1] * inv); w2.y = pk2(num[mt][2] * inv, num[mt][3] * inv);
                *(u32x2*)(HO + (size_t)pos * 512 + 16 * wave + 4 * q4) = w2;
            }
#pragma unroll
            for (int nt = 0; nt < 4; ++nt)
#pragma unroll
                for (int ks = 0; ks < 2; ++ks) kt1[nt][ks] = *(const LAS bf16x8*)(lds + ML_KT + sw64(16 * (nt + 4) + r16, (32 * ks + 8 * q4) * 2));
            __builtin_amdgcn_sched_barrier(0);
#pragma unroll
            for (int nt = 0; nt < 4; ++nt) {
                accC[nt] = accC[nt] * decay;
#pragma unroll
                for (int ks = 0; ks < 2; ++ks) accC[nt] = MFMA16(kt0[nt][ks], vt[ks], accC[nt]);
            }
            __builtin_amdgcn_sched_barrier(0);
#pragma unroll
            for (int nt = 4; nt < 8; ++nt) {
                accC[nt] = accC[nt] * decay;
#pragma unroll
                for (int ks = 0; ks < 2; ++ks) accC[nt] = MFMA16(kt1[nt - 4][ks], vt[ks], accC[nt]);
            }
            if (tidv < 128) { float s = 0.f; const unsigned ones = 0x3f803f80u;
#pragma unroll
                for (int j = 0; j < 8; ++j) { const u32x4 kv = *(const LAS u32x4*)(lds + ML_KT + sw64(tidv, j * 16));
                    s = dot2bf(kv.x, ones, s); s = dot2bf(kv.y, ones, s); s = dot2bf(kv.z, ones, s); s = dot2bf(kv.w, ones, s); }
                const float nn = decay * sc[SC_N + tidv] + s; sc[SC_N + tidv] = nn;
                ((LAS bf16*)(sc + SC_NB))[tidv] = (bf16)(pk2(nn, 0.f) & 0xffffu); }
#pragma unroll
            for (int i = 0; i < 2; ++i) { const int idx = tidv + NTHREADS * i, lr = idx >> 4, cc = idx & 15;
                *(LAS u32x4*)(lds + ML_XM + xsw(lr, cc)) = pxm[i]; *(LAS u32x4*)(lds + ML_XC + xsw(lr, cc)) = pxc[i]; }
            if (wave == 0) { scn[SC_R + lanev] = pg0[0]; scn[SC_MU + lanev] = pg0[1]; scn[SC_WI + lanev] = pg0[2]; scn[SC_ME + lanev] = pg0[3]; scn[SC_WS + lanev] = pg1[0]; scn[SC_DEN + lanev] = 0.f;
                if (lanev == 0) scn[SC_DEC] = pg1[1]; }
        }
        __syncthreads();
    }
}

__device__ __forceinline__ void ml_combine(const Args& a, unsigned char* ws, int gw, int NGW, int lane) {
    const bf16* HF = (const bf16*)(ws + WS_HF); const bf16* HB = (const bf16*)(ws + WS_HB); const bf16* XCg = (const bf16*)(ws + WS_XC); const bf16* OP = (const bf16*)(ws + WS_OP);
    bf16* YC = (bf16*)(ws + WS_YCAT);
    const int col = 8 * lane;
    float hn[8], sk[8];
#pragma unroll
    for (int e = 0; e < 8; ++e) { hn[e] = a.in[I_HNORM][col + e]; sk[e] = a.in[I_SKIP][col + e]; }
    for (int grp = gw; grp < MTOK / 4; grp += NGW) {
        u32x4 hf[4], hb[4], ov[4], xc[4];
#pragma unroll
        for (int r = 0; r < 4; ++r) { const size_t o = (size_t)(grp * 4 + r) * 512 + col; hf[r] = *(const u32x4*)(HF + o); hb[r] = *(const u32x4*)(HB + o); ov[r] = *(const u32x4*)(OP + o); xc[r] = *(const u32x4*)(XCg + o); }
#pragma unroll
        for (int r = 0; r < 4; ++r) {
            float hv[8] = {bflo(hf[r].x) + bflo(hb[r].x), bfhi(hf[r].x) + bfhi(hb[r].x), bflo(hf[r].y) + bflo(hb[r].y), bfhi(hf[r].y) + bfhi(hb[r].y), bflo(hf[r].z) + bflo(hb[r].z), bfhi(hf[r].z) + bfhi(hb[r].z), bflo(hf[r].w) + bflo(hb[r].w), bfhi(hf[r].w) + bfhi(hb[r].w)};
            float sm = 0.f;
#pragma unroll
            for (int e = 0; e < 8; ++e) sm += hv[e];
            sm += __shfl_xor(sm, 1); sm += __shfl_xor(sm, 2); sm += __shfl_xor(sm, 4); sm += __shfl_xor(sm, 8);
            const float mean = sm * (1.f / DH); float vs = 0.f;
#pragma unroll
            for (int e = 0; e < 8; ++e) { hv[e] -= mean; vs += hv[e] * hv[e]; }
            vs += __shfl_xor(vs, 1); vs += __shfl_xor(vs, 2); vs += __shfl_xor(vs, 4); vs += __shfl_xor(vs, 8);
            const float rstd = __builtin_amdgcn_rsqf(vs * (1.f / DH) + EPS);
            const float og[8] = {bflo(ov[r].x), bfhi(ov[r].x), bflo(ov[r].y), bfhi(ov[r].y), bflo(ov[r].z), bfhi(ov[r].z), bflo(ov[r].w), bfhi(ov[r].w)};
            const float xg[8] = {bflo(xc[r].x), bfhi(xc[r].x), bflo(xc[r].y), bfhi(xc[r].y), bflo(xc[r].z), bfhi(xc[r].z), bflo(xc[r].w), bfhi(xc[r].w)};
            float o[8];
#pragma unroll
            for (int e = 0; e < 8; ++e) o[e] = sigmoidf_(og[e]) * (hv[e] * rstd * hn[e] + sk[e] * xg[e]);
            u32x4 w; w.x = pk2(o[0], o[1]); w.y = pk2(o[2], o[3]); w.z = pk2(o[4], o[5]); w.w = pk2(o[6], o[7]);
            *(u32x4*)(YC + (size_t)(grp * 4 + r) * 1024 + 512 + col) = w;
        }
    }
}

__global__ void __launch_bounds__(NTHREADS, 2) hyb_fwd(Args args) {
    extern __shared__ __attribute__((aligned(16))) unsigned char lds_raw[];
    LAS unsigned char* lds = (LAS unsigned char*)lds_raw;
    volatile LAS unsigned* MISC = (volatile LAS unsigned*)(lds + MISC_OFF);
    const int tid = threadIdx.x, lane = tid & 63, wave = __builtin_amdgcn_readfirstlane(tid >> 6);
    const int G = gridDim.x, bx = blockIdx.x, vcu = (G % 8 == 0) ? (bx % 8) * (G / 8) + bx / 8 : bx;
    const int gw = vcu * NWAVES + wave, NGW = G * NWAVES;
    unsigned char* ws = args.ws;
    for (int u = tid; u < (LDS_BYTES - MISC_OFF) / 4; u += NTHREADS) ((LAS unsigned*)(lds + MISC_OFF))[u] = 0u;
    __syncthreads();
    const int lo = args.ph_lo, hi = args.ph_hi;
    const bool one = (hi - lo) > 1;
    XcdBarrier bar; bar.bar = (unsigned*)(ws + WS_CTL) + CW_BAR; bar.x = 0; bar.st = nullptr;
    if (one) bar = xcd_barrier_post((unsigned*)(ws + WS_CTL) + CW_BAR, MISC + 8);
#define IN(k) (lo <= (k) && (k) < hi)
#define SEAM(k) do { if (one) xcd_barrier(bar); } while (0)

    if (IN(0)) { p0_prologue(args, ws, lds, tid, wave, lane, vcu, G); SEAM(0); }
    if (IN(1)) {
        pg8::Gemm g{(const bf16*)(ws + WS_XB), (const bf16*)(ws + WS_WIN), DM, DM, DM}; pg8::StaticOrder S; S.init(MTOK, NPROJ, G, bx);
        pg8::EpiP1 E{(const float*)(ws + WS_RS1), (bf16*)(ws + WS_UX), (bf16*)(ws + WS_XM), (bf16*)(ws + WS_OP)};
        pg8::gemm_phase<pg8::EpiP1, pg8::StaticOrder, true>(lds, g, S, E);
        SEAM(1);
    }
    if (IN(2)) {
        if (G == 256) {
            { pg8::Gemm g{(const bf16*)(ws + WS_UX), (const bf16*)(ws + WS_MZ), 512, 256, 256}; pg8::S5One S{bx}; pg8::EpiZL E{};
              pg8::gemm_phase<pg8::EpiZL, pg8::S5One, true, true>(lds, g, S, E); }
            __syncthreads();
            s5_scan_lds(args, ws, lds, bx, tid);
            __syncthreads();
            { pg8::Gemm g{(const bf16*)(ws + WS_UX), (const bf16*)(ws + WS_MZ), 512, 256, 256}; pg8::S5One S{G + bx}; pg8::EpiZL E{};
              pg8::gemm_phase<pg8::EpiZL, pg8::S5One, true, true>(lds, g, S, E); }
            __syncthreads();
            s5_scan_lds(args, ws, lds, G + bx, tid);
            VM_WAIT(); __syncthreads();
        } else {
            { pg8::Gemm g{(const bf16*)(ws + WS_UX), (const bf16*)(ws + WS_MZ), 512, 256, 256}; pg8::S5Order S{G, bx}; pg8::EpiZ E{(bf16*)(ws + WS_ZB)};
              pg8::gemm_phase<pg8::EpiZ, pg8::S5Order, true>(lds, g, S, E); }
            VM_WAIT(); __syncthreads();
            s5_scan(args, ws, tid, G);
            VM_WAIT(); __syncthreads();
        }
        { pg8::Gemm g{(const bf16*)(ws + WS_UX), (const bf16*)(ws + WS_TMY), 512, 512, 512}; pg8::S5Order S{G, bx}; pg8::EpiY E{(bf16*)(ws + WS_YACT)};
          pg8::gemm_phase<pg8::EpiY, pg8::S5Order, true>(lds, g, S, E); }
        ml_pre(args, ws, lds, gw, NGW, wave, lane, G);
        SEAM(2);
    }
    if (IN(3)) {
        { pg8::Gemm g{(const bf16*)(ws + WS_YACT), (const bf16*)(ws + WS_WGLU), 512, 512, 512}; pg8::StaticOrder S; S.init(MTOK, 512, G, bx);
          pg8::EpiGLU E{(const bf16*)(ws + WS_YACT), args.in[I_BGLU], (bf16*)(ws + WS_YCAT)};
          pg8::gemm_phase<pg8::EpiGLU, pg8::StaticOrder, true>(lds, g, S, E); }
        __syncthreads();
        for (int cid = bx; cid < BATCH * NH * 2; cid += G) mlstm_chain(args, ws, lds, cid, tid, wave, lane);
        SEAM(3);
    }
    if (IN(4)) { ml_combine(args, ws, gw, NGW, lane); SEAM(4); }
    if (IN(5)) { }
    unsigned* const ctlw = (unsigned*)(ws + WS_CTL);
    if (IN(6)) {
        pg8::Gemm g{(const bf16*)(ws + WS_YCAT), (const bf16*)(ws + WS_WOUT), DM, DM, DM}; pg8::StaticOrder S; S.init(MTOK, DM, G, bx);
        pg8::PanelSS s1{(unsigned long long*)(ws + WS_XS), ctlw + CW_TMO};
        pg8::EpiMid E{(bf16*)(ws + WS_XB), args.in[I_NMPOST], (float*)(ws + WS_RS2), s1};
        pg8::gemm_phase<pg8::EpiMid, pg8::StaticOrder, true>(lds, g, S, E);
        SEAM(6);
    }
    if (IN(8)) {
        { pg8::Gemm g{(const bf16*)(ws + WS_XB), (const bf16*)(ws + WS_WGU), DM, DM, DM}; pg8::PassOrder S; S.init(MTOK, G, bx);
          pg8::EpiGU E{(const float*)(ws + WS_RS2), (bf16*)(ws + WS_ACT), 0};
          pg8::gemm_phase<pg8::EpiGU, pg8::PassOrder, true>(lds, g, S, E); }
        SEAM(8);
    }
    if (IN(9)) {
        pg8::Gemm g{(const bf16*)(ws + WS_ACT), (const bf16*)(ws + WS_WDN), DFF, DFF, DFF}; pg8::StaticOrder S; S.init(MTOK, DM, G, bx);
        pg8::PanelSS s3{(unsigned long long*)(ws + WS_XS) + (size_t)MTOK * 8, ctlw + CW_TMO};
        pg8::EpiOut E{(const bf16*)(ws + WS_XB), args.in[I_NFPOST], args.out, s3};
        pg8::gemm_phase<pg8::EpiOut, pg8::StaticOrder, true>(lds, g, S, E);
    }
#undef IN
#undef SEAM
}

extern "C" void kernel_launch(void* const* d_in, const int* in_sizes, int n_in, void* d_out, int out_size, void* d_ws, size_t ws_size, hipStream_t stream) {
    static int grid = 0;
    if (grid == 0) {
        if (n_in != 28 || in_sizes[0] != MTOK * DM || out_size != MTOK * DM || ws_size < WS_END) { fprintf(stderr, "kernel_launch: unexpected shapes (n_in %d, in0 %d, out %d, ws %zu); nothing launched\n", n_in, n_in > 0 ? in_sizes[0] : -1, out_size, ws_size); grid = -1; return; }
        int dev = 0, cus = 0;
        if (hipGetDevice(&dev) != hipSuccess || hipDeviceGetAttribute(&cus, hipDeviceAttributeMultiprocessorCount, dev) != hipSuccess) { grid = -1; return; }
        if (hipFuncSetAttribute((const void*)hyb_fwd, hipFuncAttributeMaxDynamicSharedMemorySize, LDS_BYTES) != hipSuccess) { fprintf(stderr, "kernel_launch: hipFuncSetAttribute failed\n"); grid = -1; return; }
        int per_cu = 0;
        if (hipOccupancyMaxActiveBlocksPerMultiprocessor(&per_cu, (const void*)hyb_fwd, NTHREADS, LDS_BYTES) != hipSuccess || per_cu < 1) fprintf(stderr, "kernel_launch: occupancy query reports %d\n", per_cu);
        (void)hipGetLastError();
        if (cus < 256) { fprintf(stderr, "kernel_launch: built for a 256-CU device (got %d CUs); nothing launched\n", cus); grid = -1; return; }
        grid = 256;
    }
    if (grid < 0) return;
    (void)hipMemsetAsync((char*)d_ws + WS_CTL, 0, CTL_ZERO_BYTES, stream);
    Args a{};
    for (int i = 0; i < 28; ++i) a.in[i] = (const float*)d_in[i];
    a.out = (float*)d_out; a.ws = (unsigned char*)d_ws; a.pad0 = 0; a.pad1 = 0;
    a.ph_lo = 0; a.ph_hi = N_PHASES;
    hipLaunchKernelGGL(hyb_fwd, dim3(grid), dim3(NTHREADS), LDS_BYTES, stream, a);
}
```

```cpp
#include <hip/hip_runtime.h>
#include <cstdio>
#include <cstdint>


#define GAS __attribute__((address_space(1)))
#define LAS __attribute__((address_space(3)))
typedef unsigned short bf16;
typedef short bf16x8 __attribute__((ext_vector_type(8)));
typedef float f32x4 __attribute__((ext_vector_type(4)));
typedef float f32x2 __attribute__((ext_vector_type(2)));
typedef unsigned u32x4 __attribute__((ext_vector_type(4)));
typedef unsigned u32x2 __attribute__((ext_vector_type(2)));
typedef __bf16 bf16x2_t __attribute__((ext_vector_type(2)));
typedef GAS unsigned gu32;

constexpr int BATCH = 32, SEQ = 2048, DM = 1024, MTOK = BATCH * SEQ;
constexpr int D_S5 = 512, D_ML = 512, NG = 32, GC = 16, SP = 64, NH = 4, DH = 128, D_IN = 1552, DFF = 2816, NPROJ = 1536;
constexpr int S5L = 16, S5NCH = SEQ / S5L, S5ROWS = BATCH * S5NCH;
constexpr float EPS = 1e-6f;
constexpr int NWAVES = 8, NTHREADS = 512;
constexpr int N_PHASES = 11;

constexpr size_t MiB = 1u << 20;
constexpr size_t WS_CTL = 0, CTL_ZERO_BYTES = 1 * MiB;
constexpr size_t WS_WIN = 1 * MiB;
constexpr size_t WS_WGLU = 4 * MiB;
constexpr size_t WS_WQKV = 5 * MiB;
constexpr size_t WS_WOUT = 6 * MiB;
constexpr size_t WS_WGU = 8 * MiB;
constexpr size_t WS_WDN = 19 * MiB;
constexpr size_t WS_MZ = 25 * MiB;
constexpr size_t WS_TMY = 29 * MiB;
constexpr size_t WS_RS1 = 37 * MiB;
constexpr size_t WS_RS2 = 48 * MiB;
constexpr size_t WS_GATES = 38 * MiB;
constexpr size_t WS_XS = 42 * MiB;
constexpr size_t WS_XB = 64 * MiB;
constexpr size_t WS_UX = 192 * MiB;
constexpr size_t WS_XM = 320 * MiB;
constexpr size_t WS_OP = 384 * MiB;
constexpr size_t WS_ZB = 448 * MiB;
constexpr size_t WS_YACT = 512 * MiB;
constexpr size_t WS_HF = 576 * MiB;
constexpr size_t WS_HB = 640 * MiB;
constexpr size_t WS_YCAT = 704 * MiB;
constexpr size_t WS_ACT = 192 * MiB;
constexpr size_t WS_XC = 832 * MiB;
constexpr size_t WS_GS = 896 * MiB;
constexpr size_t WS_END = 960 * MiB;
constexpr int CW_TMO = 0, CW_BAR = 4096;
constexpr int CW_PANEL = 16384, PANEL_BANK = 256 * 64;

constexpr int MISC_OFF = 162816;
constexpr int LDS_BYTES = 163840;

__device__ __forceinline__ unsigned pk2(float lo, float hi) { f32x2 v = {lo, hi}; bf16x2_t b = __builtin_convertvector(v, bf16x2_t); return __builtin_bit_cast(unsigned, b); }
__device__ __forceinline__ float bflo(unsigned u) { return __builtin_bit_cast(float, u << 16); }
__device__ __forceinline__ float bfhi(unsigned u) { return __builtin_bit_cast(float, u & 0xffff0000u); }
__device__ __forceinline__ float bf2f(bf16 h) { return __builtin_bit_cast(float, (unsigned)h << 16); }
__device__ __forceinline__ float fexp(float x) { return __expf(x); }
__device__ __forceinline__ float frcp(float x) { return __builtin_amdgcn_rcpf(x); }
__device__ __forceinline__ float sigmoidf_(float z) { return frcp(1.f + fexp(-z)); }
__device__ __forceinline__ float siluf_(float z) { return z * frcp(1.f + fexp(-z)); }
__device__ __forceinline__ float gelu_tanh(float y) { const float t = 1.5957691216057308f * (y + 0.044715f * y * y * y); return y * frcp(1.f + fexp(-t)); }
__device__ __forceinline__ float wave_sum(float v) {
#pragma unroll
    for (int o = 1; o < 64; o <<= 1) v += __shfl_xor(v, o);
    return v;
}
#define LDS_WAIT() asm volatile("s_waitcnt lgkmcnt(0)" ::: "memory")
#define VM_WAIT() asm volatile("s_waitcnt vmcnt(0)" ::: "memory")

namespace pg8 {
constexpr int BM = 256, BK = 64, HALF = 128, HTB = HALF * BK * 2, STAGE_BYTES = 8 * HTB, NXCD = 8, WGM = 4;
__host__ __device__ __forceinline__ int lds_byte(int r, int c) { const int st = (r >> 4) * 2 + (c >> 5), rr = r & 15, cc = c & 31, ob = rr * 64 + cc * 2; return st * 1024 + (ob ^ (((ob >> 9) & 1) << 5)); }
__host__ __device__ __forceinline__ void stage_rc(int b, int& R, int& C) { const int st = b / 1024, sb = b % 1024, swz = sb ^ (((sb >> 9) & 1) << 5); R = (st >> 1) * 16 + swz / 64; C = (st & 1) * 32 + (swz % 64) / 2; }
__host__ __device__ __forceinline__ int perm32(int rho) { const int n = rho >> 4, i = rho & 15; return 8 * (i >> 2) + 4 * n + (i & 3); }

struct Unit { int pm, pn; };
struct Gemm { const bf16* A; const bf16* Bt; int lda, ldb, K; };

struct StaticOrder {
    int nig, nwg, G, qq, rr; int gid, rem, L;
    __device__ void init(int M, int N, int G_, int c_) {
        const int nN = N / BM; nwg = (M / BM) * nN; G = G_; nig = WGM * nN;
        const int w0 = (c_ % NXCD) * (nwg / NXCD) + c_ / NXCD, st = G_ / NXCD; gid = w0 / nig; rem = w0 % nig; qq = st / nig; rr = st % nig; L = c_; }
    __device__ __forceinline__ bool next(int, Unit& u) {
        if (L >= nwg) return false;
        u.pm = gid * WGM + (rem & (WGM - 1)); u.pn = rem / WGM; L += G; gid += qq; rem += rr; if (rem >= nig) { rem -= nig; ++gid; } return true; }
    __device__ __forceinline__ void a_ready(const Unit&) const {}
    __device__ __forceinline__ void done(const Unit&) const {}
};
struct PassOrder {
    StaticOrder so; int M, G, c, p, pn0;
    __device__ static __forceinline__ int nn(int p) { return p < 2 ? 6 : 5; }
    __device__ void init(int M_, int G_, int c_) { M = M_; G = G_; c = c_; p = 0; pn0 = 0; so.init(M, nn(0) * BM, G, c); }
    __device__ __forceinline__ bool next(int i, Unit& u) {
        if (!so.next(i, u)) { if (p == 3) return false; pn0 += nn(p); ++p; so.init(M, nn(p) * BM, G, c); (void)so.next(0, u); }
        u.pn += pn0; return true; }
    __device__ __forceinline__ void a_ready(const Unit&) const {}
    __device__ __forceinline__ void done(const Unit&) const {}
};
struct S5Order {
    int G, c;
    __device__ __forceinline__ bool next(int i, Unit& u) const { const int L = i * G + c; if (L >= NG * 16) return false; u.pm = L; u.pn = L >> 4; return true; }
    __device__ __forceinline__ void a_ready(const Unit&) const {}
    __device__ __forceinline__ void done(const Unit&) const {}
};

__device__ __forceinline__ u32x4 pack8(f32x4 v0, f32x4 v1) { u32x4 w; w.x = pk2(v0[0], v0[1]); w.y = pk2(v0[2], v0[3]); w.z = pk2(v1[0], v1[1]); w.w = pk2(v1[2], v1[3]); return w; }

struct EpiP1 {
    static constexpr bool PEEL = true, PERM = true, AFTER_DRAIN = false; static constexpr int NS = 16;
    const float* rs1; bf16* UX; bf16* XM; bf16* OP;
    __device__ __forceinline__ void pre(const Unit& u, LAS unsigned char* xlds, int tid) const {
        if (tid < 64) __builtin_amdgcn_global_load_lds((const unsigned*)(rs1 + (size_t)u.pm * BM + tid * 4), (LAS unsigned*)xlds, 16, 0, 0); }
    __device__ __forceinline__ void operator()(const f32x4 (&acc)[2][2][4][2], const Unit& u, int wr, int wc, int fr, int fq, const LAS unsigned char* xlds) const {
#pragma unroll
        for (int ai = 0; ai < 2; ++ai)
#pragma unroll
            for (int m = 0; m < 4; ++m) {
                const int row = u.pm * BM + ai * HALF + wr * 64 + m * 16 + fr; const float s = ((const LAS float*)xlds)[ai * HALF + wr * 64 + m * 16 + fr];
#pragma unroll
                for (int bj = 0; bj < 2; ++bj) {
                    const int col = u.pn * BM + bj * HALF + wc * 32 + 8 * fq;
                    const u32x4 w = pack8(acc[ai][bj][m][0] * s, acc[ai][bj][m][1] * s);
                    bf16* dst;
                    if (u.pn < 2) { const int g = col >> 4, c0 = col & 15, b = row >> 11, si = row & 2047, k = si >> 4, t = si & 15;
                        dst = UX + ((size_t)(g * S5ROWS + b * S5NCH + k) * 512 + t * 16 + c0); }
                    else if (u.pn < 4) dst = XM + (size_t)row * 512 + (col - 512);
                    else dst = OP + (size_t)row * 512 + (col - 1024);
                    *(u32x4*)dst = w;
                }
            }
    }
};
struct EpiZ {
    __device__ __forceinline__ void pre(const Unit&, LAS unsigned char*, int) const {}
    static constexpr bool PEEL = false, PERM = true, AFTER_DRAIN = false; static constexpr int NS = 16;
    bf16* Z;
    __device__ __forceinline__ void operator()(const f32x4 (&acc)[2][2][4][2], const Unit& u, int wr, int wc, int fr, int fq, const LAS unsigned char* xlds) const {
#pragma unroll
        for (int ai = 0; ai < 2; ++ai)
#pragma unroll
            for (int m = 0; m < 4; ++m) {
                const size_t row = (size_t)u.pm * BM + ai * HALF + wr * 64 + m * 16 + fr;
#pragma unroll
                for (int bj = 0; bj < 2; ++bj) { const int col = bj * HALF + wc * 32 + 8 * fq; *(u32x4*)(Z + row * 256 + col) = pack8(acc[ai][bj][m][0], acc[ai][bj][m][1]); }
            }
    }
};
constexpr int ZLP = 528;
struct EpiZL {
    __device__ __forceinline__ void pre(const Unit&, LAS unsigned char*, int) const {}
    static constexpr bool PEEL = false, PERM = true, AFTER_DRAIN = false; static constexpr int NS = 0;
    __device__ __forceinline__ void operator()(const f32x4 (&acc)[2][2][4][2], const Unit& u, int wr, int wc, int fr, int fq, const LAS unsigned char* xlds) const {
        LAS unsigned char* zl = const_cast<LAS unsigned char*>(xlds) - STAGE_BYTES;
#pragma unroll
        for (int ai = 0; ai < 2; ++ai)
#pragma unroll
            for (int m = 0; m < 4; ++m) { const int row = ai * HALF + wr * 64 + m * 16 + fr;
#pragma unroll
                for (int bj = 0; bj < 2; ++bj) { const int col = bj * HALF + wc * 32 + 8 * fq; *(LAS u32x4*)(zl + row * ZLP + col * 2) = pack8(acc[ai][bj][m][0], acc[ai][bj][m][1]); } }
    }
};
struct S5One {
    int L;
    __device__ __forceinline__ bool next(int i, Unit& u) const { if (i != 0) return false; u.pm = L; u.pn = L >> 4; return true; }
    __device__ __forceinline__ void a_ready(const Unit&) const {}
    __device__ __forceinline__ void done(const Unit&) const {}
};
struct EpiY {
    __device__ __forceinline__ void pre(const Unit&, LAS unsigned char*, int) const {}
    static constexpr bool PEEL = true, PERM = true, AFTER_DRAIN = false; static constexpr int NS = 16;
    bf16* YACT;
    __device__ __forceinline__ void operator()(const f32x4 (&acc)[2][2][4][2], const Unit& u, int wr, int wc, int fr, int fq, const LAS unsigned char* xlds) const {
        const int g = u.pm >> 4;
#pragma unroll
        for (int ai = 0; ai < 2; ++ai)
#pragma unroll
            for (int m = 0; m < 4; ++m) {
                const int R = u.pm * BM + ai * HALF + wr * 64 + m * 16 + fr, rr = R & (S5ROWS - 1), b = rr >> 7, k = rr & 127;
#pragma unroll
                for (int bj = 0; bj < 2; ++bj) { const int colt = bj * HALF + wc * 32 + 8 * fq, t = colt >> 4, c0 = colt & 15;
                    const size_t token = (size_t)b * SEQ + k * S5L + t;
                    f32x4 v0 = acc[ai][bj][m][0], v1 = acc[ai][bj][m][1];
#pragma unroll
                    for (int e = 0; e < 4; ++e) { v0[e] = gelu_tanh(v0[e]); v1[e] = gelu_tanh(v1[e]); }
                    *(u32x4*)(YACT + token * 512 + g * 16 + c0) = pack8(v0, v1); }
            }
    }
};
struct EpiGLU {
    __device__ __forceinline__ void pre(const Unit&, LAS unsigned char*, int) const {}
    static constexpr bool PEEL = true, PERM = true, AFTER_DRAIN = false; static constexpr int NS = 16;
    const bf16* YACT; const float* bglu; bf16* YCAT;
    __device__ __forceinline__ void operator()(const f32x4 (&acc)[2][2][4][2], const Unit& u, int wr, int wc, int fr, int fq, const LAS unsigned char* xlds) const {
        u32x4 ya[2][2][4]; f32x4 bb[2][2];
        const size_t row0 = (size_t)u.pm * BM + wr * 64 + fr; const int col0 = u.pn * BM + wc * 32 + 8 * fq;
#pragma unroll
        for (int bj = 0; bj < 2; ++bj) { bb[bj][0] = *(const f32x4*)(bglu + col0 + bj * HALF); bb[bj][1] = *(const f32x4*)(bglu + col0 + bj * HALF + 4);
#pragma unroll
            for (int ai = 0; ai < 2; ++ai)
#pragma unroll
                for (int m = 0; m < 4; ++m) ya[bj][ai][m] = *(const u32x4*)(YACT + (row0 + ai * HALF + m * 16) * 512 + col0 + bj * HALF); }
#pragma unroll
        for (int bj = 0; bj < 2; ++bj)
#pragma unroll
            for (int ai = 0; ai < 2; ++ai)
#pragma unroll
                for (int m = 0; m < 4; ++m) {
                    const u32x4 y = ya[bj][ai][m];
                    const f32x4 z0 = acc[ai][bj][m][0] + bb[bj][0], z1 = acc[ai][bj][m][1] + bb[bj][1]; f32x4 o0, o1;
                    o0[0] = bflo(y.x) * sigmoidf_(z0[0]); o0[1] = bfhi(y.x) * sigmoidf_(z0[1]); o0[2] = bflo(y.y) * sigmoidf_(z0[2]); o0[3] = bfhi(y.y) * sigmoidf_(z0[3]);
                    o1[0] = bflo(y.z) * sigmoidf_(z1[0]); o1[1] = bfhi(y.z) * sigmoidf_(z1[1]); o1[2] = bflo(y.w) * sigmoidf_(z1[2]); o1[3] = bfhi(y.w) * sigmoidf_(z1[3]);
                    *(u32x4*)(YCAT + (row0 + ai * HALF + m * 16) * 1024 + col0 + bj * HALF) = pack8(o0, o1);
                }
    }
};
struct EpiPlain {
    __device__ __forceinline__ void pre(const Unit&, LAS unsigned char*, int) const {}
    static constexpr bool PEEL = false, PERM = true, AFTER_DRAIN = false; static constexpr int NS = 16;
    bf16* O; int ldc;
    __device__ __forceinline__ void operator()(const f32x4 (&acc)[2][2][4][2], const Unit& u, int wr, int wc, int fr, int fq, const LAS unsigned char* xlds) const {
#pragma unroll
        for (int ai = 0; ai < 2; ++ai)
#pragma unroll
            for (int m = 0; m < 4; ++m) {
                const size_t row = (size_t)u.pm * BM + ai * HALF + wr * 64 + m * 16 + fr;
#pragma unroll
                for (int bj = 0; bj < 2; ++bj) { const int col = u.pn * BM + bj * HALF + wc * 32 + 8 * fq; *(u32x4*)(O + row * ldc + col) = pack8(acc[ai][bj][m][0], acc[ai][bj][m][1]); }
            }
    }
};
struct EpiNull {
    __device__ __forceinline__ void pre(const Unit&, LAS unsigned char*, int) const {}
    static constexpr bool PEEL = false, PERM = true, AFTER_DRAIN = false; static constexpr int NS = 0;
    __device__ __forceinline__ void operator()(const f32x4 (&acc)[2][2][4][2], const Unit& u, int wr, int wc, int fr, int fq, const LAS unsigned char* xlds) const {
#pragma unroll
        for (int ai = 0; ai < 2; ++ai)
#pragma unroll
            for (int bj = 0; bj < 2; ++bj)
#pragma unroll
                for (int m = 0; m < 4; ++m)
#pragma unroll
                    for (int n = 0; n < 2; ++n) asm volatile("" :: "v"(acc[ai][bj][m][n]));
    }
};
struct PanelSS {
    unsigned long long* slots;
    unsigned* tmo;
    template <class F> __device__ __forceinline__ bool run(const f32x4 (&v)[2][2][4][2], const Unit& u, int wr, int wc, int fr, int fq, LAS unsigned char* xl, F mid) const {
        LAS float* P = (LAS float*)(xl + 4096); LAS float* S = (LAS float*)(xl + 8192);
        const int wid = wr * 4 + wc, lane = fq * 16 + fr;
#pragma unroll
        for (int ai = 0; ai < 2; ++ai)
#pragma unroll
            for (int m = 0; m < 4; ++m) {
                float q = 0.f;
#pragma unroll
                for (int bj = 0; bj < 2; ++bj)
#pragma unroll
                    for (int n = 0; n < 2; ++n) { const f32x4 x = v[ai][bj][m][n]; q += (x[0] * x[0] + x[1] * x[1]) + (x[2] * x[2] + x[3] * x[3]); }
                q += __shfl_xor(q, 16); q += __shfl_xor(q, 32);
                P[(ai * HALF + wr * 64 + m * 16 + fr) * 4 + wc] = q;
            }
        asm volatile("s_waitcnt lgkmcnt(0)" ::: "memory"); __builtin_amdgcn_s_barrier(); asm volatile("" ::: "memory");
        const int row = wid * 32 + (lane & 31);
        unsigned long long* sl = slots + (size_t)u.pm * BM + row;
        if (lane < 32) {
            const f32x4 p = *(const LAS f32x4*)(P + row * 4);
            __hip_atomic_store(sl + (size_t)u.pn * MTOK, (1ull << 32) | (unsigned long long)__builtin_bit_cast(unsigned, (p[0] + p[1]) + (p[2] + p[3])), __ATOMIC_RELAXED, __HIP_MEMORY_SCOPE_AGENT);
        }
        mid();
        float tot = 0.f; bool ok = true; unsigned spins = 0u;
        for (;;) {
            ok = true; tot = 0.f;
            if (lane < 32) {
#pragma unroll
                for (int t = 0; t < 4; ++t) { const unsigned long long x = __hip_atomic_load(sl + (size_t)t * MTOK, __ATOMIC_RELAXED, __HIP_MEMORY_SCOPE_AGENT); ok = ok && ((unsigned)(x >> 32) == 1u); tot += __builtin_bit_cast(float, (unsigned)x); }
            }
            if (__all(ok)) break;
            if (++spins > (1u << 15)) { if (lane == 0) __hip_atomic_store(tmo, 1u, __ATOMIC_RELAXED, __HIP_MEMORY_SCOPE_AGENT); break; }
            __builtin_amdgcn_s_sleep(1);
        }
        const bool good = __all(ok);
        if (lane < 32) S[row] = good ? __builtin_amdgcn_rsqf(tot * (1.f / 1024.f) + EPS) : __builtin_nanf("");
        asm volatile("s_waitcnt lgkmcnt(0)" ::: "memory"); __builtin_amdgcn_s_barrier(); asm volatile("" ::: "memory");
        return false;
    }
};
struct EpiMid {
    __device__ __forceinline__ void pre(const Unit&, LAS unsigned char*, int) const {}
    static constexpr bool PEEL = false, PERM = true, AFTER_DRAIN = false; static constexpr int NS = 0;
    bf16* XB; const float* gpost; float* RS2P; PanelSS st1;
    __device__ __forceinline__ void operator()(const f32x4 (&acc_)[2][2][4][2], const Unit& u, int wr, int wc, int fr, int fq, const LAS unsigned char* xlds) const {
        f32x4 (&acc)[2][2][4][2] = const_cast<f32x4 (&)[2][2][4][2]>(acc_);
        LAS unsigned char* xl = const_cast<LAS unsigned char*>(xlds);
        LAS float* P = (LAS float*)(xl + 4096); const LAS float* S = (const LAS float*)(xl + 8192);
        const bf16* xb0 = XB + (size_t)(u.pm * BM + wr * 64 + fr) * DM + u.pn * BM + wc * 32 + 8 * fq;
        u32x4 r0[4][2];
#pragma unroll
        for (int m = 0; m < 4; ++m)
#pragma unroll
            for (int bj = 0; bj < 2; ++bj) r0[m][bj] = *(const u32x4*)(xb0 + (size_t)(m * 16) * DM + bj * HALF);
        f32x4 g[2][2];
#pragma unroll
        for (int bj = 0; bj < 2; ++bj) { const int col = u.pn * BM + bj * HALF + wc * 32 + 8 * fq; g[bj][0] = *(const f32x4*)(gpost + col); g[bj][1] = *(const f32x4*)(gpost + col + 4); }
        u32x4 r1[4][2];
        (void)st1.run(acc, u, wr, wc, fr, fq, xl, [&]() {
#pragma unroll
            for (int m = 0; m < 4; ++m)
#pragma unroll
                for (int bj = 0; bj < 2; ++bj) r1[m][bj] = *(const u32x4*)(xb0 + (size_t)(HALF + m * 16) * DM + bj * HALF); });
#pragma unroll
        for (int ai = 0; ai < 2; ++ai)
#pragma unroll
            for (int m = 0; m < 4; ++m) { const int r = ai * HALF + wr * 64 + m * 16 + fr; const float rsy = S[r]; const size_t row = (size_t)u.pm * BM + r; float q = 0.f;
#pragma unroll
                for (int bj = 0; bj < 2; ++bj) { const int col = u.pn * BM + bj * HALF + wc * 32 + 8 * fq;
                    const u32x4 xv = ai == 0 ? r0[m][bj] : r1[m][bj];
                    const f32x4 a0 = acc[ai][bj][m][0], a1 = acc[ai][bj][m][1]; f32x4 o0, o1;
                    o0[0] = bflo(xv.x) + g[bj][0][0] * a0[0] * rsy; o0[1] = bfhi(xv.x) + g[bj][0][1] * a0[1] * rsy; o0[2] = bflo(xv.y) + g[bj][0][2] * a0[2] * rsy; o0[3] = bfhi(xv.y) + g[bj][0][3] * a0[3] * rsy;
                    o1[0] = bflo(xv.z) + g[bj][1][0] * a1[0] * rsy; o1[1] = bfhi(xv.z) + g[bj][1][1] * a1[1] * rsy; o1[2] = bflo(xv.w) + g[bj][1][2] * a1[2] * rsy; o1[3] = bfhi(xv.w) + g[bj][1][3] * a1[3] * rsy;
                    q += (o0[0] * o0[0] + o0[1] * o0[1]) + (o0[2] * o0[2] + o0[3] * o0[3]) + (o1[0] * o1[0] + o1[1] * o1[1]) + (o1[2] * o1[2] + o1[3] * o1[3]);
                    *(u32x4*)(XB + row * DM + col) = pack8(o0, o1); }
                q += __shfl_xor(q, 16); q += __shfl_xor(q, 32);
                P[r * 4 + wc] = q;
            }
        asm volatile("s_waitcnt lgkmcnt(0)" ::: "memory"); __builtin_amdgcn_s_barrier(); asm volatile("" ::: "memory");
        { const int wid = wr * 4 + wc, lane = fq * 16 + fr, row = wid * 32 + (lane & 31);
          if (lane < 32) { const f32x4 p = *(const LAS f32x4*)(P + row * 4); RS2P[((size_t)u.pm * BM + row) * 4 + u.pn] = (p[0] + p[1]) + (p[2] + p[3]); } }
        asm volatile("s_waitcnt lgkmcnt(0)" ::: "memory"); __builtin_amdgcn_s_barrier(); asm volatile("" ::: "memory");
    }
};
struct EpiOut {
    __device__ __forceinline__ void pre(const Unit&, LAS unsigned char*, int) const {}
    static constexpr bool PEEL = true, PERM = false, AFTER_DRAIN = false; static constexpr int NS = 0;
    const bf16* XB; const float* gpost; float* out; PanelSS st;
    __device__ __forceinline__ void operator()(const f32x4 (&acc)[2][2][4][2], const Unit& u, int wr, int wc, int fr, int fq, const LAS unsigned char* xlds) const {
        LAS unsigned char* xl = const_cast<LAS unsigned char*>(xlds);
        const LAS float* S = (const LAS float*)(xl + 8192);
        const size_t off0 = (size_t)(u.pm * BM + wr * 64 + fr) * DM + u.pn * BM + wc * 32 + 4 * fq;
        const bf16* xb0 = XB + off0; float* o0p = out + off0;
        u32x2 r0[4][2][2];
#pragma unroll
        for (int m = 0; m < 4; ++m)
#pragma unroll
            for (int bj = 0; bj < 2; ++bj)
#pragma unroll
                for (int n = 0; n < 2; ++n) r0[m][bj][n] = *(const u32x2*)(xb0 + (size_t)(m * 16) * DM + bj * HALF + 16 * n);
        f32x4 g[2][2];
#pragma unroll
        for (int bj = 0; bj < 2; ++bj)
#pragma unroll
            for (int n = 0; n < 2; ++n) g[bj][n] = *(const f32x4*)(gpost + u.pn * BM + bj * HALF + wc * 32 + 16 * n + 4 * fq);
        u32x2 r1[4][2][2];
        (void)st.run(acc, u, wr, wc, fr, fq, xl, [&]() {
#pragma unroll
            for (int m = 0; m < 4; ++m)
#pragma unroll
                for (int bj = 0; bj < 2; ++bj)
#pragma unroll
                    for (int n = 0; n < 2; ++n) r1[m][bj][n] = *(const u32x2*)(xb0 + (size_t)(HALF + m * 16) * DM + bj * HALF + 16 * n); });
#pragma unroll
        for (int ai = 0; ai < 2; ++ai)
#pragma unroll
            for (int m = 0; m < 4; ++m) { const int r = ai * HALF + wr * 64 + m * 16 + fr; const float rsf = S[r];
#pragma unroll
                for (int bj = 0; bj < 2; ++bj)
#pragma unroll
                    for (int n = 0; n < 2; ++n) {
                        const u32x2 xv = ai == 0 ? r0[m][bj][n] : r1[m][bj][n]; const f32x4 a0 = acc[ai][bj][m][n]; f32x4 o;
                        o[0] = bflo(xv.x) + g[bj][n][0] * a0[0] * rsf; o[1] = bfhi(xv.x) + g[bj][n][1] * a0[1] * rsf; o[2] = bflo(xv.y) + g[bj][n][2] * a0[2] * rsf; o[3] = bfhi(xv.y) + g[bj][n][3] * a0[3] * rsf;
                        *(f32x4*)(o0p + (size_t)(ai * HALF + m * 16) * DM + bj * HALF + 16 * n) = o; }
            }
    }
};
struct EpiGU {
    static constexpr bool PEEL = true, PERM = true, AFTER_DRAIN = false; static constexpr int NS = 8;
    const float* rs2p; bf16* ACT; int pn0;
    __device__ __forceinline__ void pre(const Unit& u, LAS unsigned char* xlds, int tid) const {
        if (tid < 64) {
#pragma unroll
            for (int i = 0; i < 4; ++i) __builtin_amdgcn_global_load_lds((const unsigned*)(rs2p + ((size_t)u.pm * BM + i * 64 + tid) * 4), (LAS unsigned*)(xlds + i * 1024), 16, 0, 0); }
    }
    __device__ __forceinline__ void operator()(const f32x4 (&acc)[2][2][4][2], const Unit& u, int wr, int wc, int fr, int fq, const LAS unsigned char* xlds) const {
        const int hid = (u.pn + pn0) * HALF + wc * 32 + 8 * fq;
        float vv[8], sll[8];
#pragma unroll
        for (int i = 0; i < 8; ++i) { const f32x4 pq = *(const LAS f32x4*)(xlds + ((i >> 2) * HALF + wr * 64 + (i & 3) * 16 + fr) * 16);
            vv[i] = ((pq[0] + pq[1]) + (pq[2] + pq[3])) * (1.f / 1024.f) + EPS; }
#pragma unroll
        for (int i = 0; i < 8; ++i) sll[i] = __builtin_amdgcn_rsqf(vv[i]) * -1.4426950408889634f;
#pragma unroll
        for (int ai = 0; ai < 2; ++ai)
#pragma unroll
            for (int m = 0; m < 4; ++m) {
                const size_t row = (size_t)u.pm * BM + ai * HALF + wr * 64 + m * 16 + fr; const float v = vv[ai * 4 + m], sl = sll[ai * 4 + m];
                const f32x2 v2 = {v, v}, sl2 = {sl, sl};
                f32x4 o[2];
#pragma unroll
                for (int n = 0; n < 2; ++n)
#pragma unroll
                    for (int p = 0; p < 2; ++p) {
                        const f32x2 g2 = {acc[ai][0][m][n][2 * p], acc[ai][0][m][n][2 * p + 1]}, u2 = {acc[ai][1][m][n][2 * p], acc[ai][1][m][n][2 * p + 1]};
                        const f32x2 t = g2 * sl2; f32x2 e = {__builtin_amdgcn_exp2f(t[0]), __builtin_amdgcn_exp2f(t[1])};
                        e = __builtin_elementwise_fma(e, v2, v2); const f32x2 r = {frcp(e[0]), frcp(e[1])}, q = (g2 * u2) * r;
                        o[n][2 * p] = q[0]; o[n][2 * p + 1] = q[1]; }
                *(u32x4*)(ACT + row * DFF + hid) = pack8(o[0], o[1]);
            }
    }
};

template <class Epi, class Sched, bool ALIGN_EPI = true, bool NOWRAP = false>
__device__ __forceinline__ void gemm_phase(LAS unsigned char* lds, const Gemm g, Sched S, const Epi& E) {
    int tid = threadIdx.x; asm volatile("" : "+v"(tid));
    const int wid = __builtin_amdgcn_readfirstlane(tid >> 6), lane = tid & 63, wr = wid >> 2, wc = wid & 3, fr = lane & 15, fq = lane >> 4;
    const int K = g.K, nt = K / BK;
    unsigned voffA[2], voffB[2];
#pragma unroll
    for (int i = 0; i < 2; ++i) { int R, C; stage_rc(tid * 16 + i * 8192, R, C); const int Rb = Epi::PERM ? ((R & ~31) + perm32(R & 31)) : R;
        voffA[i] = (unsigned)(R * g.lda + C) * 2u; voffB[i] = (unsigned)(Rb * g.ldb + C) * 2u; }
    const size_t kstep = (size_t)(BK * 2);
    const size_t hstepA = (size_t)HALF * g.lda * 2, hstepB = (size_t)HALF * g.ldb * 2;
    const size_t tstepA = 2 * hstepA, tstepB = 2 * hstepB;
    const unsigned ldsw = (unsigned)wid * 1024u;
    const int aoff = lds_byte(wr * 64 + fr, fq * 8), boff = lds_byte(wc * 32 + fr, fq * 8);
#define PG8_SA(b, h) (((b) * 2 + (h)) * HTB)
#define PG8_SB(b, h) ((4 + (b) * 2 + (h)) * HTB)
#define PG8_STAGE(bufoff, gbase, voff) do { _Pragma("unroll") for (int _i = 0; _i < 2; ++_i) \
        __builtin_amdgcn_global_load_lds((const unsigned*)((const char*)(gbase) + (voff)[_i]), (LAS unsigned*)(lds + (bufoff) + ldsw + _i * 8192), 16, 0, 0); } while (0)
#define PG8_LDA(dst, b, h) do { _Pragma("unroll") for (int m = 0; m < 4; ++m) _Pragma("unroll") for (int k = 0; k < 2; ++k) dst[m][k] = *(const LAS bf16x8*)(lds + PG8_SA(b, h) + aoff + m * 2048 + k * 1024); } while (0)
#define PG8_LDB(dst, b, h) do { _Pragma("unroll") for (int n = 0; n < 2; ++n) _Pragma("unroll") for (int k = 0; k < 2; ++k) dst[n][k] = *(const LAS bf16x8*)(lds + PG8_SB(b, h) + boff + n * 2048 + k * 1024); } while (0)
#define PG8_MMA(ai, bj, At, Bt) do { __builtin_amdgcn_s_setprio(1); _Pragma("unroll") for (int m = 0; m < 4; ++m) _Pragma("unroll") for (int n = 0; n < 2; ++n) _Pragma("unroll") for (int k = 0; k < 2; ++k) \
        acc[ai][bj][m][n] = __builtin_amdgcn_mfma_f32_16x16x32_bf16(Bt[n][k], At[m][k], acc[ai][bj][m][n], 0, 0, 0); __builtin_amdgcn_s_setprio(0); } while (0)
#define PG8_MMAZ(ai, bj, At, Bt) do { __builtin_amdgcn_s_setprio(1); _Pragma("unroll") for (int m = 0; m < 4; ++m) _Pragma("unroll") for (int n = 0; n < 2; ++n) { \
        acc[ai][bj][m][n] = __builtin_amdgcn_mfma_f32_16x16x32_bf16(Bt[n][0], At[m][0], (f32x4){0.f, 0.f, 0.f, 0.f}, 0, 0, 0); \
        acc[ai][bj][m][n] = __builtin_amdgcn_mfma_f32_16x16x32_bf16(Bt[n][1], At[m][1], acc[ai][bj][m][n], 0, 0, 0); } __builtin_amdgcn_s_setprio(0); } while (0)
#define PG8_WAIT_V(n) asm volatile("s_waitcnt vmcnt(" #n ")" ::: "memory")
#define PG8_WAIT_L(n) asm volatile("s_waitcnt lgkmcnt(" #n ")" ::: "memory")
#define PG8_WAIT_VF PG8_WAIT_V(8)
#define PG8_BAR __builtin_amdgcn_s_barrier()
#define PG8_SCHED __builtin_amdgcn_sched_barrier(0)
    Unit cur, nxt; int ui = 0;
    if (!S.next(0, cur)) return;
    f32x4 acc[2][2][4][2];
    bf16x8 At[4][2], B0[2][2], B1[2][2];
    const char* cA = (const char*)g.A + (size_t)cur.pm * tstepA; const char* cB = (const char*)g.Bt + (size_t)cur.pn * tstepB;
    S.a_ready(cur);
    PG8_STAGE(PG8_SB(0, 0), cB, voffB); PG8_STAGE(PG8_SB(0, 1), cB + hstepB, voffB); PG8_STAGE(PG8_SA(0, 0), cA, voffA); PG8_STAGE(PG8_SA(0, 1), cA + hstepA, voffA);
    if (wr == 1) PG8_BAR;
    PG8_WAIT_V(2); PG8_BAR;
    PG8_STAGE(PG8_SB(1, 0), cB + kstep, voffB); PG8_STAGE(PG8_SA(1, 0), cA + kstep, voffA); PG8_STAGE(PG8_SB(1, 1), cB + hstepB + kstep, voffB);
    PG8_WAIT_V(6); PG8_BAR;
    for (;;) {
        const bool has_next = S.next(ui + 1, nxt);
        const char* nA = has_next ? (const char*)g.A + (size_t)nxt.pm * tstepA : cA; const char* nB = has_next ? (const char*)g.Bt + (size_t)nxt.pn * tstepB : cB;
#define PG8_KBODY(MM, LAST) { \
            const bool last = (LAST); \
            const char* a1 = cA + (size_t)(t + 1) * kstep; \
            const char* a2 = last ? nA : cA + (size_t)(t + 2) * kstep; const char* b2 = last ? nB : cB + (size_t)(t + 2) * kstep; \
            const char* a3 = a2 + kstep; const char* b3 = b2 + kstep; \
            if (last && has_next) S.a_ready(nxt); \
            if (last) { int tp = tid; asm volatile("" : "+v"(tp)); E.pre(cur, lds + STAGE_BYTES, tp); }     \
              \
            PG8_LDB(B0, 0, 0); PG8_LDB(B1, 0, 1); PG8_SCHED; PG8_LDA(At, 0, 0); PG8_STAGE(PG8_SA(1, 1), a1 + hstepA, voffA); \
            PG8_WAIT_VF; PG8_WAIT_L(0); PG8_BAR; MM(0, 0, At, B0); MM(0, 1, At, B1); PG8_BAR; PG8_SCHED; \
            const bool nw = NOWRAP && last;     \
              \
            PG8_LDA(At, 0, 1); if (!nw) { PG8_STAGE(PG8_SB(0, 0), b2, voffB); PG8_STAGE(PG8_SB(0, 1), b2 + hstepB, voffB); PG8_STAGE(PG8_SA(0, 0), a2, voffA); } \
            if (nw) PG8_WAIT_V(2); else PG8_WAIT_VF; PG8_WAIT_L(0); PG8_BAR; MM(1, 0, At, B0); MM(1, 1, At, B1); PG8_BAR; PG8_SCHED; \
              \
            PG8_LDB(B0, 1, 0); PG8_LDB(B1, 1, 1); PG8_SCHED; PG8_LDA(At, 1, 0); if (!nw) PG8_STAGE(PG8_SA(0, 1), a2 + hstepA, voffA); \
            if (nw) PG8_WAIT_V(0); else PG8_WAIT_V(8); PG8_WAIT_L(0); PG8_BAR; PG8_MMA(0, 0, At, B0); PG8_MMA(0, 1, At, B1); PG8_BAR; PG8_SCHED; \
              \
            PG8_LDA(At, 1, 1); if (!nw) { PG8_STAGE(PG8_SB(1, 0), b3, voffB); PG8_STAGE(PG8_SB(1, 1), b3 + hstepB, voffB); PG8_STAGE(PG8_SA(1, 0), a3, voffA); } \
            if (nw) PG8_WAIT_V(0); else PG8_WAIT_V(8); PG8_WAIT_L(0); PG8_BAR; PG8_MMA(1, 0, At, B0); PG8_MMA(1, 1, At, B1); PG8_BAR; PG8_SCHED; }
        if constexpr (Epi::PEEL) { int t = 0; asm volatile("" : "+s"(t)); PG8_KBODY(PG8_MMAZ, false) } else { _Pragma("unroll") for (int a_ = 0; a_ < 2; ++a_) _Pragma("unroll") for (int b_ = 0; b_ < 2; ++b_) _Pragma("unroll") for (int m_ = 0; m_ < 4; ++m_) _Pragma("unroll") for (int n_ = 0; n_ < 2; ++n_) acc[a_][b_][m_][n_] = (f32x4){0.f, 0.f, 0.f, 0.f}; }
#pragma unroll 1
        for (int t = Epi::PEEL ? 2 : 0; t < nt; t += 2) PG8_KBODY(PG8_MMA, t == nt - 2)
#undef PG8_KBODY
        if constexpr (ALIGN_EPI) { if (wr == 0) PG8_BAR; }
        { int tv = tid; asm volatile("" : "+v"(tv)); const int frv = tv & 15, fqv = (tv >> 4) & 3;
          E(acc, cur, wr, wc, frv, fqv, lds + STAGE_BYTES); } S.done(cur);
        if (!has_next) break;
        cur = nxt; cA = nA; cB = nB; ++ui;
        if constexpr (ALIGN_EPI) { if (wr == 1) PG8_BAR; }
    }
    PG8_WAIT_V(0);
    if constexpr (!ALIGN_EPI) { if (wr == 0) PG8_BAR; }
    PG8_BAR;
#undef PG8_SA
#undef PG8_SB
#undef PG8_STAGE
#undef PG8_LDA
#undef PG8_LDB
#undef PG8_MMA
#undef PG8_MMAZ
#undef PG8_WAIT_V
#undef PG8_WAIT_L
#undef PG8_WAIT_VF
#undef PG8_BAR
#undef PG8_SCHED
}
}

#define XB_TMO      128
#define XB_XCNT(j)  (256  + 64 * (j))
#define XB_XSUB(j)  (1280 + 64 * (j))
#define XB_XGEN(j)  (2304 + 64 * (j))
#define XB_TOP      3328
#define XB_TOPGEN   3392
#define XCD_BAR_WORDS 3456
#define XB_SPIN_CAP (1u << 20)
__device__ __forceinline__ unsigned xb_ld(unsigned* p)              { return __hip_atomic_load(p, __ATOMIC_RELAXED, __HIP_MEMORY_SCOPE_AGENT); }
__device__ __forceinline__ unsigned xb_add(unsigned* p, unsigned v) { return __hip_atomic_fetch_add(p, v, __ATOMIC_RELAXED, __HIP_MEMORY_SCOPE_AGENT); }
__device__ __forceinline__ unsigned xb_xcc_id() { return (unsigned)__builtin_amdgcn_s_getreg((3 << 11) | 20) & 0xFu; }
#define XB_SPIN(cond, bar) do { unsigned _sp = 0; while (cond) { __builtin_amdgcn_s_sleep(1); \
    if ((++_sp & 255u) == 0u) { if (xb_ld(&(bar)[XB_TMO])) break; if (_sp > XB_SPIN_CAP) { atomicAdd(&(bar)[XB_TMO], 1u); break; } } } } while (0)
struct XcdBarrier { unsigned* bar; unsigned x; volatile LAS unsigned* st; };
__device__ __forceinline__ XcdBarrier xcd_barrier_post(unsigned* bar, volatile LAS unsigned* st) {
    XcdBarrier b; b.bar = bar; b.x = xb_xcc_id(); b.st = st;
    if (threadIdx.x == 0) (void)xb_add(&bar[XB_XCNT(b.x)], 1u);
    return b;
}
__device__ __forceinline__ void xcd_barrier_complete(unsigned* bar, unsigned x, unsigned& nloc, unsigned& nx) {
    const unsigned G = gridDim.x * gridDim.y * gridDim.z;
    unsigned sum, cnt, mine, sp = 0u;
    for (;;) {
        sum = 0u; cnt = 0u; mine = 0u;
#pragma unroll
        for (unsigned j = 0; j < 16; ++j) { const unsigned c = xb_ld(&bar[XB_XCNT(j)]); sum += c; cnt += (c > 0u) ? 1u : 0u; mine = (j == x) ? c : mine; }
        if (sum == G) break;
        __builtin_amdgcn_s_sleep(1);
        if ((++sp & 255u) == 0u) { if (xb_ld(&bar[XB_TMO])) break; if (sp > XB_SPIN_CAP) { atomicAdd(&bar[XB_TMO], 1u); break; } }
    }
    nloc = mine > 0u ? mine : 1u; nx = cnt > 0u ? cnt : 1u;
}
__device__ __forceinline__ void xcd_barrier(const XcdBarrier& b) {
    asm volatile("s_waitcnt vmcnt(0)" ::: "memory");
    __syncthreads();
    if (threadIdx.x == 0) {
        unsigned* bar = b.bar;
        __builtin_amdgcn_s_waitcnt(0);
        unsigned nloc = b.st[0], nx = b.st[1];
        if (nloc == 0u) { xcd_barrier_complete(bar, b.x, nloc, nx); b.st[0] = nloc; b.st[1] = nx; }
        const unsigned old = xb_add(&bar[XB_XSUB(b.x)], 1u);
        const unsigned gen = old / nloc;
        if (old + 1u == (gen + 1u) * nloc) {
            __builtin_amdgcn_fence(__ATOMIC_RELEASE, "agent");
            asm volatile("s_waitcnt vmcnt(0)" ::: "memory");
            const unsigned og = xb_add(&bar[XB_TOP], 1u);
            const unsigned tg = og / nx;
            if (og + 1u == (tg + 1u) * nx) xb_add(&bar[XB_TOPGEN], 1u);
            else XB_SPIN(xb_ld(&bar[XB_TOPGEN]) == tg, bar);
            __builtin_amdgcn_fence(__ATOMIC_ACQUIRE, "agent");
            xb_add(&bar[XB_XGEN(b.x)], 1u);
            asm volatile("s_waitcnt vmcnt(0)" ::: "memory");
        } else {
            XB_SPIN(xb_ld(&bar[XB_XGEN(b.x)]) == gen, bar);
            __builtin_amdgcn_fence(__ATOMIC_ACQUIRE, "agent");
            asm volatile("s_waitcnt vmcnt(0)" ::: "memory");
        }
    }
    __syncthreads();
}

struct Args {
    const float* in[28]; float* out; unsigned char* ws; int ph_lo, ph_hi, pad0, pad1;
};
enum { I_X = 0, I_NMPRE, I_NMPOST, I_NFPRE, I_NFPOST, I_WIN, I_GBIAS, I_LRE, I_LIM, I_LDT, I_BRE, I_BIM, I_CRE, I_CIM, I_S5D, I_WGLU, I_BGLU,
       I_CONVW, I_CONVB, I_WQ, I_WK, I_WV, I_HNORM, I_SKIP, I_WOUT, I_WGATE, I_WUP, I_WDOWN };


__device__ __forceinline__ void p0_s5_unit(const Args& a, unsigned char* ws, LAS unsigned char* lds, int u, int tid) {
    const int g = u >> 3, part = u & 7;
    LAS float* pwr = (LAS float*)lds; LAS float* pwi = pwr + 2176; LAS float* bbr = pwi + 2176; LAS float* bbi = bbr + 2048;
    LAS float* cr = bbi + 2048; LAS float* ci = cr + 1024; LAS float* kl = ci + 1024; LAS float* fac = kl + 8192;
    for (int idx = tid; idx < 2176; idx += NTHREADS) {
        const int dir = idx / 1088, rem = idx - dir * 1088, e = rem >> 6, p = rem & 63;
        const float lr = a.in[I_LRE][(dir * NG + g) * 64 + p], li = a.in[I_LIM][(dir * NG + g) * 64 + p], dt = expf(a.in[I_LDT][dir * NG + g]);
        const float mag = expf(lr * dt * (float)e); float sn, cs; sincosf(li * dt * (float)e, &sn, &cs);
        pwr[idx] = mag * cs; pwi[idx] = mag * sn;
        if (e == 1) { const float xr = expm1f(lr * dt) * cs - 2.f * sinf(0.5f * li * dt) * sinf(0.5f * li * dt), xi = mag * sn, den = lr * lr + li * li;
            fac[(dir * 64 + p) * 2] = (xr * lr + xi * li) / den; fac[(dir * 64 + p) * 2 + 1] = (xi * lr - xr * li) / den; }
    }
    for (int i = tid; i < 1024; i += NTHREADS) { const int c = i >> 6, p = i & 63; cr[p * 16 + c] = a.in[I_CRE][g * 1024 + i]; ci[p * 16 + c] = a.in[I_CIM][g * 1024 + i]; }
    __syncthreads();
    for (int idx = tid; idx < 2048; idx += NTHREADS) { const int dir = idx >> 10, p = (idx >> 4) & 63, c = idx & 15;
        const float fr = fac[(dir * 64 + p) * 2], fi = fac[(dir * 64 + p) * 2 + 1], b_r = a.in[I_BRE][(g * 64 + p) * 16 + c], b_i = a.in[I_BIM][(g * 64 + p) * 16 + c];
        bbr[idx] = fr * b_r - fi * b_i; bbi[idx] = fr * b_i + fi * b_r; }
    __syncthreads();
    {
        const int dir = tid >> 8, lsel = (tid >> 7) & 1, c = (tid >> 3) & 15, c2p = tid & 7, lag = 2 * part + lsel;
        float s0 = 0.f, s1 = 0.f;
        for (int p = 0; p < 64; ++p) {
            const float pr = pwr[(dir * 17 + lag) * 64 + p], pi = pwi[(dir * 17 + lag) * 64 + p], c_r = cr[p * 16 + c], c_i = ci[p * 16 + c];
            const float x_r = c_r * pr - c_i * pi, x_i = c_r * pi + c_i * pr;
            const f32x2 b_r = *(const LAS f32x2*)(bbr + (dir * 64 + p) * 16 + 2 * c2p), b_i = *(const LAS f32x2*)(bbi + (dir * 64 + p) * 16 + 2 * c2p);
            s0 += x_r * b_r[0] - x_i * b_i[0]; s1 += x_r * b_r[1] - x_i * b_i[1];
        }
        *(LAS f32x2*)(kl + ((dir * 2 + lsel) * 16 + c) * 16 + 2 * c2p) = (f32x2){s0, s1};
    }
    __syncthreads();
    bf16* MZ = (bf16*)(ws + WS_MZ) + (size_t)g * 256 * 256; bf16* TMY = (bf16*)(ws + WS_TMY) + (size_t)g * 256 * 512;
    for (int v = part * 1024 + tid; v < (part + 1) * 1024; v += NTHREADS) {
        const int n = v >> 5, k0 = (v & 31) * 8, dir = n >> 7, ri = (n >> 6) & 1, p = n & 63, j = k0 >> 4, c0 = k0 & 15, e = dir ? j : 15 - j;
        const float pr = pwr[(dir * 17 + e) * 64 + p], pi = pwi[(dir * 17 + e) * 64 + p]; float o[8];
#pragma unroll
        for (int cc = 0; cc < 8; ++cc) { const float b_r = bbr[(dir * 64 + p) * 16 + c0 + cc], b_i = bbi[(dir * 64 + p) * 16 + c0 + cc]; o[cc] = ri ? (pr * b_i + pi * b_r) : (pr * b_r - pi * b_i); }
        u32x4 w; w.x = pk2(o[0], o[1]); w.y = pk2(o[2], o[3]); w.z = pk2(o[4], o[5]); w.w = pk2(o[6], o[7]);
        *(u32x4*)(MZ + (size_t)n * 256 + k0) = w;
    }
    for (int v = tid; v < 2048; v += NTHREADS) {
        const int dir = v >> 10, lsel = (v >> 9) & 1, t = (v >> 5) & 15, c = (v >> 1) & 15, hf = v & 1, lag = 2 * part + lsel;
        const int j = dir ? t + lag : t - lag;
        if (j < 0 || j > 15 || (lag == 0 && dir == 1)) continue;
        float o[8];
#pragma unroll
        for (int cc = 0; cc < 8; ++cc) { const int c2 = 8 * hf + cc; float sv = kl[((dir * 2 + lsel) * 16 + c) * 16 + c2];
            if (lag == 0) { sv += kl[((1 * 2 + lsel) * 16 + c) * 16 + c2]; if (c2 == c) sv += a.in[I_S5D][g * 16 + c]; }
            o[cc] = sv; }
        u32x4 w; w.x = pk2(o[0], o[1]); w.y = pk2(o[2], o[3]); w.z = pk2(o[4], o[5]); w.w = pk2(o[6], o[7]);
        *(u32x4*)(TMY + (size_t)(t * 16 + c) * 512 + j * 16 + 8 * hf) = w;
    }
    for (int v = part * 1024 + tid; v < (part + 1) * 1024; v += NTHREADS) {
        const int n = v >> 5, k0 = 256 + (v & 31) * 8, t = n >> 4, c = n & 15; float o[8];
        const int s0 = k0 - 256, dir = s0 >> 7, ri = (s0 >> 6) & 1, e = dir ? 16 - t : t + 1;
#pragma unroll
        for (int cc = 0; cc < 8; ++cc) { const int p = (s0 & 63) + cc; const float pr = pwr[(dir * 17 + e) * 64 + p], pi = pwi[(dir * 17 + e) * 64 + p], c_r = cr[p * 16 + c], c_i = ci[p * 16 + c];
            o[cc] = ri ? -(c_r * pi + c_i * pr) : (c_r * pr - c_i * pi); }
        u32x4 w; w.x = pk2(o[0], o[1]); w.y = pk2(o[2], o[3]); w.z = pk2(o[4], o[5]); w.w = pk2(o[6], o[7]);
        *(u32x4*)(TMY + (size_t)n * 512 + k0) = w;
    }
    __syncthreads();
}
struct TrItem { const float* s0; const float* s1; const float* rs; bf16* dst; int ld, c0, c1, nh, k0, K; float cs; };
__device__ __forceinline__ void tr_load(const TrItem& t, f32x4 (&v)[2][4], float (&sc)[4], int tid) {
#pragma unroll
    for (int i = 0; i < 4; ++i) { const int idx = tid + NTHREADS * i, row = idx >> 5, c4 = idx & 31;
        sc[i] = t.rs ? t.rs[t.k0 + row] * t.cs : t.cs;
#pragma unroll
        for (int hf = 0; hf < 2; ++hf) { v[hf][i] = (f32x4){0.f, 0.f, 0.f, 0.f};
            if (hf < t.nh) v[hf][i] = *(const f32x4*)((hf ? t.s1 : t.s0) + (size_t)(t.k0 + row) * t.ld + (hf ? t.c1 : t.c0) + 4 * c4); } }
}
__device__ __forceinline__ void tr_finish(const TrItem& t, const f32x4 (&v)[2][4], const float (&sc)[4], LAS float* T, int tid) {
#pragma unroll
    for (int hf = 0; hf < 2; ++hf)
#pragma unroll
        for (int i = 0; i < 4; ++i) { const int idx = tid + NTHREADS * i, row = idx >> 5, c4 = idx & 31;
            LAS float* p = T + row * 257 + 128 * hf + 4 * c4; p[0] = v[hf][i][0] * sc[i]; p[1] = v[hf][i][1] * sc[i]; p[2] = v[hf][i][2] * sc[i]; p[3] = v[hf][i][3] * sc[i]; }
    __syncthreads();
#pragma unroll
    for (int i = 0; i < 4; ++i) { const int idx = tid + NTHREADS * i, n = idx >> 3, kc = idx & 7;
        if (n < 128 * t.nh) { const LAS float* p = T + (8 * kc) * 257 + n;
            u32x4 o; o.x = pk2(p[0], p[257]); o.y = pk2(p[2 * 257], p[3 * 257]); o.z = pk2(p[4 * 257], p[5 * 257]); o.w = pk2(p[6 * 257], p[7 * 257]);
            *(u32x4*)(t.dst + (size_t)n * t.K + t.k0 + 8 * kc) = o; } }
    __syncthreads();
}
constexpr int TR_J0 = 16 * 6, TR_J1 = 8 * 2, TR_J2 = 12 * 2, TR_J3 = 16 * 4, TR_J4 = 16 * 22, TR_J5 = 44 * 4, TR_NJ = TR_J0 + TR_J1 + TR_J2 + TR_J3 + TR_J4 + TR_J5;
__device__ __forceinline__ TrItem tr_decode(const Args& a, unsigned char* ws, int r) {
    if (r < TR_J0) { const int kb = r / 6, nb = r % 6; return TrItem{a.in[I_WIN], a.in[I_WIN], a.in[I_NMPRE], (bf16*)(ws + WS_WIN) + (size_t)(256 * nb) * 1024, D_IN, 256 * nb, 256 * nb + 128, 2, 64 * kb, 1024, 1.f}; } r -= TR_J0;
    if (r < TR_J1) { const int kb = r / 2, nb = r % 2; return TrItem{a.in[I_WGLU], a.in[I_WGLU], nullptr, (bf16*)(ws + WS_WGLU) + (size_t)(256 * nb) * 512, 512, 256 * nb, 256 * nb + 128, 2, 64 * kb, 512, 1.f}; } r -= TR_J1;
    if (r < TR_J2) { const int mh = r >> 1, kb = r & 1, mat = mh >> 2; const float* sp = (mat == 0 ? a.in[I_WQ] : mat == 1 ? a.in[I_WK] : a.in[I_WV]) + (size_t)(mh & 3) * 16384;
        return TrItem{sp, sp, nullptr, (bf16*)(ws + WS_WQKV) + (size_t)(mh * 128) * 128, 128, 0, 0, 1, 64 * kb, 128, mat == 1 ? 0.08838834764831845f : 1.f}; } r -= TR_J2;
    if (r < TR_J3) { const int kb = r / 4, nb = r % 4; return TrItem{a.in[I_WOUT], a.in[I_WOUT], nullptr, (bf16*)(ws + WS_WOUT) + (size_t)(256 * nb) * 1024, 1024, 256 * nb, 256 * nb + 128, 2, 64 * kb, 1024, 1.f}; } r -= TR_J3;
    if (r < TR_J4) { const int kb = r / 22, nb = r % 22; return TrItem{a.in[I_WGATE], a.in[I_WUP], a.in[I_NFPRE], (bf16*)(ws + WS_WGU) + (size_t)(256 * nb) * 1024, DFF, 128 * nb, 128 * nb, 2, 64 * kb, 1024, 1.f}; } r -= TR_J4;
    { const int kb = r / 4, nb = r % 4; return TrItem{a.in[I_WDOWN], a.in[I_WDOWN], nullptr, (bf16*)(ws + WS_WDN) + (size_t)(256 * nb) * DFF, 1024, 256 * nb, 256 * nb + 128, 2, 64 * kb, DFF, 1.f}; }
}
__device__ __forceinline__ void p0_prologue(const Args& a, unsigned char* ws, LAS unsigned char* lds, int tid, int wave, int lane, int vcu, int G) {
    for (int i = blockIdx.x * NTHREADS + tid; i < (int)(6 * MiB / 16); i += G * NTHREADS) *(u32x4*)(ws + WS_XS + (size_t)i * 16) = (u32x4){0u, 0u, 0u, 0u};
    const int gw = vcu * NWAVES + wave, NGW = G * NWAVES;
    {   LAS float* T = (LAS float*)lds;
        int it = vcu; bool have = it < TR_NJ; TrItem cur = tr_decode(a, ws, have ? it : 0); f32x4 v[2][4]; float sc[4];
        if (have) tr_load(cur, v, sc, tid);
        for (int u = blockIdx.x; u < NG * 8; u += G) p0_s5_unit(a, ws, lds, u, tid);
        while (have) {
            const int nx = it + G; const bool hn = nx < TR_NJ; const TrItem nxt = tr_decode(a, ws, hn ? nx : 0); f32x4 w[2][4]; float sn[4];
#pragma unroll
            for (int i = 0; i < 4; ++i) { sn[i] = 0.f; w[0][i] = (f32x4){0.f, 0.f, 0.f, 0.f}; w[1][i] = w[0][i]; }
            if (hn) tr_load(nxt, w, sn, tid);
            tr_finish(cur, v, sc, T, tid);
            cur = nxt; it = nx; have = hn;
#pragma unroll
            for (int i = 0; i < 4; ++i) { sc[i] = sn[i]; v[0][i] = w[0][i]; v[1][i] = w[1][i]; }
        }
    }
    __syncthreads();
    for (int idx = tid; idx < 32 * 64; idx += NTHREADS) {
        const int f = idx >> 6, l = idx & 63, n = l & 15, q = l >> 4, k0 = 64 * (f >> 1) + 16 * q + 8 * (f & 1); float o[8];
#pragma unroll
        for (int j = 0; j < 8; ++j) o[j] = a.in[I_NMPRE][k0 + j] * a.in[I_WIN][(size_t)(k0 + j) * D_IN + NPROJ + n];
        u32x4 w; w.x = pk2(o[0], o[1]); w.y = pk2(o[2], o[3]); w.z = pk2(o[4], o[5]); w.w = pk2(o[6], o[7]);
        *(LAS u32x4*)(lds + idx * 16) = w;
    }
    __syncthreads();
    const int r16 = lane & 15, q4 = lane >> 4;
    const float gbias = a.in[I_GBIAS][r16];
    float* RS1 = (float*)(ws + WS_RS1); float* GT = (float*)(ws + WS_GATES);
    for (int grp = gw; grp < MTOK / 16; grp += NGW) {
        const int row0 = grp * 16;
        const float* xr = a.in[I_X] + (size_t)(row0 + r16) * DM + 16 * q4;
        bf16* xo = (bf16*)(ws + WS_XB) + (size_t)(row0 + r16) * DM + 16 * q4;
        f32x4 acc = {0.f, 0.f, 0.f, 0.f}; float ss = 0.f;
#pragma unroll 1
        for (int half = 0; half < 4; ++half) {
            f32x4 v[4][4];
#pragma unroll
            for (int s8 = 0; s8 < 4; ++s8)
#pragma unroll
                for (int j = 0; j < 4; ++j) v[s8][j] = *(const f32x4*)(xr + 64 * (4 * half + s8) + 4 * j);
#pragma unroll
            for (int s8 = 0; s8 < 4; ++s8) {
                const int s = 4 * half + s8; const f32x4 v0 = v[s8][0], v1 = v[s8][1], v2 = v[s8][2], v3 = v[s8][3];
                ss += (v0[0] * v0[0] + v0[1] * v0[1]) + (v0[2] * v0[2] + v0[3] * v0[3]) + (v1[0] * v1[0] + v1[1] * v1[1]) + (v1[2] * v1[2] + v1[3] * v1[3])
                    + (v2[0] * v2[0] + v2[1] * v2[1]) + (v2[2] * v2[2] + v2[3] * v2[3]) + (v3[0] * v3[0] + v3[1] * v3[1]) + (v3[2] * v3[2] + v3[3] * v3[3]);
                u32x4 a0, a1; a0.x = pk2(v0[0], v0[1]); a0.y = pk2(v0[2], v0[3]); a0.z = pk2(v1[0], v1[1]); a0.w = pk2(v1[2], v1[3]);
                a1.x = pk2(v2[0], v2[1]); a1.y = pk2(v2[2], v2[3]); a1.z = pk2(v3[0], v3[1]); a1.w = pk2(v3[2], v3[3]);
                *(u32x4*)(xo + 64 * s) = a0; *(u32x4*)(xo + 64 * s + 8) = a1;
                const bf16x8 b0 = *(const LAS bf16x8*)(lds + ((2 * s) * 64 + lane) * 16), b1 = *(const LAS bf16x8*)(lds + ((2 * s + 1) * 64 + lane) * 16);
                acc = __builtin_amdgcn_mfma_f32_16x16x32_bf16(__builtin_bit_cast(bf16x8, a0), b0, acc, 0, 0, 0);
                acc = __builtin_amdgcn_mfma_f32_16x16x32_bf16(__builtin_bit_cast(bf16x8, a1), b1, acc, 0, 0, 0);
            }
        }
        ss += __shfl_xor(ss, 16); ss += __shfl_xor(ss, 32);
        const float rs = __builtin_amdgcn_rsqf(ss * (1.f / DM) + EPS);
        if (q4 == 0) RS1[row0 + r16] = rs;
#pragma unroll
        for (int reg = 0; reg < 4; ++reg) { const float rsr = __shfl(rs, 4 * q4 + reg); GT[(size_t)(row0 + 4 * q4 + reg) * 16 + r16] = acc[reg] * rsr + gbias; }
    }
    __syncthreads();
}

__device__ __forceinline__ void s5_scan_lds(const Args& a, unsigned char* ws, const LAS unsigned char* zl, int L, int tid) {
    if (tid < 256) {
        bf16* UX = (bf16*)(ws + WS_UX);
        const int g = L >> 4, bl = (tid >> 7) & 1, b = 2 * (L & 15) + bl, dir = (tid >> 6) & 1, p = tid & 63;
        const float lr = a.in[I_LRE][(dir * NG + g) * 64 + p], li = a.in[I_LIM][(dir * NG + g) * 64 + p], dt = expf(a.in[I_LDT][dir * NG + g]);
        const float mag = expf(lr * dt * 16.f); float sn, cs; sincosf(li * dt * 16.f, &sn, &cs);
        const float ar = mag * cs, ai = mag * sn;
        const LAS bf16* z = (const LAS bf16*)(zl + (size_t)(bl * S5NCH) * pg8::ZLP) + dir * 128 + p;
        bf16* o = UX + (size_t)(g * S5ROWS + b * S5NCH) * 512 + 256 + dir * 128 + p;
        float sr = 0.f, si = 0.f;
#pragma unroll 1
        for (int kb = 0; kb < S5NCH / 16; ++kb) {
            float zr[16], zi[16];
#pragma unroll
            for (int j = 0; j < 16; ++j) { const int kk = kb * 16 + j, k = dir ? (S5NCH - 1 - kk) : kk; zr[j] = bf2f(z[k * (pg8::ZLP / 2)]); zi[j] = bf2f(z[k * (pg8::ZLP / 2) + 64]); }
#pragma unroll
            for (int j = 0; j < 16; ++j) { const int kk = kb * 16 + j, k = dir ? (S5NCH - 1 - kk) : kk;
                o[(size_t)k * 512] = (bf16)(pk2(sr, 0.f) & 0xffffu); o[(size_t)k * 512 + 64] = (bf16)(pk2(si, 0.f) & 0xffffu);
                const float nr = ar * sr - ai * si + zr[j], ni = ar * si + ai * sr + zi[j]; sr = nr; si = ni; }
        }
    }
}

__device__ __forceinline__ void s5_scan(const Args& a, unsigned char* ws, int tid, int G) {
    const bf16* ZB = (const bf16*)(ws + WS_ZB); bf16* UX = (bf16*)(ws + WS_UX);
    for (int base = 0; base * G < NG * 16; base += 2) {
        const int L = (base + (tid >> 8)) * G + (int)blockIdx.x;
        if (L < NG * 16) {
            const int g = L >> 4, b = 2 * (L & 15) + ((tid >> 7) & 1), dir = (tid >> 6) & 1, p = tid & 63;
            const float lr = a.in[I_LRE][(dir * NG + g) * 64 + p], li = a.in[I_LIM][(dir * NG + g) * 64 + p], dt = expf(a.in[I_LDT][dir * NG + g]);
            const float mag = expf(lr * dt * 16.f); float sn, cs; sincosf(li * dt * 16.f, &sn, &cs);
            const float ar = mag * cs, ai = mag * sn;
            const bf16* z = ZB + (size_t)(g * S5ROWS + b * S5NCH) * 256 + dir * 128 + p;
            bf16* o = UX + (size_t)(g * S5ROWS + b * S5NCH) * 512 + 256 + dir * 128 + p;
            float sr = 0.f, si = 0.f;
#pragma unroll 1
            for (int kb = 0; kb < S5NCH / 16; ++kb) {
                float zr[16], zi[16];
#pragma unroll
                for (int j = 0; j < 16; ++j) { const int kk = kb * 16 + j, k = dir ? (S5NCH - 1 - kk) : kk; zr[j] = bf2f(z[(size_t)k * 256]); zi[j] = bf2f(z[(size_t)k * 256 + 64]); }
#pragma unroll
                for (int j = 0; j < 16; ++j) { const int kk = kb * 16 + j, k = dir ? (S5NCH - 1 - kk) : kk;
                    o[(size_t)k * 512] = (bf16)(pk2(sr, 0.f) & 0xffffu); o[(size_t)k * 512 + 64] = (bf16)(pk2(si, 0.f) & 0xffffu);
                    const float nr = ar * sr - ai * si + zr[j], ni = ar * si + ai * sr + zi[j]; sr = nr; si = ni; }
            }
        }
    }
}

__device__ __forceinline__ void ml_pre(const Args& a, unsigned char* ws, LAS unsigned char* lds, int gw, int NGW, int wave, int lane, int G) {
    const float* GT = (const float*)(ws + WS_GATES);
    LAS float* sm = (LAS float*)lds;
    const int w4 = __builtin_amdgcn_readfirstlane(wave) * 4;
    for (int cid = blockIdx.x; cid < BATCH * NH * 2; cid += G) {
        const int b = cid >> 3, h = (cid >> 1) & 3, dir = cid & 1;
        float* GS = (float*)(ws + WS_GS) + (size_t)cid * SEQ * 8;
        float gi[4], gf[4], rr[4], bs[4], Rm[4];
#pragma unroll
        for (int j = 0; j < 4; ++j) { const int lp = (w4 + j) * 64 + lane, pos = dir ? (SEQ - 1 - lp) : lp; const float* gp = GT + (size_t)(b * SEQ + pos) * 16;
            gi[j] = gp[(dir ? 4 : 0) + h]; gf[j] = gp[(dir ? 12 : 8) + h]; }
#pragma unroll
        for (int j = 0; j < 4; ++j) {
            const float lf = fminf(gf[j], 0.f) - log1pf(expf(-fabsf(gf[j])));
            float bsum = lf;
#pragma unroll
            for (int o = 1; o < 64; o <<= 1) { const float v = __shfl_up(bsum, o); if (lane >= o) bsum += v; }
            const float r = gi[j] - bsum; float R = r;
#pragma unroll
            for (int o = 1; o < 64; o <<= 1) { const float v = __shfl_up(R, o); if (lane >= o) R = fmaxf(R, v); }
            rr[j] = r; bs[j] = bsum; Rm[j] = R;
            if (lane == 63) *(LAS f32x2*)(sm + (w4 + j) * 2) = (f32x2){bsum, R};
        }
        __syncthreads();
        float ms = 0.f;
#pragma unroll
        for (int c = 0; c < 28; ++c) if (c < w4) { const f32x2 e = *(const LAS f32x2*)(sm + c * 2); ms = e[0] + fmaxf(ms, e[1]); }
#pragma unroll
        for (int j = 0; j < 4; ++j) { const int lp = (w4 + j) * 64 + lane;
            const float mu = fmaxf(ms, Rm[j]), mu_last = __shfl(mu, 63), b_last = __shfl(bs[j], 63);
            *(f32x4*)(GS + (size_t)lp * 8) = (f32x4){rr[j], mu, expf(ms - mu), expf(-(bs[j] + mu))};
            *(f32x2*)(GS + (size_t)lp * 8 + 4) = (f32x2){expf(rr[j] - mu_last), expf(ms - mu_last)};
            ms = b_last + mu_last; }
        __syncthreads();
    }
    const bf16* XMg = (const bf16*)(ws + WS_XM); bf16* XCg = (bf16*)(ws + WS_XC);
    const int col = 8 * lane;
    float cw[5][8], cb[8];
#pragma unroll
    for (int e = 0; e < 8; ++e) { cb[e] = a.in[I_CONVB][col + e];
#pragma unroll
        for (int j = 0; j < 5; ++j) cw[j][e] = a.in[I_CONVW][j * 512 + col + e]; }
    for (int grp = gw; grp < MTOK / 8; grp += NGW) {
        const int row0 = grp * 8, s0 = row0 & (SEQ - 1);
        u32x4 xv[12];
#pragma unroll
        for (int i = 0; i < 12; ++i) { const int sp = s0 + i - 2; xv[i] = (u32x4){0u, 0u, 0u, 0u}; if (sp >= 0 && sp < SEQ) xv[i] = *(const u32x4*)(XMg + (size_t)(row0 + i - 2) * 512 + col); }
#pragma unroll
        for (int r = 0; r < 8; ++r) { float z[8];
#pragma unroll
            for (int e = 0; e < 8; ++e) z[e] = cb[e];
#pragma unroll
            for (int j = 0; j < 5; ++j) { const u32x4 x = xv[r + j];
                z[0] += cw[j][0] * bflo(x.x); z[1] += cw[j][1] * bfhi(x.x); z[2] += cw[j][2] * bflo(x.y); z[3] += cw[j][3] * bfhi(x.y);
                z[4] += cw[j][4] * bflo(x.z); z[5] += cw[j][5] * bfhi(x.z); z[6] += cw[j][6] * bflo(x.w); z[7] += cw[j][7] * bfhi(x.w); }
            u32x4 o; o.x = pk2(siluf_(z[0]), siluf_(z[1])); o.y = pk2(siluf_(z[2]), siluf_(z[3])); o.z = pk2(siluf_(z[4]), siluf_(z[5])); o.w = pk2(siluf_(z[6]), siluf_(z[7]));
            *(u32x4*)(XCg + (size_t)(row0 + r) * 512 + col) = o; }
    }
}

constexpr int ML_XM = 0, ML_XC = 16384, ML_QS = 32768, ML_KS = 51200, ML_VT = 69632, ML_KT = 88064, ML_P = 108544, ML_CB = 118784, ML_SC = 153600;
constexpr int RPQ = 288, RQ = 160, RPC = 272, RQV = 144;
__device__ __forceinline__ int sw128(int row, int off) { return row * 256 + ((((off) >> 4) ^ (row & 15)) << 4) + (off & 15); }
__device__ __forceinline__ int sw64(int row, int off) { return row * 128 + ((((off) >> 4) ^ ((row >> 1) & 7)) << 4) + (off & 15); }
__device__ __forceinline__ int xsw(int row, int chunk) { return row * 256 + ((chunk ^ (row & 15)) << 4); }
constexpr int SC_R = 0, SC_MU = 64, SC_WI = 128, SC_ME = 192, SC_WS = 256, SC_DEN = 320, SC_NQ = 384, SC_DEC = 448, SC_BUF = 512, SC_N = 1024, SC_NB = 1152;
static_assert(ML_SC + (SC_NB + 64) * 4 <= MISC_OFF, "mLSTM LDS map");
typedef __bf16 bf16x2v __attribute__((ext_vector_type(2)));
__device__ __forceinline__ float dot2bf(unsigned a, unsigned b, float c) { return __builtin_amdgcn_fdot2_f32_bf16(__builtin_bit_cast(bf16x2v, a), __builtin_bit_cast(bf16x2v, b), c, false); }
#define MFMA16(a, b, c) __builtin_amdgcn_mfma_f32_16x16x32_bf16((a), (b), (c), 0, 0, 0)
__device__ __forceinline__ void mlstm_chain(const Args& a, unsigned char* ws, LAS unsigned char* lds, int cid, int tid, int wave, int lane) {
    const int b = cid >> 3, h = (cid >> 1) & 3, dir = cid & 1;
    const bf16* XMg = (const bf16*)(ws + WS_XM) + (size_t)b * SEQ * 512 + h * 128; const bf16* XCg = (const bf16*)(ws + WS_XC) + (size_t)b * SEQ * 512 + h * 128;
    const float* GS = (const float*)(ws + WS_GS) + (size_t)cid * SEQ * 8; bf16* HO = (bf16*)(ws + (dir ? WS_HB : WS_HF)) + (size_t)b * SEQ * 512 + h * 128;
    const bf16* WQ = (const bf16*)(ws + WS_WQKV) + (size_t)(0 * 4 + h) * 16384; const bf16* WK = (const bf16*)(ws + WS_WQKV) + (size_t)(1 * 4 + h) * 16384; const bf16* WV = (const bf16*)(ws + WS_WQKV) + (size_t)(2 * 4 + h) * 16384;
    LAS float* sc = (LAS float*)(lds + ML_SC);
    for (int i = tid; i < (ML_SC - ML_P) / 16; i += NTHREADS) *(LAS u32x4*)(lds + ML_P + i * 16) = (u32x4){0u, 0u, 0u, 0u};
    if (tid < 128) sc[SC_N + tid] = 0.f;
    if (tid < 64) sc[SC_NB + tid] = 0.f;
    for (int i = tid; i < 64 * 16; i += NTHREADS) { const int lr = i >> 4, cc = i & 15, pos = dir ? (SEQ - 1 - lr) : lr;
        *(LAS u32x4*)(lds + ML_XM + xsw(lr, cc)) = *(const u32x4*)(XMg + (size_t)pos * 512 + cc * 8);
        *(LAS u32x4*)(lds + ML_XC + xsw(lr, cc)) = *(const u32x4*)(XCg + (size_t)pos * 512 + cc * 8); }
    if (wave == 0) { const f32x4 g0 = *(const f32x4*)(GS + (size_t)lane * 8); const f32x2 g1 = *(const f32x2*)(GS + (size_t)lane * 8 + 4);
        sc[SC_R + lane] = g0[0]; sc[SC_MU + lane] = g0[1]; sc[SC_WI + lane] = g0[2]; sc[SC_ME + lane] = g0[3]; sc[SC_WS + lane] = g1[0]; sc[SC_DEN + lane] = 0.f; if (lane == 0) sc[SC_DEC] = g1[1]; }
    bf16x8 bq[4], bk[4], bv[4];
#pragma unroll
    for (int ks = 0; ks < 4; ++ks) { const size_t o = (size_t)(16 * wave + (lane & 15)) * 128 + 32 * ks + 8 * (lane >> 4); bq[ks] = *(const bf16x8*)(WQ + o); bk[ks] = *(const bf16x8*)(WK + o); bv[ks] = *(const bf16x8*)(WV + o); }
#pragma unroll
    for (int ks = 0; ks < 4; ++ks) asm volatile("" : "+v"(bq[ks]), "+v"(bk[ks]), "+v"(bv[ks]));
    f32x4 accC[8];
#pragma unroll
    for (int nt = 0; nt < 8; ++nt) accC[nt] = (f32x4){0.f, 0.f, 0.f, 0.f};
    __syncthreads();
    if (wave < 2) __builtin_amdgcn_s_setprio(2);
#pragma unroll 1
    for (int ci = 0; ci < SEQ / 64; ++ci) {
        const int p0 = ci * 64;
        int tidv = tid; asm volatile("" : "+v"(tidv));
        const int lanev = tidv & 63, r16 = lanev & 15, q4 = lanev >> 4;
        LAS float* scc = sc + (ci & 1) * SC_BUF; LAS float* scn = sc + ((ci & 1) ^ 1) * SC_BUF;
        u32x4 pxm[2], pxc[2]; f32x4 pg0 = {0.f, 0.f, 0.f, 0.f}; f32x2 pg1 = {0.f, 0.f};
        const bool more = (ci + 1 < SEQ / 64);
#pragma unroll
        for (int i = 0; i < 2; ++i) { const int idx = tidv + NTHREADS * i, lr = idx >> 4, cc = idx & 15, lp = p0 + 64 + lr, pos = dir ? (SEQ - 1 - lp) : lp;
            pxm[i] = (u32x4){0u, 0u, 0u, 0u}; pxc[i] = pxm[i];
            if (more) { pxm[i] = *(const u32x4*)(XMg + (size_t)pos * 512 + cc * 8); pxc[i] = *(const u32x4*)(XCg + (size_t)pos * 512 + cc * 8); } }
        if (wave == 0 && more) { pg0 = *(const f32x4*)(GS + (size_t)(p0 + 64 + lanev) * 8); pg1 = *(const f32x2*)(GS + (size_t)(p0 + 64 + lanev) * 8 + 4); }
        {
            f32x4 aq[4], ak[4], av[4];
#pragma unroll
            for (int mt = 0; mt < 4; ++mt) { aq[mt] = (f32x4){0.f, 0.f, 0.f, 0.f}; ak[mt] = aq[mt]; av[mt] = aq[mt]; }
            bf16x8 xa0[4], xv0[4], xa1[4], xv1[4];
#define ML_LDX(XA, XV, MT) _Pragma("unroll") for (int ks = 0; ks < 4; ++ks) { XA[ks] = *(const LAS bf16x8*)(lds + ML_XC + xsw(16 * (MT) + r16, 4 * ks + q4)); XV[ks] = *(const LAS bf16x8*)(lds + ML_XM + xsw(16 * (MT) + r16, 4 * ks + q4)); }
#define ML_MMX(XA, XV, MT) _Pragma("unroll") for (int ks = 0; ks < 4; ++ks) { aq[MT] = MFMA16(bq[ks], XA[ks], aq[MT]); ak[MT] = MFMA16(XA[ks], bk[ks], ak[MT]); av[MT] = MFMA16(XV[ks], bv[ks], av[MT]); }
            ML_LDX(xa0, xv0, 0)
            ML_LDX(xa1, xv1, 1)
            __builtin_amdgcn_sched_barrier(0);
            ML_MMX(xa0, xv0, 0)
            ML_LDX(xa0, xv0, 2)
            __builtin_amdgcn_sched_barrier(0);
            ML_MMX(xa1, xv1, 1)
            ML_LDX(xa1, xv1, 3)
            __builtin_amdgcn_sched_barrier(0);
            ML_MMX(xa0, xv0, 2)
            __builtin_amdgcn_sched_barrier(0);
            ML_MMX(xa1, xv1, 3)
#undef ML_LDX
#undef ML_MMX
#pragma unroll
            for (int mt = 0; mt < 4; ++mt) {
                u32x2 w2; w2.x = pk2(aq[mt][0], aq[mt][1]); w2.y = pk2(aq[mt][2], aq[mt][3]);
                *(LAS u32x2*)(lds + ML_QS + sw128(16 * mt + r16, (16 * wave + 4 * q4) * 2)) = w2;
                const f32x4 ws4 = *(const LAS f32x4*)(scc + SC_WS + 16 * mt + 4 * q4);
                w2.x = pk2(ak[mt][0] * ws4[0], ak[mt][1] * ws4[1]); w2.y = pk2(ak[mt][2] * ws4[2], ak[mt][3] * ws4[3]);
                *(LAS u32x2*)(lds + ML_KT + sw64(16 * wave + r16, (16 * mt + 4 * q4) * 2)) = w2;
                {
                  float y0 = ak[mt][0], y1 = ak[mt][1], y2 = ak[mt][2], y3 = ak[mt][3]; const bool o1 = (r16 & 1) != 0, o2 = (r16 & 2) != 0;
#define ML_XCH(A, B, ODD, CTRL) { const float s_ = (ODD) ? A : B; const float r_ = __builtin_bit_cast(float, __builtin_amdgcn_mov_dpp(__builtin_bit_cast(int, s_), CTRL, 0xf, 0xf, true)); if (ODD) A = r_; else B = r_; }
                  ML_XCH(y0, y1, o1, 0xB1) ML_XCH(y2, y3, o1, 0xB1)
                  ML_XCH(y0, y2, o2, 0x4E) ML_XCH(y1, y3, o2, 0x4E)
#undef ML_XCH
                  u32x2 kw; kw.x = pk2(y0, y1); kw.y = pk2(y2, y3);
                  *(LAS u32x2*)(lds + ML_KS + (16 * mt + 4 * q4 + (r16 & 3)) * RPQ + (16 * wave + (r16 & ~3)) * 2) = kw; }
                w2.x = pk2(av[mt][0], av[mt][1]); w2.y = pk2(av[mt][2], av[mt][3]);
                *(LAS u32x2*)(lds + ML_VT + sw64(16 * wave + r16, (16 * mt + 4 * q4) * 2)) = w2;
            }
        }
        __syncthreads();
        f32x4 num[4];
        {
            bf16x8 cb[4], qa0[4], qa1[4], sa[4], sb[4];
            const int mt1 = wave >= 6 ? 3 : wave >= 3 ? 2 : wave >= 1 ? 1 : 0, nt1 = wave - (mt1 * (mt1 + 1)) / 2;
#define ML_LDQ(Q, MT) _Pragma("unroll") for (int ks = 0; ks < 4; ++ks) Q[ks] = *(const LAS bf16x8*)(lds + ML_QS + sw128(16 * (MT) + r16, (32 * ks + 8 * q4) * 2));
#define ML_MMQ(Q, MT) _Pragma("unroll") for (int ks = 0; ks < 4; ++ks) num[MT] = MFMA16(cb[ks], Q[ks], num[MT]);
#define ML_LDS_(MT, NT) _Pragma("unroll") for (int ks = 0; ks < 4; ++ks) { sa[ks] = *(const LAS bf16x8*)(lds + ML_QS + sw128(16 * (MT) + r16, (32 * ks + 8 * q4) * 2)); sb[ks] = *(const LAS bf16x8*)(lds + ML_KS + (16 * (NT) + r16) * RPQ + (32 * ks + 8 * q4) * 2); }
#define ML_STILE(MT, NT, MU, R4) { f32x4 s = {0.f, 0.f, 0.f, 0.f}; \
                _Pragma("unroll") for (int ks = 0; ks < 4; ++ks) s = MFMA16(sb[ks], sa[ks], s);     \
                const int t = 16 * (MT) + r16; float p[4], psum = 0.f; \
                _Pragma("unroll") for (int reg = 0; reg < 4; ++reg) { const int sidx = 16 * (NT) + 4 * q4 + reg; const float w = (sidx <= t) ? fexp(fminf(R4[reg] - MU, 0.f)) : 0.f; p[reg] = s[reg] * w; psum += p[reg]; } \
                u32x2 w2; w2.x = pk2(p[0], p[1]); w2.y = pk2(p[2], p[3]); \
                *(LAS u32x2*)(lds + ML_P + sw64(t, (16 * (NT) + 4 * q4) * 2)) = w2; \
                psum += __shfl_xor(psum, 16); psum += __shfl_xor(psum, 32); \
                if (q4 == 0) atomicAdd((float*)(scc + SC_DEN + t), psum); }
#pragma unroll
            for (int ks = 0; ks < 4; ++ks) cb[ks] = *(const LAS bf16x8*)(lds + ML_CB + sw128(16 * wave + r16, (32 * ks + 8 * q4) * 2));
            ML_LDQ(qa0, 0)
            ML_LDQ(qa1, 1)
            ML_LDS_(mt1, nt1)
            const float mu1 = scc[SC_MU + 16 * mt1 + r16]; const f32x4 r41 = *(const LAS f32x4*)(scc + SC_R + 16 * nt1 + 4 * q4);
#pragma unroll
            for (int mt = 0; mt < 4; ++mt) num[mt] = (f32x4){0.f, 0.f, 0.f, 0.f};
            __builtin_amdgcn_sched_barrier(0);
            ML_MMQ(qa0, 0)
            ML_LDQ(qa0, 2)
            __builtin_amdgcn_sched_barrier(0);
            ML_MMQ(qa1, 1)
            ML_LDQ(qa1, 3)
            __builtin_amdgcn_sched_barrier(0);
            ML_STILE(mt1, nt1, mu1, r41)
            ML_MMQ(qa0, 2)
            __builtin_amdgcn_sched_barrier(0);
            ML_MMQ(qa1, 3)
            if (wave < 2) {
                ML_LDS_(3, 2 + wave)
                const float mu2 = scc[SC_MU + 48 + r16]; const f32x4 r42 = *(const LAS f32x4*)(scc + SC_R + 16 * (2 + wave) + 4 * q4);
                ML_STILE(3, 2 + wave, mu2, r42)
            }
#undef ML_LDQ
#undef ML_MMQ
#undef ML_LDS_
#undef ML_STILE
            { const int t = tidv >> 3, part = tidv & 7; float s = 0.f;
              const u32x4 qa = *(const LAS u32x4*)(lds + ML_QS + sw128(t, part * 32)), qb = *(const LAS u32x4*)(lds + ML_QS + sw128(t, part * 32 + 16));
              const u32x4 na = *(const LAS u32x4*)((const LAS unsigned char*)(sc + SC_NB) + part * 32), nb = *(const LAS u32x4*)((const LAS unsigned char*)(sc + SC_NB) + part * 32 + 16);
              s = dot2bf(qa.x, na.x, s); s = dot2bf(qa.y, na.y, s); s = dot2bf(qa.z, na.z, s); s = dot2bf(qa.w, na.w, s);
              s = dot2bf(qb.x, nb.x, s); s = dot2bf(qb.y, nb.y, s); s = dot2bf(qb.z, nb.z, s); s = dot2bf(qb.w, nb.w, s);
              s += __shfl_xor(s, 1); s += __shfl_xor(s, 2); s += __shfl_xor(s, 4);
              if (part == 0) scc[SC_NQ + t] = s; }
        }
        __syncthreads();
        {
            bf16x8 vt[2], pf[4][2], kt0[4][2], kt1[4][2]; float wi[4], dn[4], nqv[4], me[4];
#pragma unroll
            for (int ks = 0; ks < 2; ++ks) vt[ks] = *(const LAS bf16x8*)(lds + ML_VT + sw64(16 * wave + r16, (32 * ks + 8 * q4) * 2));
#pragma unroll
            for (int mt = 0; mt < 4; ++mt) {
#pragma unroll
                for (int ks = 0; ks < 2; ++ks) pf[mt][ks] = *(const LAS bf16x8*)(lds + ML_P + sw64(16 * mt + r16, (32 * ks + 8 * q4) * 2));
                const int t = 16 * mt + r16; wi[mt] = scc[SC_WI + t]; dn[mt] = scc[SC_DEN + t]; nqv[mt] = scc[SC_NQ + t]; me[mt] = scc[SC_ME + t]; }
            const float decay = scc[SC_DEC];
#pragma unroll
            for (int nt = 0; nt < 4; ++nt)
#pragma unroll
                for (int ks = 0; ks < 2; ++ks) kt0[nt][ks] = *(const LAS bf16x8*)(lds + ML_KT + sw64(16 * nt + r16, (32 * ks + 8 * q4) * 2));
            __builtin_amdgcn_sched_barrier(0);
#pragma unroll
            for (int mt = 0; mt < 4; ++mt) {
                const int t = 16 * mt + r16;
                num[mt] = num[mt] * wi[mt];
#pragma unroll
                for (int ks = 0; ks < 2; ++ks) num[mt] = MFMA16(vt[ks], pf[mt][ks], num[mt]);
                const float den = dn[mt] + wi[mt] * nqv[mt], inv = frcp(fmaxf(fabsf(den), me[mt]));
                const int lp = p0 + t, pos = dir ? (SEQ - 1 - lp) : lp;
                u32x2 w2; w2.x = pk2(num[mt][0] * inv, num[mt][1] * inv); w2.y = pk2(num[mt][2] * inv, num[mt][3] * inv);
                *(u32x2*)(HO + (size_t)pos * 512 + 16 * wave + 4 * q4) = w2;
            }
#pragma unroll
            for (int nt = 0; nt < 4; ++nt)
#pragma unroll
                for (int ks = 0; ks < 2; ++ks) kt1[nt][ks] = *(const LAS bf16x8*)(lds + ML_KT + sw64(16 * (nt + 4) + r16, (32 * ks + 8 * q4) * 2));
            __builtin_amdgcn_sched_barrier(0);
#pragma unroll
            for (int nt = 0; nt < 4; ++nt) {
                accC[nt] = accC[nt] * decay;
#pragma unroll
                for (int ks = 0; ks < 2; ++ks) accC[nt] = MFMA16(kt0[nt][ks], vt[ks], accC[nt]);
                u32x2 w2; w2.x = pk2(accC[nt][0], accC[nt][1]); w2.y = pk2(accC[nt][2], accC[nt][3]);
                *(LAS u32x2*)(lds + ML_CB + sw128(16 * wave + r16, (16 * nt + 4 * q4) * 2)) = w2;
            }
            __builtin_amdgcn_sched_barrier(0);
#pragma unroll
            for (int nt = 4; nt < 8; ++nt) {
                accC[nt] = accC[nt] * decay;
#pragma unroll
                for (int ks = 0; ks < 2; ++ks) accC[nt] = MFMA16(kt1[nt - 4][ks], vt[ks], accC[nt]);
                u32x2 w2; w2.x = pk2(accC[nt][0], accC[nt][1]); w2.y = pk2(accC[nt][2], accC[nt][3]);
                *(LAS u32x2*)(lds + ML_CB + sw128(16 * wave + r16, (16 * nt + 4 * q4) * 2)) = w2;
            }
            if (tidv < 128) { float s = 0.f; const unsigned ones = 0x3f803f80u;
#pragma unroll
                for (int j = 0; j < 8; ++j) { const u32x4 kv = *(const LAS u32x4*)(lds + ML_KT + sw64(tidv, j * 16));
                    s = dot2bf(kv.x, ones, s); s = dot2bf(kv.y, ones, s); s = dot2bf(kv.z, ones, s); s = dot2bf(kv.w, ones, s); }
                const float nn = decay * sc[SC_N + tidv] + s; sc[SC_N + tidv] = nn;
                ((LAS bf16*)(sc + SC_NB))[tidv] = (bf16)(pk2(nn, 0.f) & 0xffffu); }
#pragma unroll
            for (int i = 0; i < 2; ++i) { const int idx = tidv + NTHREADS * i, lr = idx >> 4, cc = idx & 15;
                *(LAS u32x4*)(lds + ML_XM + xsw(lr, cc)) = pxm[i]; *(LAS u32x4*)(lds + ML_XC + xsw(lr, cc)) = pxc[i]; }
            if (wave == 0) { scn[SC_R + lanev] = pg0[0]; scn[SC_MU + lanev] = pg0[1]; scn[SC_WI + lanev] = pg0[2]; scn[SC_ME + lanev] = pg0[3]; scn[SC_WS + lanev] = pg1[0]; scn[SC_DEN + lanev] = 0.f;
                if (lanev == 0) scn[SC_DEC] = pg1[1]; }
        }
        __syncthreads();
    }
    __builtin_amdgcn_s_setprio(0);
}

__device__ __forceinline__ void ml_combine(const Args& a, unsigned char* ws, int gw, int NGW, int lane) {
    const bf16* HF = (const bf16*)(ws + WS_HF); const bf16* HB = (const bf16*)(ws + WS_HB); const bf16* XCg = (const bf16*)(ws + WS_XC); const bf16* OP = (const bf16*)(ws + WS_OP);
    bf16* YC = (bf16*)(ws + WS_YCAT);
    const int col = 8 * lane;
    float hn[8], sk[8];
#pragma unroll
    for (int e = 0; e < 8; ++e) { hn[e] = a.in[I_HNORM][col + e]; sk[e] = a.in[I_SKIP][col + e]; }
    for (int grp = gw; grp < MTOK / 4; grp += NGW) {
        u32x4 hf[4], hb[4], ov[4], xc[4];
#pragma unroll
        for (int r = 0; r < 4; ++r) { const size_t o = (size_t)(grp * 4 + r) * 512 + col; hf[r] = *(const u32x4*)(HF + o); hb[r] = *(const u32x4*)(HB + o); ov[r] = *(const u32x4*)(OP + o); xc[r] = *(const u32x4*)(XCg + o); }
#pragma unroll
        for (int r = 0; r < 4; ++r) {
            float hv[8] = {bflo(hf[r].x) + bflo(hb[r].x), bfhi(hf[r].x) + bfhi(hb[r].x), bflo(hf[r].y) + bflo(hb[r].y), bfhi(hf[r].y) + bfhi(hb[r].y), bflo(hf[r].z) + bflo(hb[r].z), bfhi(hf[r].z) + bfhi(hb[r].z), bflo(hf[r].w) + bflo(hb[r].w), bfhi(hf[r].w) + bfhi(hb[r].w)};
            float sm = 0.f;
#pragma unroll
            for (int e = 0; e < 8; ++e) sm += hv[e];
            sm += __shfl_xor(sm, 1); sm += __shfl_xor(sm, 2); sm += __shfl_xor(sm, 4); sm += __shfl_xor(sm, 8);
            const float mean = sm * (1.f / DH); float vs = 0.f;
#pragma unroll
            for (int e = 0; e < 8; ++e) { hv[e] -= mean; vs += hv[e] * hv[e]; }
            vs += __shfl_xor(vs, 1); vs += __shfl_xor(vs, 2); vs += __shfl_xor(vs, 4); vs += __shfl_xor(vs, 8);
            const float rstd = __builtin_amdgcn_rsqf(vs * (1.f / DH) + EPS);
            const float og[8] = {bflo(ov[r].x), bfhi(ov[r].x), bflo(ov[r].y), bfhi(ov[r].y), bflo(ov[r].z), bfhi(ov[r].z), bflo(ov[r].w), bfhi(ov[r].w)};
            const float xg[8] = {bflo(xc[r].x), bfhi(xc[r].x), bflo(xc[r].y), bfhi(xc[r].y), bflo(xc[r].z), bfhi(xc[r].z), bflo(xc[r].w), bfhi(xc[r].w)};
            float o[8];
#pragma unroll
            for (int e = 0; e < 8; ++e) o[e] = sigmoidf_(og[e]) * (hv[e] * rstd * hn[e] + sk[e] * xg[e]);
            u32x4 w; w.x = pk2(o[0], o[1]); w.y = pk2(o[2], o[3]); w.z = pk2(o[4], o[5]); w.w = pk2(o[6], o[7]);
            *(u32x4*)(YC + (size_t)(grp * 4 + r) * 1024 + 512 + col) = w;
        }
    }
}

__global__ void __launch_bounds__(NTHREADS, 2) hyb_fwd(Args args) {
    extern __shared__ __attribute__((aligned(16))) unsigned char lds_raw[];
    LAS unsigned char* lds = (LAS unsigned char*)lds_raw;
    volatile LAS unsigned* MISC = (volatile LAS unsigned*)(lds + MISC_OFF);
    const int tid = threadIdx.x, lane = tid & 63, wave = __builtin_amdgcn_readfirstlane(tid >> 6);
    const int G = gridDim.x, bx = blockIdx.x, vcu = (G % 8 == 0) ? (bx % 8) * (G / 8) + bx / 8 : bx;
    const int gw = vcu * NWAVES + wave, NGW = G * NWAVES;
    unsigned char* ws = args.ws;
    for (int u = tid; u < (LDS_BYTES - MISC_OFF) / 4; u += NTHREADS) ((LAS unsigned*)(lds + MISC_OFF))[u] = 0u;
    __syncthreads();
    const int lo = args.ph_lo, hi = args.ph_hi;
    const bool one = (hi - lo) > 1;
    XcdBarrier bar; bar.bar = (unsigned*)(ws + WS_CTL) + CW_BAR; bar.x = 0; bar.st = nullptr;
    if (one) bar = xcd_barrier_post((unsigned*)(ws + WS_CTL) + CW_BAR, MISC + 8);
#define IN(k) (lo <= (k) && (k) < hi)
#define SEAM(k) do { if (one) xcd_barrier(bar); } while (0)

    if (IN(0)) { p0_prologue(args, ws, lds, tid, wave, lane, vcu, G); SEAM(0); }
    if (IN(1)) {
        pg8::Gemm g{(const bf16*)(ws + WS_XB), (const bf16*)(ws + WS_WIN), DM, DM, DM}; pg8::StaticOrder S; S.init(MTOK, NPROJ, G, bx);
        pg8::EpiP1 E{(const float*)(ws + WS_RS1), (bf16*)(ws + WS_UX), (bf16*)(ws + WS_XM), (bf16*)(ws + WS_OP)};
        pg8::gemm_phase<pg8::EpiP1, pg8::StaticOrder, true>(lds, g, S, E);
        SEAM(1);
    }
    if (IN(2)) {
        if (G == 256) {
            { pg8::Gemm g{(const bf16*)(ws + WS_UX), (const bf16*)(ws + WS_MZ), 512, 256, 256}; pg8::S5One S{bx}; pg8::EpiZL E{};
              pg8::gemm_phase<pg8::EpiZL, pg8::S5One, true, true>(lds, g, S, E); }
            __syncthreads();
            s5_scan_lds(args, ws, lds, bx, tid);
            __syncthreads();
            { pg8::Gemm g{(const bf16*)(ws + WS_UX), (const bf16*)(ws + WS_MZ), 512, 256, 256}; pg8::S5One S{G + bx}; pg8::EpiZL E{};
              pg8::gemm_phase<pg8::EpiZL, pg8::S5One, true, true>(lds, g, S, E); }
            __syncthreads();
            s5_scan_lds(args, ws, lds, G + bx, tid);
            VM_WAIT(); __syncthreads();
        } else {
            { pg8::Gemm g{(const bf16*)(ws + WS_UX), (const bf16*)(ws + WS_MZ), 512, 256, 256}; pg8::S5Order S{G, bx}; pg8::EpiZ E{(bf16*)(ws + WS_ZB)};
              pg8::gemm_phase<pg8::EpiZ, pg8::S5Order, true>(lds, g, S, E); }
            VM_WAIT(); __syncthreads();
            s5_scan(args, ws, tid, G);
            VM_WAIT(); __syncthreads();
        }
        { pg8::Gemm g{(const bf16*)(ws + WS_UX), (const bf16*)(ws + WS_TMY), 512, 512, 512}; pg8::S5Order S{G, bx}; pg8::EpiY E{(bf16*)(ws + WS_YACT)};
          pg8::gemm_phase<pg8::EpiY, pg8::S5Order, true>(lds, g, S, E); }
        ml_pre(args, ws, lds, gw, NGW, wave, lane, G);
        SEAM(2);
    }
    if (IN(3)) {
        { pg8::Gemm g{(const bf16*)(ws + WS_YACT), (const bf16*)(ws + WS_WGLU), 512, 512, 512}; pg8::StaticOrder S; S.init(MTOK, 512, G, bx);
          pg8::EpiGLU E{(const bf16*)(ws + WS_YACT), args.in[I_BGLU], (bf16*)(ws + WS_YCAT)};
          pg8::gemm_phase<pg8::EpiGLU, pg8::StaticOrder, true>(lds, g, S, E); }
        __syncthreads();
        for (int cid = bx; cid < BATCH * NH * 2; cid += G) mlstm_chain(args, ws, lds, cid, tid, wave, lane);
        SEAM(3);
    }
    if (IN(4)) { ml_combine(args, ws, gw, NGW, lane); SEAM(4); }
    if (IN(5)) { }
    unsigned* const ctlw = (unsigned*)(ws + WS_CTL);
    if (IN(6)) {
        pg8::Gemm g{(const bf16*)(ws + WS_YCAT), (const bf16*)(ws + WS_WOUT), DM, DM, DM}; pg8::StaticOrder S; S.init(MTOK, DM, G, bx);
        pg8::PanelSS s1{(unsigned long long*)(ws + WS_XS), ctlw + CW_TMO};
        pg8::EpiMid E{(bf16*)(ws + WS_XB), args.in[I_NMPOST], (float*)(ws + WS_RS2), s1};
        pg8::gemm_phase<pg8::EpiMid, pg8::StaticOrder, true>(lds, g, S, E);
        SEAM(6);
    }
    if (IN(8)) {
        { pg8::Gemm g{(const bf16*)(ws + WS_XB), (const bf16*)(ws + WS_WGU), DM, DM, DM}; pg8::PassOrder S; S.init(MTOK, G, bx);
          pg8::EpiGU E{(const float*)(ws + WS_RS2), (bf16*)(ws + WS_ACT), 0};
          pg8::gemm_phase<pg8::EpiGU, pg8::PassOrder, true>(lds, g, S, E); }
        SEAM(8);
    }
    if (IN(9)) {
        pg8::Gemm g{(const bf16*)(ws + WS_ACT), (const bf16*)(ws + WS_WDN), DFF, DFF, DFF}; pg8::StaticOrder S; S.init(MTOK, DM, G, bx);
        pg8::PanelSS s3{(unsigned long long*)(ws + WS_XS) + (size_t)MTOK * 8, ctlw + CW_TMO};
        pg8::EpiOut E{(const bf16*)(ws + WS_XB), args.in[I_NFPOST], args.out, s3};
        pg8::gemm_phase<pg8::EpiOut, pg8::StaticOrder, true>(lds, g, S, E);
    }
#undef IN
#undef SEAM
}

extern "C" void kernel_launch(void* const* d_in, const int* in_sizes, int n_in, void* d_out, int out_size, void* d_ws, size_t ws_size, hipStream_t stream) {
    static int grid = 0;
    if (grid == 0) {
        if (n_in != 28 || in_sizes[0] != MTOK * DM || out_size != MTOK * DM || ws_size < WS_END) { fprintf(stderr, "kernel_launch: unexpected shapes (n_in %d, in0 %d, out %d, ws %zu); nothing launched\n", n_in, n_in > 0 ? in_sizes[0] : -1, out_size, ws_size); grid = -1; return; }
        int dev = 0, cus = 0;
        if (hipGetDevice(&dev) != hipSuccess || hipDeviceGetAttribute(&cus, hipDeviceAttributeMultiprocessorCount, dev) != hipSuccess) { grid = -1; return; }
        if (hipFuncSetAttribute((const void*)hyb_fwd, hipFuncAttributeMaxDynamicSharedMemorySize, LDS_BYTES) != hipSuccess) { fprintf(stderr, "kernel_launch: hipFuncSetAttribute failed\n"); grid = -1; return; }
        int per_cu = 0;
        if (hipOccupancyMaxActiveBlocksPerMultiprocessor(&per_cu, (const void*)hyb_fwd, NTHREADS, LDS_BYTES) != hipSuccess || per_cu < 1) fprintf(stderr, "kernel_launch: occupancy query reports %d\n", per_cu);
        (void)hipGetLastError();
        if (cus < 256) { fprintf(stderr, "kernel_launch: built for a 256-CU device (got %d CUs); nothing launched\n", cus); grid = -1; return; }
        grid = 256;
    }
    if (grid < 0) return;
    (void)hipMemsetAsync((char*)d_ws + WS_CTL, 0, CTL_ZERO_BYTES, stream);
    Args a{};
    for (int i = 0; i < 28; ++i) a.in[i] = (const float*)d_in[i];
    a.out = (float*)d_out; a.ws = (unsigned char*)d_ws; a.pad0 = 0; a.pad1 = 0;
    a.ph_lo = 0; a.ph_hi = N_PHASES;
    hipLaunchKernelGGL(hyb_fwd, dim3(grid), dim3(NTHREADS), LDS_BYTES, stream, a);
}
```

```cpp
#include <hip/hip_runtime.h>
#include <cstdio>
#include <cstdint>


#define GAS __attribute__((address_space(1)))
#define LAS __attribute__((address_space(3)))
typedef unsigned short bf16;
typedef short bf16x8 __attribute__((ext_vector_type(8)));
typedef float f32x4 __attribute__((ext_vector_type(4)));
typedef float f32x2 __attribute__((ext_vector_type(2)));
typedef unsigned u32x4 __attribute__((ext_vector_type(4)));
typedef unsigned u32x2 __attribute__((ext_vector_type(2)));
typedef __bf16 bf16x2_t __attribute__((ext_vector_type(2)));
typedef GAS unsigned gu32;

constexpr int BATCH = 32, SEQ = 2048, DM = 1024, MTOK = BATCH * SEQ;
constexpr int D_S5 = 512, D_ML = 512, NG = 32, GC = 16, SP = 64, NH = 4, DH = 128, D_IN = 1552, DFF = 2816, NPROJ = 1536;
constexpr int S5L = 16, S5NCH = SEQ / S5L, S5ROWS = BATCH * S5NCH;
constexpr float EPS = 1e-6f;
constexpr int NWAVES = 8, NTHREADS = 512;
constexpr int N_PHASES = 11;

constexpr size_t MiB = 1u << 20;
constexpr size_t WS_CTL = 0, CTL_ZERO_BYTES = 32 * 1024;
constexpr size_t WS_WIN = 1 * MiB;
constexpr size_t WS_WGLU = 4 * MiB;
constexpr size_t WS_WQKV = 5 * MiB;
constexpr size_t WS_WOUT = 6 * MiB;
constexpr size_t WS_WGU = 8 * MiB;
constexpr size_t WS_WDN = 19 * MiB;
constexpr size_t WS_MZ = 25 * MiB;
constexpr size_t WS_TMY = 29 * MiB;
constexpr size_t WS_RS1 = 37 * MiB;
constexpr size_t WS_RS2 = 48 * MiB;
constexpr size_t WS_GATES = 38 * MiB;
constexpr size_t WS_XS = 42 * MiB;
constexpr size_t WS_XB = 64 * MiB;
constexpr size_t WS_UX = 192 * MiB;
constexpr size_t WS_XM = 320 * MiB;
constexpr size_t WS_OP = 384 * MiB;
constexpr size_t WS_ZB = 448 * MiB;
constexpr size_t WS_YACT = 512 * MiB;
constexpr size_t WS_HF = 576 * MiB;
constexpr size_t WS_HB = 640 * MiB;
constexpr size_t WS_YCAT = 704 * MiB;
constexpr size_t WS_ACT = 192 * MiB;
constexpr size_t WS_XC = 832 * MiB;
constexpr size_t WS_GS = 896 * MiB;
constexpr size_t WS_END = 960 * MiB;
constexpr int CW_TMO = 0, CW_BAR = 4096;
constexpr int CW_PANEL = 16384, PANEL_BANK = 256 * 64;

constexpr int MISC_OFF = 162816;
constexpr int LDS_BYTES = 163840;

__device__ __forceinline__ unsigned pk2(float lo, float hi) { f32x2 v = {lo, hi}; bf16x2_t b = __builtin_convertvector(v, bf16x2_t); return __builtin_bit_cast(unsigned, b); }
__device__ __forceinline__ float bflo(unsigned u) { return __builtin_bit_cast(float, u << 16); }
__device__ __forceinline__ float bfhi(unsigned u) { return __builtin_bit_cast(float, u & 0xffff0000u); }
__device__ __forceinline__ float bf2f(bf16 h) { return __builtin_bit_cast(float, (unsigned)h << 16); }
__device__ __forceinline__ float fexp(float x) { return __expf(x); }
__device__ __forceinline__ float frcp(float x) { return __builtin_amdgcn_rcpf(x); }
__device__ __forceinline__ float sigmoidf_(float z) { return frcp(1.f + fexp(-z)); }
__device__ __forceinline__ float siluf_(float z) { return z * frcp(1.f + fexp(-z)); }
__device__ __forceinline__ float gelu_tanh(float y) { const float t = 1.5957691216057308f * (y + 0.044715f * y * y * y); return y * frcp(1.f + fexp(-t)); }
__device__ __forceinline__ float wave_sum(float v) {
#pragma unroll
    for (int o = 1; o < 64; o <<= 1) v += __shfl_xor(v, o);
    return v;
}
#define LDS_WAIT() asm volatile("s_waitcnt lgkmcnt(0)" ::: "memory")
#define VM_WAIT() asm volatile("s_waitcnt vmcnt(0)" ::: "memory")

namespace pg8 {
constexpr int BM = 256, BK = 64, HALF = 128, HTB = HALF * BK * 2, STAGE_BYTES = 8 * HTB, NXCD = 8, WGM = 4;
__host__ __device__ __forceinline__ int lds_byte(int r, int c) { const int st = (r >> 4) * 2 + (c >> 5), rr = r & 15, cc = c & 31, ob = rr * 64 + cc * 2; return st * 1024 + (ob ^ (((ob >> 9) & 1) << 5)); }
__host__ __device__ __forceinline__ void stage_rc(int b, int& R, int& C) { const int st = b / 1024, sb = b % 1024, swz = sb ^ (((sb >> 9) & 1) << 5); R = (st >> 1) * 16 + swz / 64; C = (st & 1) * 32 + (swz % 64) / 2; }
__host__ __device__ __forceinline__ int perm32(int rho) { const int n = rho >> 4, i = rho & 15; return 8 * (i >> 2) + 4 * n + (i & 3); }

struct Unit { int pm, pn; };
struct Gemm { const bf16* A; const bf16* Bt; int lda, ldb, K; };

struct StaticOrder {
    int nig, nwg, G, qq, rr; int gid, rem, L;
    __device__ void init(int M, int N, int G_, int c_) {
        const int nN = N / BM; nwg = (M / BM) * nN; G = G_; nig = WGM * nN;
        const int w0 = (c_ % NXCD) * (nwg / NXCD) + c_ / NXCD, st = G_ / NXCD; gid = w0 / nig; rem = w0 % nig; qq = st / nig; rr = st % nig; L = c_; }
    __device__ __forceinline__ bool next(int, Unit& u) {
        if (L >= nwg) return false;
        u.pm = gid * WGM + (rem & (WGM - 1)); u.pn = rem / WGM; L += G; gid += qq; rem += rr; if (rem >= nig) { rem -= nig; ++gid; } return true; }
    __device__ __forceinline__ void a_ready(const Unit&) const {}
    __device__ __forceinline__ void done(const Unit&) const {}
};
struct PassOrder {
    StaticOrder so; int M, G, c, p, pn0;
    __device__ static __forceinline__ int nn(int p) { return p < 2 ? 6 : 5; }
    __device__ void init(int M_, int G_, int c_) { M = M_; G = G_; c = c_; p = 0; pn0 = 0; so.init(M, nn(0) * BM, G, c); }
    __device__ __forceinline__ bool next(int i, Unit& u) {
        if (!so.next(i, u)) { if (p == 3) return false; pn0 += nn(p); ++p; so.init(M, nn(p) * BM, G, c); (void)so.next(0, u); }
        u.pn += pn0; return true; }
    __device__ __forceinline__ void a_ready(const Unit&) const {}
    __device__ __forceinline__ void done(const Unit&) const {}
};
struct S5Order {
    int G, c;
    __device__ __forceinline__ bool next(int i, Unit& u) const { const int L = i * G + c; if (L >= NG * 16) return false; u.pm = L; u.pn = L >> 4; return true; }
    __device__ __forceinline__ void a_ready(const Unit&) const {}
    __device__ __forceinline__ void done(const Unit&) const {}
};

__device__ __forceinline__ u32x4 pack8(f32x4 v0, f32x4 v1) { u32x4 w; w.x = pk2(v0[0], v0[1]); w.y = pk2(v0[2], v0[3]); w.z = pk2(v1[0], v1[1]); w.w = pk2(v1[2], v1[3]); return w; }

struct EpiP1 {
    static constexpr bool PEEL = true, PERM = true, AFTER_DRAIN = false; static constexpr int NS = 16;
    const float* rs1; bf16* UX; bf16* XM; bf16* OP;
    __device__ __forceinline__ void pre(const Unit& u, LAS unsigned char* xlds, int tid) const {
        if (tid < 64) __builtin_amdgcn_global_load_lds((const unsigned*)(rs1 + (size_t)u.pm * BM + tid * 4), (LAS unsigned*)xlds, 16, 0, 0); }
    __device__ __forceinline__ void operator()(const f32x4 (&acc)[2][2][4][2], const Unit& u, int wr, int wc, int fr, int fq, const LAS unsigned char* xlds) const {
#pragma unroll
        for (int ai = 0; ai < 2; ++ai)
#pragma unroll
            for (int m = 0; m < 4; ++m) {
                const int row = u.pm * BM + ai * HALF + wr * 64 + m * 16 + fr; const float s = ((const LAS float*)xlds)[ai * HALF + wr * 64 + m * 16 + fr];
#pragma unroll
                for (int bj = 0; bj < 2; ++bj) {
                    const int col = u.pn * BM + bj * HALF + wc * 32 + 8 * fq;
                    const u32x4 w = pack8(acc[ai][bj][m][0] * s, acc[ai][bj][m][1] * s);
                    bf16* dst;
                    if (u.pn < 2) { const int g = col >> 4, c0 = col & 15, b = row >> 11, si = row & 2047, k = si >> 4, t = si & 15;
                        dst = UX + ((size_t)(g * S5ROWS + b * S5NCH + k) * 512 + t * 16 + c0); }
                    else if (u.pn < 4) dst = XM + (size_t)row * 512 + (col - 512);
                    else dst = OP + (size_t)row * 512 + (col - 1024);
                    *(u32x4*)dst = w;
                }
            }
    }
};
struct EpiZ {
    __device__ __forceinline__ void pre(const Unit&, LAS unsigned char*, int) const {}
    static constexpr bool PEEL = false, PERM = true, AFTER_DRAIN = false; static constexpr int NS = 16;
    bf16* Z;
    __device__ __forceinline__ void operator()(const f32x4 (&acc)[2][2][4][2], const Unit& u, int wr, int wc, int fr, int fq, const LAS unsigned char* xlds) const {
#pragma unroll
        for (int ai = 0; ai < 2; ++ai)
#pragma unroll
            for (int m = 0; m < 4; ++m) {
                const size_t row = (size_t)u.pm * BM + ai * HALF + wr * 64 + m * 16 + fr;
#pragma unroll
                for (int bj = 0; bj < 2; ++bj) { const int col = bj * HALF + wc * 32 + 8 * fq; *(u32x4*)(Z + row * 256 + col) = pack8(acc[ai][bj][m][0], acc[ai][bj][m][1]); }
            }
    }
};
constexpr int ZLP = 528;
struct EpiZL {
    __device__ __forceinline__ void pre(const Unit&, LAS unsigned char*, int) const {}
    static constexpr bool PEEL = false, PERM = true, AFTER_DRAIN = false; static constexpr int NS = 0;
    __device__ __forceinline__ void operator()(const f32x4 (&acc)[2][2][4][2], const Unit& u, int wr, int wc, int fr, int fq, const LAS unsigned char* xlds) const {
        LAS unsigned char* zl = const_cast<LAS unsigned char*>(xlds) - STAGE_BYTES;
#pragma unroll
        for (int ai = 0; ai < 2; ++ai)
#pragma unroll
            for (int m = 0; m < 4; ++m) { const int row = ai * HALF + wr * 64 + m * 16 + fr;
#pragma unroll
                for (int bj = 0; bj < 2; ++bj) { const int col = bj * HALF + wc * 32 + 8 * fq; *(LAS u32x4*)(zl + row * ZLP + col * 2) = pack8(acc[ai][bj][m][0], acc[ai][bj][m][1]); } }
    }
};
struct S5One {
    int L;
    __device__ __forceinline__ bool next(int i, Unit& u) const { if (i != 0) return false; u.pm = L; u.pn = L >> 4; return true; }
    __device__ __forceinline__ void a_ready(const Unit&) const {}
    __device__ __forceinline__ void done(const Unit&) const {}
};
struct EpiY {
    __device__ __forceinline__ void pre(const Unit&, LAS unsigned char*, int) const {}
    static constexpr bool PEEL = true, PERM = true, AFTER_DRAIN = false; static constexpr int NS = 16;
    bf16* YACT;
    __device__ __forceinline__ void operator()(const f32x4 (&acc)[2][2][4][2], const Unit& u, int wr, int wc, int fr, int fq, const LAS unsigned char* xlds) const {
        const int g = u.pm >> 4;
#pragma unroll
        for (int ai = 0; ai < 2; ++ai)
#pragma unroll
            for (int m = 0; m < 4; ++m) {
                const int R = u.pm * BM + ai * HALF + wr * 64 + m * 16 + fr, rr = R & (S5ROWS - 1), b = rr >> 7, k = rr & 127;
#pragma unroll
                for (int bj = 0; bj < 2; ++bj) { const int colt = bj * HALF + wc * 32 + 8 * fq, t = colt >> 4, c0 = colt & 15;
                    const size_t token = (size_t)b * SEQ + k * S5L + t;
                    f32x4 v0 = acc[ai][bj][m][0], v1 = acc[ai][bj][m][1];
#pragma unroll
                    for (int e = 0; e < 4; ++e) { v0[e] = gelu_tanh(v0[e]); v1[e] = gelu_tanh(v1[e]); }
                    *(u32x4*)(YACT + token * 512 + g * 16 + c0) = pack8(v0, v1); }
            }
    }
};
struct EpiGLU {
    __device__ __forceinline__ void pre(const Unit&, LAS unsigned char*, int) const {}
    static constexpr bool PEEL = true, PERM = true, AFTER_DRAIN = false; static constexpr int NS = 16;
    const bf16* YACT; const float* bglu; bf16* YCAT;
    __device__ __forceinline__ void operator()(const f32x4 (&acc)[2][2][4][2], const Unit& u, int wr, int wc, int fr, int fq, const LAS unsigned char* xlds) const {
        u32x4 ya[2][2][4]; f32x4 bb[2][2];
        const size_t row0 = (size_t)u.pm * BM + wr * 64 + fr; const int col0 = u.pn * BM + wc * 32 + 8 * fq;
#pragma unroll
        for (int bj = 0; bj < 2; ++bj) { bb[bj][0] = *(const f32x4*)(bglu + col0 + bj * HALF); bb[bj][1] = *(const f32x4*)(bglu + col0 + bj * HALF + 4);
#pragma unroll
            for (int ai = 0; ai < 2; ++ai)
#pragma unroll
                for (int m = 0; m < 4; ++m) ya[bj][ai][m] = *(const u32x4*)(YACT + (row0 + ai * HALF + m * 16) * 512 + col0 + bj * HALF); }
#pragma unroll
        for (int bj = 0; bj < 2; ++bj)
#pragma unroll
            for (int ai = 0; ai < 2; ++ai)
#pragma unroll
                for (int m = 0; m < 4; ++m) {
                    const u32x4 y = ya[bj][ai][m];
                    const f32x4 z0 = acc[ai][bj][m][0] + bb[bj][0], z1 = acc[ai][bj][m][1] + bb[bj][1]; f32x4 o0, o1;
                    o0[0] = bflo(y.x) * sigmoidf_(z0[0]); o0[1] = bfhi(y.x) * sigmoidf_(z0[1]); o0[2] = bflo(y.y) * sigmoidf_(z0[2]); o0[3] = bfhi(y.y) * sigmoidf_(z0[3]);
                    o1[0] = bflo(y.z) * sigmoidf_(z1[0]); o1[1] = bfhi(y.z) * sigmoidf_(z1[1]); o1[2] = bflo(y.w) * sigmoidf_(z1[2]); o1[3] = bfhi(y.w) * sigmoidf_(z1[3]);
                    *(u32x4*)(YCAT + (row0 + ai * HALF + m * 16) * 1024 + col0 + bj * HALF) = pack8(o0, o1);
                }
    }
};
struct EpiPlain {
    __device__ __forceinline__ void pre(const Unit&, LAS unsigned char*, int) const {}
    static constexpr bool PEEL = false, PERM = true, AFTER_DRAIN = false; static constexpr int NS = 16;
    bf16* O; int ldc;
    __device__ __forceinline__ void operator()(const f32x4 (&acc)[2][2][4][2], const Unit& u, int wr, int wc, int fr, int fq, const LAS unsigned char* xlds) const {
#pragma unroll
        for (int ai = 0; ai < 2; ++ai)
#pragma unroll
            for (int m = 0; m < 4; ++m) {
                const size_t row = (size_t)u.pm * BM + ai * HALF + wr * 64 + m * 16 + fr;
#pragma unroll
                for (int bj = 0; bj < 2; ++bj) { const int col = u.pn * BM + bj * HALF + wc * 32 + 8 * fq; *(u32x4*)(O + row * ldc + col) = pack8(acc[ai][bj][m][0], acc[ai][bj][m][1]); }
            }
    }
};
struct EpiNull {
    __device__ __forceinline__ void pre(const Unit&, LAS unsigned char*, int) const {}
    static constexpr bool PEEL = false, PERM = true, AFTER_DRAIN = false; static constexpr int NS = 0;
    __device__ __forceinline__ void operator()(const f32x4 (&acc)[2][2][4][2], const Unit& u, int wr, int wc, int fr, int fq, const LAS unsigned char* xlds) const {
#pragma unroll
        for (int ai = 0; ai < 2; ++ai)
#pragma unroll
            for (int bj = 0; bj < 2; ++bj)
#pragma unroll
                for (int m = 0; m < 4; ++m)
#pragma unroll
                    for (int n = 0; n < 2; ++n) asm volatile("" :: "v"(acc[ai][bj][m][n]));
    }
};
struct PanelSS {
    unsigned long long* slots;
    unsigned* tmo;
    template <class F> __device__ __forceinline__ bool run(const f32x4 (&v)[2][2][4][2], const Unit& u, int wr, int wc, int fr, int fq, LAS unsigned char* xl, F mid) const {
        LAS float* P = (LAS float*)(xl + 4096); LAS float* S = (LAS float*)(xl + 8192);
        const int wid = wr * 4 + wc, lane = fq * 16 + fr;
#pragma unroll
        for (int ai = 0; ai < 2; ++ai)
#pragma unroll
            for (int m = 0; m < 4; ++m) {
                float q = 0.f;
#pragma unroll
                for (int bj = 0; bj < 2; ++bj)
#pragma unroll
                    for (int n = 0; n < 2; ++n) { const f32x4 x = v[ai][bj][m][n]; q += (x[0] * x[0] + x[1] * x[1]) + (x[2] * x[2] + x[3] * x[3]); }
                q += __shfl_xor(q, 16); q += __shfl_xor(q, 32);
                P[(ai * HALF + wr * 64 + m * 16 + fr) * 4 + wc] = q;
            }
        asm volatile("s_waitcnt lgkmcnt(0)" ::: "memory"); __builtin_amdgcn_s_barrier(); asm volatile("" ::: "memory");
        const int row = wid * 32 + (lane & 31);
        unsigned long long* sl = slots + (size_t)u.pm * BM + row;
        if (lane < 32) {
            const f32x4 p = *(const LAS f32x4*)(P + row * 4);
            __hip_atomic_store(sl + (size_t)u.pn * MTOK, (1ull << 32) | (unsigned long long)__builtin_bit_cast(unsigned, (p[0] + p[1]) + (p[2] + p[3])), __ATOMIC_RELAXED, __HIP_MEMORY_SCOPE_AGENT);
        }
        mid();
        float tot = 0.f; bool ok = true; unsigned spins = 0u;
        for (;;) {
            ok = true; tot = 0.f;
            if (lane < 32) {
#pragma unroll
                for (int t = 0; t < 4; ++t) { const unsigned long long x = __hip_atomic_load(sl + (size_t)t * MTOK, __ATOMIC_RELAXED, __HIP_MEMORY_SCOPE_AGENT); ok = ok && ((unsigned)(x >> 32) == 1u); tot += __builtin_bit_cast(float, (unsigned)x); }
            }
            if (__all(ok)) break;
            if (++spins > (1u << 15)) { if (lane == 0) __hip_atomic_store(tmo, 1u, __ATOMIC_RELAXED, __HIP_MEMORY_SCOPE_AGENT); break; }
            __builtin_amdgcn_s_sleep(1);
        }
        const bool good = __all(ok);
        if (lane < 32) S[row] = good ? __builtin_amdgcn_rsqf(tot * (1.f / 1024.f) + EPS) : __builtin_nanf("");
        asm volatile("s_waitcnt lgkmcnt(0)" ::: "memory"); __builtin_amdgcn_s_barrier(); asm volatile("" ::: "memory");
        return false;
    }
};
struct EpiMid {
    __device__ __forceinline__ void pre(const Unit&, LAS unsigned char*, int) const {}
    static constexpr bool PEEL = false, PERM = true, AFTER_DRAIN = false; static constexpr int NS = 0;
    bf16* XB; const float* gpost; float* RS2P; PanelSS st1;
    __device__ __forceinline__ void operator()(const f32x4 (&acc_)[2][2][4][2], const Unit& u, int wr, int wc, int fr, int fq, const LAS unsigned char* xlds) const {
        f32x4 (&acc)[2][2][4][2] = const_cast<f32x4 (&)[2][2][4][2]>(acc_);
        LAS unsigned char* xl = const_cast<LAS unsigned char*>(xlds);
        LAS float* P = (LAS float*)(xl + 4096); const LAS float* S = (const LAS float*)(xl + 8192);
        const bf16* xb0 = XB + (size_t)(u.pm * BM + wr * 64 + fr) * DM + u.pn * BM + wc * 32 + 8 * fq;
        u32x4 r0[4][2];
#pragma unroll
        for (int m = 0; m < 4; ++m)
#pragma unroll
            for (int bj = 0; bj < 2; ++bj) r0[m][bj] = *(const u32x4*)(xb0 + (size_t)(m * 16) * DM + bj * HALF);
        f32x4 g[2][2];
#pragma unroll
        for (int bj = 0; bj < 2; ++bj) { const int col = u.pn * BM + bj * HALF + wc * 32 + 8 * fq; g[bj][0] = *(const f32x4*)(gpost + col); g[bj][1] = *(const f32x4*)(gpost + col + 4); }
        u32x4 r1[4][2];
        (void)st1.run(acc, u, wr, wc, fr, fq, xl, [&]() {
#pragma unroll
            for (int m = 0; m < 4; ++m)
#pragma unroll
                for (int bj = 0; bj < 2; ++bj) r1[m][bj] = *(const u32x4*)(xb0 + (size_t)(HALF + m * 16) * DM + bj * HALF); });
#pragma unroll
        for (int ai = 0; ai < 2; ++ai)
#pragma unroll
            for (int m = 0; m < 4; ++m) { const int r = ai * HALF + wr * 64 + m * 16 + fr; const float rsy = S[r]; const size_t row = (size_t)u.pm * BM + r; float q = 0.f;
#pragma unroll
                for (int bj = 0; bj < 2; ++bj) { const int col = u.pn * BM + bj * HALF + wc * 32 + 8 * fq;
                    const u32x4 xv = ai == 0 ? r0[m][bj] : r1[m][bj];
                    const f32x4 a0 = acc[ai][bj][m][0], a1 = acc[ai][bj][m][1]; f32x4 o0, o1;
                    o0[0] = bflo(xv.x) + g[bj][0][0] * a0[0] * rsy; o0[1] = bfhi(xv.x) + g[bj][0][1] * a0[1] * rsy; o0[2] = bflo(xv.y) + g[bj][0][2] * a0[2] * rsy; o0[3] = bfhi(xv.y) + g[bj][0][3] * a0[3] * rsy;
                    o1[0] = bflo(xv.z) + g[bj][1][0] * a1[0] * rsy; o1[1] = bfhi(xv.z) + g[bj][1][1] * a1[1] * rsy; o1[2] = bflo(xv.w) + g[bj][1][2] * a1[2] * rsy; o1[3] = bfhi(xv.w) + g[bj][1][3] * a1[3] * rsy;
                    q += (o0[0] * o0[0] + o0[1] * o0[1]) + (o0[2] * o0[2] + o0[3] * o0[3]) + (o1[0] * o1[0] + o1[1] * o1[1]) + (o1[2] * o1[2] + o1[3] * o1[3]);
                    *(u32x4*)(XB + row * DM + col) = pack8(o0, o1); }
                q += __shfl_xor(q, 16); q += __shfl_xor(q, 32);
                P[r * 4 + wc] = q;
            }
        asm volatile("s_waitcnt lgkmcnt(0)" ::: "memory"); __builtin_amdgcn_s_barrier(); asm volatile("" ::: "memory");
        { const int wid = wr * 4 + wc, lane = fq * 16 + fr, row = wid * 32 + (lane & 31);
          if (lane < 32) { const f32x4 p = *(const LAS f32x4*)(P + row * 4); RS2P[((size_t)u.pm * BM + row) * 4 + u.pn] = (p[0] + p[1]) + (p[2] + p[3]); } }
        asm volatile("s_waitcnt lgkmcnt(0)" ::: "memory"); __builtin_amdgcn_s_barrier(); asm volatile("" ::: "memory");
    }
};
struct EpiOut {
    __device__ __forceinline__ void pre(const Unit&, LAS unsigned char*, int) const {}
    static constexpr bool PEEL = true, PERM = false, AFTER_DRAIN = false; static constexpr int NS = 0;
    const bf16* XB; const float* gpost; float* out; PanelSS st;
    __device__ __forceinline__ void operator()(const f32x4 (&acc)[2][2][4][2], const Unit& u, int wr, int wc, int fr, int fq, const LAS unsigned char* xlds) const {
        LAS unsigned char* xl = const_cast<LAS unsigned char*>(xlds);
        const LAS float* S = (const LAS float*)(xl + 8192);
        const size_t off0 = (size_t)(u.pm * BM + wr * 64 + fr) * DM + u.pn * BM + wc * 32 + 4 * fq;
        const bf16* xb0 = XB + off0; float* o0p = out + off0;
        u32x2 r0[4][2][2];
#pragma unroll
        for (int m = 0; m < 4; ++m)
#pragma unroll
            for (int bj = 0; bj < 2; ++bj)
#pragma unroll
                for (int n = 0; n < 2; ++n) r0[m][bj][n] = *(const u32x2*)(xb0 + (size_t)(m * 16) * DM + bj * HALF + 16 * n);
        f32x4 g[2][2];
#pragma unroll
        for (int bj = 0; bj < 2; ++bj)
#pragma unroll
            for (int n = 0; n < 2; ++n) g[bj][n] = *(const f32x4*)(gpost + u.pn * BM + bj * HALF + wc * 32 + 16 * n + 4 * fq);
        u32x2 r1[4][2][2];
        (void)st.run(acc, u, wr, wc, fr, fq, xl, [&]() {
#pragma unroll
            for (int m = 0; m < 4; ++m)
#pragma unroll
                for (int bj = 0; bj < 2; ++bj)
#pragma unroll
                    for (int n = 0; n < 2; ++n) r1[m][bj][n] = *(const u32x2*)(xb0 + (size_t)(HALF + m * 16) * DM + bj * HALF + 16 * n); });
#pragma unroll
        for (int ai = 0; ai < 2; ++ai)
#pragma unroll
            for (int m = 0; m < 4; ++m) { const int r = ai * HALF + wr * 64 + m * 16 + fr; const float rsf = S[r];
#pragma unroll
                for (int bj = 0; bj < 2; ++bj)
#pragma unroll
                    for (int n = 0; n < 2; ++n) {
                        const u32x2 xv = ai == 0 ? r0[m][bj][n] : r1[m][bj][n]; const f32x4 a0 = acc[ai][bj][m][n]; f32x4 o;
                        o[0] = bflo(xv.x) + g[bj][n][0] * a0[0] * rsf; o[1] = bfhi(xv.x) + g[bj][n][1] * a0[1] * rsf; o[2] = bflo(xv.y) + g[bj][n][2] * a0[2] * rsf; o[3] = bfhi(xv.y) + g[bj][n][3] * a0[3] * rsf;
                        *(f32x4*)(o0p + (size_t)(ai * HALF + m * 16) * DM + bj * HALF + 16 * n) = o; }
            }
    }
};
struct EpiGU {
    static constexpr bool PEEL = true, PERM = true, AFTER_DRAIN = false; static constexpr int NS = 8;
    const float* rs2p; bf16* ACT; int pn0;
    __device__ __forceinline__ void pre(const Unit& u, LAS unsigned char* xlds, int tid) const {
        if (tid < 64) {
#pragma unroll
            for (int i = 0; i < 4; ++i) __builtin_amdgcn_global_load_lds((const unsigned*)(rs2p + ((size_t)u.pm * BM + i * 64 + tid) * 4), (LAS unsigned*)(xlds + i * 1024), 16, 0, 0); }
    }
    __device__ __forceinline__ void operator()(const f32x4 (&acc)[2][2][4][2], const Unit& u, int wr, int wc, int fr, int fq, const LAS unsigned char* xlds) const {
        const int hid = (u.pn + pn0) * HALF + wc * 32 + 8 * fq;
        float vv[8], sll[8];
#pragma unroll
        for (int i = 0; i < 8; ++i) { const f32x4 pq = *(const LAS f32x4*)(xlds + ((i >> 2) * HALF + wr * 64 + (i & 3) * 16 + fr) * 16);
            vv[i] = ((pq[0] + pq[1]) + (pq[2] + pq[3])) * (1.f / 1024.f) + EPS; }
#pragma unroll
        for (int i = 0; i < 8; ++i) sll[i] = __builtin_amdgcn_rsqf(vv[i]) * -1.4426950408889634f;
#pragma unroll
        for (int ai = 0; ai < 2; ++ai)
#pragma unroll
            for (int m = 0; m < 4; ++m) {
                const size_t row = (size_t)u.pm * BM + ai * HALF + wr * 64 + m * 16 + fr; const float v = vv[ai * 4 + m], sl = sll[ai * 4 + m];
                const f32x2 v2 = {v, v}, sl2 = {sl, sl};
                f32x4 o[2];
#pragma unroll
                for (int n = 0; n < 2; ++n)
#pragma unroll
                    for (int p = 0; p < 2; ++p) {
                        const f32x2 g2 = {acc[ai][0][m][n][2 * p], acc[ai][0][m][n][2 * p + 1]}, u2 = {acc[ai][1][m][n][2 * p], acc[ai][1][m][n][2 * p + 1]};
                        const f32x2 t = g2 * sl2; f32x2 e = {__builtin_amdgcn_exp2f(t[0]), __builtin_amdgcn_exp2f(t[1])};
                        e = __builtin_elementwise_fma(e, v2, v2); const f32x2 r = {frcp(e[0]), frcp(e[1])}, q = (g2 * u2) * r;
                        o[n][2 * p] = q[0]; o[n][2 * p + 1] = q[1]; }
                *(u32x4*)(ACT + row * DFF + hid) = pack8(o[0], o[1]);
            }
    }
};

template <class Epi, class Sched, bool ALIGN_EPI = true, bool NOWRAP = false>
__device__ __forceinline__ void gemm_phase(LAS unsigned char* lds, const Gemm g, Sched S, const Epi& E) {
    int tid = threadIdx.x; asm volatile("" : "+v"(tid));
    const int wid = __builtin_amdgcn_readfirstlane(tid >> 6), lane = tid & 63, wr = wid >> 2, wc = wid & 3, fr = lane & 15, fq = lane >> 4;
    const int K = g.K, nt = K / BK;
    unsigned voffA[2], voffB[2];
#pragma unroll
    for (int i = 0; i < 2; ++i) { int R, C; stage_rc(tid * 16 + i * 8192, R, C); const int Rb = Epi::PERM ? ((R & ~31) + perm32(R & 31)) : R;
        voffA[i] = (unsigned)(R * g.lda + C) * 2u; voffB[i] = (unsigned)(Rb * g.ldb + C) * 2u; }
    const size_t kstep = (size_t)(BK * 2);
    const size_t hstepA = (size_t)HALF * g.lda * 2, hstepB = (size_t)HALF * g.ldb * 2;
    const size_t tstepA = 2 * hstepA, tstepB = 2 * hstepB;
    const unsigned ldsw = (unsigned)wid * 1024u;
    const int aoff = lds_byte(wr * 64 + fr, fq * 8), boff = lds_byte(wc * 32 + fr, fq * 8);
#define PG8_SA(b, h) (((b) * 2 + (h)) * HTB)
#define PG8_SB(b, h) ((4 + (b) * 2 + (h)) * HTB)
#define PG8_STAGE(bufoff, gbase, voff) do { _Pragma("unroll") for (int _i = 0; _i < 2; ++_i) \
        __builtin_amdgcn_global_load_lds((const unsigned*)((const char*)(gbase) + (voff)[_i]), (LAS unsigned*)(lds + (bufoff) + ldsw + _i * 8192), 16, 0, 0); } while (0)
#define PG8_LDA(dst, b, h) do { _Pragma("unroll") for (int m = 0; m < 4; ++m) _Pragma("unroll") for (int k = 0; k < 2; ++k) dst[m][k] = *(const LAS bf16x8*)(lds + PG8_SA(b, h) + aoff + m * 2048 + k * 1024); } while (0)
#define PG8_LDB(dst, b, h) do { _Pragma("unroll") for (int n = 0; n < 2; ++n) _Pragma("unroll") for (int k = 0; k < 2; ++k) dst[n][k] = *(const LAS bf16x8*)(lds + PG8_SB(b, h) + boff + n * 2048 + k * 1024); } while (0)
#define PG8_MMA(ai, bj, At, Bt) do { __builtin_amdgcn_s_setprio(1); _Pragma("unroll") for (int m = 0; m < 4; ++m) _Pragma("unroll") for (int n = 0; n < 2; ++n) _Pragma("unroll") for (int k = 0; k < 2; ++k) \
        acc[ai][bj][m][n] = __builtin_amdgcn_mfma_f32_16x16x32_bf16(Bt[n][k], At[m][k], acc[ai][bj][m][n], 0, 0, 0); __builtin_amdgcn_s_setprio(0); } while (0)
#define PG8_MMAZ(ai, bj, At, Bt) do { __builtin_amdgcn_s_setprio(1); _Pragma("unroll") for (int m = 0; m < 4; ++m) _Pragma("unroll") for (int n = 0; n < 2; ++n) { \
        acc[ai][bj][m][n] = __builtin_amdgcn_mfma_f32_16x16x32_bf16(Bt[n][0], At[m][0], (f32x4){0.f, 0.f, 0.f, 0.f}, 0, 0, 0); \
        acc[ai][bj][m][n] = __builtin_amdgcn_mfma_f32_16x16x32_bf16(Bt[n][1], At[m][1], acc[ai][bj][m][n], 0, 0, 0); } __builtin_amdgcn_s_setprio(0); } while (0)
#define PG8_WAIT_V(n) asm volatile("s_waitcnt vmcnt(" #n ")" ::: "memory")
#define PG8_WAIT_L(n) asm volatile("s_waitcnt lgkmcnt(" #n ")" ::: "memory")
#define PG8_WAIT_VF PG8_WAIT_V(8)
#define PG8_BAR __builtin_amdgcn_s_barrier()
#define PG8_SCHED __builtin_amdgcn_sched_barrier(0)
    Unit cur, nxt; int ui = 0;
    if (!S.next(0, cur)) return;
    f32x4 acc[2][2][4][2];
    bf16x8 At[4][2], B0[2][2], B1[2][2];
    const char* cA = (const char*)g.A + (size_t)cur.pm * tstepA; const char* cB = (const char*)g.Bt + (size_t)cur.pn * tstepB;
    S.a_ready(cur);
    PG8_STAGE(PG8_SB(0, 0), cB, voffB); PG8_STAGE(PG8_SB(0, 1), cB + hstepB, voffB); PG8_STAGE(PG8_SA(0, 0), cA, voffA); PG8_STAGE(PG8_SA(0, 1), cA + hstepA, voffA);
    if (wr == 1) PG8_BAR;
    PG8_WAIT_V(2); PG8_BAR;
    PG8_STAGE(PG8_SB(1, 0), cB + kstep, voffB); PG8_STAGE(PG8_SA(1, 0), cA + kstep, voffA); PG8_STAGE(PG8_SB(1, 1), cB + hstepB + kstep, voffB);
    PG8_WAIT_V(6); PG8_BAR;
    for (;;) {
        const bool has_next = S.next(ui + 1, nxt);
        const char* nA = has_next ? (const char*)g.A + (size_t)nxt.pm * tstepA : cA; const char* nB = has_next ? (const char*)g.Bt + (size_t)nxt.pn * tstepB : cB;
#define PG8_KBODY(MM, LAST) { \
            const bool last = (LAST); \
            const char* a1 = cA + (size_t)(t + 1) * kstep; \
            const char* a2 = last ? nA : cA + (size_t)(t + 2) * kstep; const char* b2 = last ? nB : cB + (size_t)(t + 2) * kstep; \
            const char* a3 = a2 + kstep; const char* b3 = b2 + kstep; \
            if (last && has_next) S.a_ready(nxt); \
            if (last) { int tp = tid; asm volatile("" : "+v"(tp)); E.pre(cur, lds + STAGE_BYTES, tp); }     \
              \
            PG8_LDB(B0, 0, 0); PG8_LDB(B1, 0, 1); PG8_SCHED; PG8_LDA(At, 0, 0); PG8_STAGE(PG8_SA(1, 1), a1 + hstepA, voffA); \
            PG8_WAIT_VF; PG8_WAIT_L(0); PG8_BAR; MM(0, 0, At, B0); MM(0, 1, At, B1); PG8_BAR; PG8_SCHED; \
            const bool nw = NOWRAP && last;     \
              \
            PG8_LDA(At, 0, 1); if (!nw) { PG8_STAGE(PG8_SB(0, 0), b2, voffB); PG8_STAGE(PG8_SB(0, 1), b2 + hstepB, voffB); PG8_STAGE(PG8_SA(0, 0), a2, voffA); } \
            if (nw) PG8_WAIT_V(2); else PG8_WAIT_VF; PG8_WAIT_L(0); PG8_BAR; MM(1, 0, At, B0); MM(1, 1, At, B1); PG8_BAR; PG8_SCHED; \
              \
            PG8_LDB(B0, 1, 0); PG8_LDB(B1, 1, 1); PG8_SCHED; PG8_LDA(At, 1, 0); if (!nw) PG8_STAGE(PG8_SA(0, 1), a2 + hstepA, voffA); \
            if (nw) PG8_WAIT_V(0); else PG8_WAIT_V(8); PG8_WAIT_L(0); PG8_BAR; PG8_MMA(0, 0, At, B0); PG8_MMA(0, 1, At, B1); PG8_BAR; PG8_SCHED; \
              \
            PG8_LDA(At, 1, 1); if (!nw) { PG8_STAGE(PG8_SB(1, 0), b3, voffB); PG8_STAGE(PG8_SB(1, 1), b3 + hstepB, voffB); PG8_STAGE(PG8_SA(1, 0), a3, voffA); } \
            if (nw) PG8_WAIT_V(0); else PG8_WAIT_V(8); PG8_WAIT_L(0); PG8_BAR; PG8_MMA(1, 0, At, B0); PG8_MMA(1, 1, At, B1); PG8_BAR; PG8_SCHED; }
        if constexpr (Epi::PEEL) { int t = 0; asm volatile("" : "+s"(t)); PG8_KBODY(PG8_MMAZ, false) } else { _Pragma("unroll") for (int a_ = 0; a_ < 2; ++a_) _Pragma("unroll") for (int b_ = 0; b_ < 2; ++b_) _Pragma("unroll") for (int m_ = 0; m_ < 4; ++m_) _Pragma("unroll") for (int n_ = 0; n_ < 2; ++n_) acc[a_][b_][m_][n_] = (f32x4){0.f, 0.f, 0.f, 0.f}; }
#pragma unroll 1
        for (int t = Epi::PEEL ? 2 : 0; t < nt; t += 2) PG8_KBODY(PG8_MMA, t == nt - 2)
#undef PG8_KBODY
        if constexpr (ALIGN_EPI) { if (wr == 0) PG8_BAR; }
        { int tv = tid; asm volatile("" : "+v"(tv)); const int frv = tv & 15, fqv = (tv >> 4) & 3;
          E(acc, cur, wr, wc, frv, fqv, lds + STAGE_BYTES); } S.done(cur);
        if (!has_next) break;
        cur = nxt; cA = nA; cB = nB; ++ui;
        if constexpr (ALIGN_EPI) { if (wr == 1) PG8_BAR; }
    }
    PG8_WAIT_V(0);
    if constexpr (!ALIGN_EPI) { if (wr == 0) PG8_BAR; }
    PG8_BAR;
#undef PG8_SA
#undef PG8_SB
#undef PG8_STAGE
#undef PG8_LDA
#undef PG8_LDB
#undef PG8_MMA
#undef PG8_MMAZ
#undef PG8_WAIT_V
#undef PG8_WAIT_L
#undef PG8_WAIT_VF
#undef PG8_BAR
#undef PG8_SCHED
}
}

#define XB_TMO      128
#define XB_XCNT(j)  (256  + 64 * (j))
#define XB_XSUB(j)  (1280 + 64 * (j))
#define XB_XGEN(j)  (2304 + 64 * (j))
#define XB_TOP      3328
#define XB_TOPGEN   3392
#define XCD_BAR_WORDS 3456
#define XB_SPIN_CAP (1u << 20)
__device__ __forceinline__ unsigned xb_ld(unsigned* p)              { return __hip_atomic_load(p, __ATOMIC_RELAXED, __HIP_MEMORY_SCOPE_AGENT); }
__device__ __forceinline__ unsigned xb_add(unsigned* p, unsigned v) { return __hip_atomic_fetch_add(p, v, __ATOMIC_RELAXED, __HIP_MEMORY_SCOPE_AGENT); }
__device__ __forceinline__ unsigned xb_xcc_id() { return (unsigned)__builtin_amdgcn_s_getreg((3 << 11) | 20) & 0xFu; }
#define XB_SPIN(cond, bar) do { unsigned _sp = 0; while (cond) { __builtin_amdgcn_s_sleep(1); \
    if ((++_sp & 255u) == 0u) { if (xb_ld(&(bar)[XB_TMO])) break; if (_sp > XB_SPIN_CAP) { atomicAdd(&(bar)[XB_TMO], 1u); break; } } } } while (0)
struct XcdBarrier { unsigned* bar; unsigned x; volatile LAS unsigned* st; };
__device__ __forceinline__ XcdBarrier xcd_barrier_post(unsigned* bar, volatile LAS unsigned* st) {
    XcdBarrier b; b.bar = bar; b.x = xb_xcc_id(); b.st = st;
    if (threadIdx.x == 0) (void)xb_add(&bar[XB_XCNT(b.x)], 1u);
    return b;
}
__device__ __forceinline__ void xcd_barrier_complete(unsigned* bar, unsigned x, unsigned& nloc, unsigned& nx) {
    const unsigned G = gridDim.x * gridDim.y * gridDim.z;
    unsigned sum, cnt, mine, sp = 0u;
    for (;;) {
        sum = 0u; cnt = 0u; mine = 0u;
#pragma unroll
        for (unsigned j = 0; j < 16; ++j) { const unsigned c = xb_ld(&bar[XB_XCNT(j)]); sum += c; cnt += (c > 0u) ? 1u : 0u; mine = (j == x) ? c : mine; }
        if (sum == G) break;
        __builtin_amdgcn_s_sleep(1);
        if ((++sp & 255u) == 0u) { if (xb_ld(&bar[XB_TMO])) break; if (sp > XB_SPIN_CAP) { atomicAdd(&bar[XB_TMO], 1u); break; } }
    }
    nloc = mine > 0u ? mine : 1u; nx = cnt > 0u ? cnt : 1u;
}
__device__ __forceinline__ void xcd_barrier(const XcdBarrier& b) {
    asm volatile("s_waitcnt vmcnt(0)" ::: "memory");
    __syncthreads();
    if (threadIdx.x == 0) {
        unsigned* bar = b.bar;
        __builtin_amdgcn_s_waitcnt(0);
        unsigned nloc = b.st[0], nx = b.st[1];
        if (nloc == 0u) { xcd_barrier_complete(bar, b.x, nloc, nx); b.st[0] = nloc; b.st[1] = nx; }
        const unsigned old = xb_add(&bar[XB_XSUB(b.x)], 1u);
        const unsigned gen = old / nloc;
        if (old + 1u == (gen + 1u) * nloc) {
            __builtin_amdgcn_fence(__ATOMIC_RELEASE, "agent");
            asm volatile("s_waitcnt vmcnt(0)" ::: "memory");
            const unsigned og = xb_add(&bar[XB_TOP], 1u);
            const unsigned tg = og / nx;
            if (og + 1u == (tg + 1u) * nx) xb_add(&bar[XB_TOPGEN], 1u);
            else XB_SPIN(xb_ld(&bar[XB_TOPGEN]) == tg, bar);
            __builtin_amdgcn_fence(__ATOMIC_ACQUIRE, "agent");
            xb_add(&bar[XB_XGEN(b.x)], 1u);
            asm volatile("s_waitcnt vmcnt(0)" ::: "memory");
        } else {
            XB_SPIN(xb_ld(&bar[XB_XGEN(b.x)]) == gen, bar);
            __builtin_amdgcn_fence(__ATOMIC_ACQUIRE, "agent");
            asm volatile("s_waitcnt vmcnt(0)" ::: "memory");
        }
    }
    __syncthreads();
}

struct Args {
    const float* in[28]; float* out; unsigned char* ws; int ph_lo, ph_hi, pad0, pad1;
};
enum { I_X = 0, I_NMPRE, I_NMPOST, I_NFPRE, I_NFPOST, I_WIN, I_GBIAS, I_LRE, I_LIM, I_LDT, I_BRE, I_BIM, I_CRE, I_CIM, I_S5D, I_WGLU, I_BGLU,
       I_CONVW, I_CONVB, I_WQ, I_WK, I_WV, I_HNORM, I_SKIP, I_WOUT, I_WGATE, I_WUP, I_WDOWN };


__device__ __forceinline__ void p0_s5_unit(const Args& a, unsigned char* ws, LAS unsigned char* lds, int u, int tid) {
    const int g = u >> 3, part = u & 7;
    LAS float* pwr = (LAS float*)lds; LAS float* pwi = pwr + 2176; LAS float* bbr = pwi + 2176; LAS float* bbi = bbr + 2048;
    LAS float* cr = bbi + 2048; LAS float* ci = cr + 1024; LAS float* kl = ci + 1024; LAS float* fac = kl + 8192;
    for (int idx = tid; idx < 2176; idx += NTHREADS) {
        const int dir = idx / 1088, rem = idx - dir * 1088, e = rem >> 6, p = rem & 63;
        const float lr = a.in[I_LRE][(dir * NG + g) * 64 + p], li = a.in[I_LIM][(dir * NG + g) * 64 + p], dt = expf(a.in[I_LDT][dir * NG + g]);
        const float mag = expf(lr * dt * (float)e); float sn, cs; sincosf(li * dt * (float)e, &sn, &cs);
        pwr[idx] = mag * cs; pwi[idx] = mag * sn;
        if (e == 1) { const float xr = expm1f(lr * dt) * cs - 2.f * sinf(0.5f * li * dt) * sinf(0.5f * li * dt), xi = mag * sn, den = lr * lr + li * li;
            fac[(dir * 64 + p) * 2] = (xr * lr + xi * li) / den; fac[(dir * 64 + p) * 2 + 1] = (xi * lr - xr * li) / den; }
    }
    for (int i = tid; i < 1024; i += NTHREADS) { const int c = i >> 6, p = i & 63; cr[p * 16 + c] = a.in[I_CRE][g * 1024 + i]; ci[p * 16 + c] = a.in[I_CIM][g * 1024 + i]; }
    __syncthreads();
    for (int idx = tid; idx < 2048; idx += NTHREADS) { const int dir = idx >> 10, p = (idx >> 4) & 63, c = idx & 15;
        const float fr = fac[(dir * 64 + p) * 2], fi = fac[(dir * 64 + p) * 2 + 1], b_r = a.in[I_BRE][(g * 64 + p) * 16 + c], b_i = a.in[I_BIM][(g * 64 + p) * 16 + c];
        bbr[idx] = fr * b_r - fi * b_i; bbi[idx] = fr * b_i + fi * b_r; }
    __syncthreads();
    {
        const int dir = tid >> 8, lsel = (tid >> 7) & 1, c = (tid >> 3) & 15, c2p = tid & 7, lag = 2 * part + lsel;
        float s0 = 0.f, s1 = 0.f;
        for (int p = 0; p < 64; ++p) {
            const float pr = pwr[(dir * 17 + lag) * 64 + p], pi = pwi[(dir * 17 + lag) * 64 + p], c_r = cr[p * 16 + c], c_i = ci[p * 16 + c];
            const float x_r = c_r * pr - c_i * pi, x_i = c_r * pi + c_i * pr;
            const f32x2 b_r = *(const LAS f32x2*)(bbr + (dir * 64 + p) * 16 + 2 * c2p), b_i = *(const LAS f32x2*)(bbi + (dir * 64 + p) * 16 + 2 * c2p);
            s0 += x_r * b_r[0] - x_i * b_i[0]; s1 += x_r * b_r[1] - x_i * b_i[1];
        }
        *(LAS f32x2*)(kl + ((dir * 2 + lsel) * 16 + c) * 16 + 2 * c2p) = (f32x2){s0, s1};
    }
    __syncthreads();
    bf16* MZ = (bf16*)(ws + WS_MZ) + (size_t)g * 256 * 256; bf16* TMY = (bf16*)(ws + WS_TMY) + (size_t)g * 256 * 512;
    for (int v = part * 1024 + tid; v < (part + 1) * 1024; v += NTHREADS) {
        const int n = v >> 5, k0 = (v & 31) * 8, dir = n >> 7, ri = (n >> 6) & 1, p = n & 63, j = k0 >> 4, c0 = k0 & 15, e = dir ? j : 15 - j;
        const float pr = pwr[(dir * 17 + e) * 64 + p], pi = pwi[(dir * 17 + e) * 64 + p]; float o[8];
#pragma unroll
        for (int cc = 0; cc < 8; ++cc) { const float b_r = bbr[(dir * 64 + p) * 16 + c0 + cc], b_i = bbi[(dir * 64 + p) * 16 + c0 + cc]; o[cc] = ri ? (pr * b_i + pi * b_r) : (pr * b_r - pi * b_i); }
        u32x4 w; w.x = pk2(o[0], o[1]); w.y = pk2(o[2], o[3]); w.z = pk2(o[4], o[5]); w.w = pk2(o[6], o[7]);
        *(u32x4*)(MZ + (size_t)n * 256 + k0) = w;
    }
    for (int v = tid; v < 2048; v += NTHREADS) {
        const int dir = v >> 10, lsel = (v >> 9) & 1, t = (v >> 5) & 15, c = (v >> 1) & 15, hf = v & 1, lag = 2 * part + lsel;
        const int j = dir ? t + lag : t - lag;
        if (j < 0 || j > 15 || (lag == 0 && dir == 1)) continue;
        float o[8];
#pragma unroll
        for (int cc = 0; cc < 8; ++cc) { const int c2 = 8 * hf + cc; float sv = kl[((dir * 2 + lsel) * 16 + c) * 16 + c2];
            if (lag == 0) { sv += kl[((1 * 2 + lsel) * 16 + c) * 16 + c2]; if (c2 == c) sv += a.in[I_S5D][g * 16 + c]; }
            o[cc] = sv; }
        u32x4 w; w.x = pk2(o[0], o[1]); w.y = pk2(o[2], o[3]); w.z = pk2(o[4], o[5]); w.w = pk2(o[6], o[7]);
        *(u32x4*)(TMY + (size_t)(t * 16 + c) * 512 + j * 16 + 8 * hf) = w;
    }
    for (int v = part * 1024 + tid; v < (part + 1) * 1024; v += NTHREADS) {
        const int n = v >> 5, k0 = 256 + (v & 31) * 8, t = n >> 4, c = n & 15; float o[8];
        const int s0 = k0 - 256, dir = s0 >> 7, ri = (s0 >> 6) & 1, e = dir ? 16 - t : t + 1;
#pragma unroll
        for (int cc = 0; cc < 8; ++cc) { const int p = (s0 & 63) + cc; const float pr = pwr[(dir * 17 + e) * 64 + p], pi = pwi[(dir * 17 + e) * 64 + p], c_r = cr[p * 16 + c], c_i = ci[p * 16 + c];
            o[cc] = ri ? -(c_r * pi + c_i * pr) : (c_r * pr - c_i * pi); }
        u32x4 w; w.x = pk2(o[0], o[1]); w.y = pk2(o[2], o[3]); w.z = pk2(o[4], o[5]); w.w = pk2(o[6], o[7]);
        *(u32x4*)(TMY + (size_t)n * 512 + k0) = w;
    }
    __syncthreads();
}
struct TrItem { const float* s0; const float* s1; const float* rs; bf16* dst; int ld, c0, c1, nh, k0, K; float cs; };
__device__ __forceinline__ void tr_load(const TrItem& t, f32x4 (&v)[2][4], float (&sc)[4], int tid) {
#pragma unroll
    for (int i = 0; i < 4; ++i) { const int idx = tid + NTHREADS * i, row = idx >> 5, c4 = idx & 31;
        sc[i] = t.rs ? t.rs[t.k0 + row] * t.cs : t.cs;
#pragma unroll
        for (int hf = 0; hf < 2; ++hf) { v[hf][i] = (f32x4){0.f, 0.f, 0.f, 0.f};
            if (hf < t.nh) v[hf][i] = *(const f32x4*)((hf ? t.s1 : t.s0) + (size_t)(t.k0 + row) * t.ld + (hf ? t.c1 : t.c0) + 4 * c4); } }
}
__device__ __forceinline__ void tr_finish(const TrItem& t, const f32x4 (&v)[2][4], const float (&sc)[4], LAS float* T, int tid) {
#pragma unroll
    for (int hf = 0; hf < 2; ++hf)
#pragma unroll
        for (int i = 0; i < 4; ++i) { const int idx = tid + NTHREADS * i, row = idx >> 5, c4 = idx & 31;
            LAS float* p = T + row * 257 + 128 * hf + 4 * c4; p[0] = v[hf][i][0] * sc[i]; p[1] = v[hf][i][1] * sc[i]; p[2] = v[hf][i][2] * sc[i]; p[3] = v[hf][i][3] * sc[i]; }
    __syncthreads();
#pragma unroll
    for (int i = 0; i < 4; ++i) { const int idx = tid + NTHREADS * i, n = idx >> 3, kc = idx & 7;
        if (n < 128 * t.nh) { const LAS float* p = T + (8 * kc) * 257 + n;
            u32x4 o; o.x = pk2(p[0], p[257]); o.y = pk2(p[2 * 257], p[3 * 257]); o.z = pk2(p[4 * 257], p[5 * 257]); o.w = pk2(p[6 * 257], p[7 * 257]);
            *(u32x4*)(t.dst + (size_t)n * t.K + t.k0 + 8 * kc) = o; } }
    __syncthreads();
}
constexpr int TR_J0 = 16 * 6, TR_J1 = 8 * 2, TR_J2 = 12 * 2, TR_J3 = 16 * 4, TR_J4 = 16 * 22, TR_J5 = 44 * 4, TR_NJ = TR_J0 + TR_J1 + TR_J2 + TR_J3 + TR_J4 + TR_J5;
__device__ __forceinline__ TrItem tr_decode(const Args& a, unsigned char* ws, int r) {
    if (r < TR_J0) { const int kb = r / 6, nb = r % 6; return TrItem{a.in[I_WIN], a.in[I_WIN], a.in[I_NMPRE], (bf16*)(ws + WS_WIN) + (size_t)(256 * nb) * 1024, D_IN, 256 * nb, 256 * nb + 128, 2, 64 * kb, 1024, 1.f}; } r -= TR_J0;
    if (r < TR_J1) { const int kb = r / 2, nb = r % 2; return TrItem{a.in[I_WGLU], a.in[I_WGLU], nullptr, (bf16*)(ws + WS_WGLU) + (size_t)(256 * nb) * 512, 512, 256 * nb, 256 * nb + 128, 2, 64 * kb, 512, 1.f}; } r -= TR_J1;
    if (r < TR_J2) { const int mh = r >> 1, kb = r & 1, mat = mh >> 2; const float* sp = (mat == 0 ? a.in[I_WQ] : mat == 1 ? a.in[I_WK] : a.in[I_WV]) + (size_t)(mh & 3) * 16384;
        return TrItem{sp, sp, nullptr, (bf16*)(ws + WS_WQKV) + (size_t)(mh * 128) * 128, 128, 0, 0, 1, 64 * kb, 128, mat == 1 ? 0.08838834764831845f : 1.f}; } r -= TR_J2;
    if (r < TR_J3) { const int kb = r / 4, nb = r % 4; return TrItem{a.in[I_WOUT], a.in[I_WOUT], nullptr, (bf16*)(ws + WS_WOUT) + (size_t)(256 * nb) * 1024, 1024, 256 * nb, 256 * nb + 128, 2, 64 * kb, 1024, 1.f}; } r -= TR_J3;
    if (r < TR_J4) { const int kb = r / 22, nb = r % 22; return TrItem{a.in[I_WGATE], a.in[I_WUP], a.in[I_NFPRE], (bf16*)(ws + WS_WGU) + (size_t)(256 * nb) * 1024, DFF, 128 * nb, 128 * nb, 2, 64 * kb, 1024, 1.f}; } r -= TR_J4;
    { const int kb = r / 4, nb = r % 4; return TrItem{a.in[I_WDOWN], a.in[I_WDOWN], nullptr, (bf16*)(ws + WS_WDN) + (size_t)(256 * nb) * DFF, 1024, 256 * nb, 256 * nb + 128, 2, 64 * kb, DFF, 1.f}; }
}
__device__ __forceinline__ void p0_prologue(const Args& a, unsigned char* ws, LAS unsigned char* lds, int tid, int wave, int lane, int vcu, int G) {
    for (int i = blockIdx.x * NTHREADS + tid; i < (int)(6 * MiB / 16); i += G * NTHREADS) *(u32x4*)(ws + WS_XS + (size_t)i * 16) = (u32x4){0u, 0u, 0u, 0u};
    const int gw = vcu * NWAVES + wave, NGW = G * NWAVES;
    {   LAS float* T = (LAS float*)lds;
        int it = vcu; bool have = it < TR_NJ; TrItem cur = tr_decode(a, ws, have ? it : 0); f32x4 v[2][4]; float sc[4];
        if (have) tr_load(cur, v, sc, tid);
        for (int u = blockIdx.x; u < NG * 8; u += G) p0_s5_unit(a, ws, lds, u, tid);
        while (have) {
            const int nx = it + G; const bool hn = nx < TR_NJ; const TrItem nxt = tr_decode(a, ws, hn ? nx : 0); f32x4 w[2][4]; float sn[4];
#pragma unroll
            for (int i = 0; i < 4; ++i) { sn[i] = 0.f; w[0][i] = (f32x4){0.f, 0.f, 0.f, 0.f}; w[1][i] = w[0][i]; }
            if (hn) tr_load(nxt, w, sn, tid);
            tr_finish(cur, v, sc, T, tid);
            cur = nxt; it = nx; have = hn;
#pragma unroll
            for (int i = 0; i < 4; ++i) { sc[i] = sn[i]; v[0][i] = w[0][i]; v[1][i] = w[1][i]; }
        }
    }
    __syncthreads();
    f32x4 vpre[4][4];
    { const float* xr0 = a.in[I_X] + (size_t)((gw < MTOK / 16 ? gw : 0) * 16 + (lane & 15)) * DM + 16 * (lane >> 4);
#pragma unroll
      for (int s8 = 0; s8 < 4; ++s8)
#pragma unroll
          for (int j = 0; j < 4; ++j) vpre[s8][j] = *(const f32x4*)(xr0 + 64 * s8 + 4 * j); }
    for (int idx = tid; idx < 32 * 64; idx += NTHREADS) {
        const int f = idx >> 6, l = idx & 63, n = l & 15, q = l >> 4, k0 = 64 * (f >> 1) + 16 * q + 8 * (f & 1); float o[8];
#pragma unroll
        for (int j = 0; j < 8; ++j) o[j] = a.in[I_NMPRE][k0 + j] * a.in[I_WIN][(size_t)(k0 + j) * D_IN + NPROJ + n];
        u32x4 w; w.x = pk2(o[0], o[1]); w.y = pk2(o[2], o[3]); w.z = pk2(o[4], o[5]); w.w = pk2(o[6], o[7]);
        *(LAS u32x4*)(lds + idx * 16) = w;
    }
    __syncthreads();
    const int r16 = lane & 15, q4 = lane >> 4;
    const float gbias = a.in[I_GBIAS][r16];
    float* RS1 = (float*)(ws + WS_RS1); float* GT = (float*)(ws + WS_GATES);
    for (int grp = gw; grp < MTOK / 16; grp += NGW) {
        const int row0 = grp * 16;
        const float* xr = a.in[I_X] + (size_t)(row0 + r16) * DM + 16 * q4;
        bf16* xo = (bf16*)(ws + WS_XB) + (size_t)(row0 + r16) * DM + 16 * q4;
        f32x4 acc = {0.f, 0.f, 0.f, 0.f}; float ss = 0.f;
#pragma unroll 1
        for (int half = 0; half < 4; ++half) {
            f32x4 v[4][4];
            if (grp == gw && half == 0) {
#pragma unroll
                for (int s8 = 0; s8 < 4; ++s8)
#pragma unroll
                    for (int j = 0; j < 4; ++j) v[s8][j] = vpre[s8][j];
            } else {
#pragma unroll
                for (int s8 = 0; s8 < 4; ++s8)
#pragma unroll
                    for (int j = 0; j < 4; ++j) v[s8][j] = *(const f32x4*)(xr + 64 * (4 * half + s8) + 4 * j);
            }
#pragma unroll
            for (int s8 = 0; s8 < 4; ++s8) {
                const int s = 4 * half + s8; const f32x4 v0 = v[s8][0], v1 = v[s8][1], v2 = v[s8][2], v3 = v[s8][3];
                ss += (v0[0] * v0[0] + v0[1] * v0[1]) + (v0[2] * v0[2] + v0[3] * v0[3]) + (v1[0] * v1[0] + v1[1] * v1[1]) + (v1[2] * v1[2] + v1[3] * v1[3])
                    + (v2[0] * v2[0] + v2[1] * v2[1]) + (v2[2] * v2[2] + v2[3] * v2[3]) + (v3[0] * v3[0] + v3[1] * v3[1]) + (v3[2] * v3[2] + v3[3] * v3[3]);
                u32x4 a0, a1; a0.x = pk2(v0[0], v0[1]); a0.y = pk2(v0[2], v0[3]); a0.z = pk2(v1[0], v1[1]); a0.w = pk2(v1[2], v1[3]);
                a1.x = pk2(v2[0], v2[1]); a1.y = pk2(v2[2], v2[3]); a1.z = pk2(v3[0], v3[1]); a1.w = pk2(v3[2], v3[3]);
                *(u32x4*)(xo + 64 * s) = a0; *(u32x4*)(xo + 64 * s + 8) = a1;
                const bf16x8 b0 = *(const LAS bf16x8*)(lds + ((2 * s) * 64 + lane) * 16), b1 = *(const LAS bf16x8*)(lds + ((2 * s + 1) * 64 + lane) * 16);
                acc = __builtin_amdgcn_mfma_f32_16x16x32_bf16(__builtin_bit_cast(bf16x8, a0), b0, acc, 0, 0, 0);
                acc = __builtin_amdgcn_mfma_f32_16x16x32_bf16(__builtin_bit_cast(bf16x8, a1), b1, acc, 0, 0, 0);
            }
        }
        ss += __shfl_xor(ss, 16); ss += __shfl_xor(ss, 32);
        const float rs = __builtin_amdgcn_rsqf(ss * (1.f / DM) + EPS);
        if (q4 == 0) RS1[row0 + r16] = rs;
#pragma unroll
        for (int reg = 0; reg < 4; ++reg) { const float rsr = __shfl(rs, 4 * q4 + reg); GT[(size_t)(row0 + 4 * q4 + reg) * 16 + r16] = acc[reg] * rsr + gbias; }
    }
    __syncthreads();
}

__device__ __forceinline__ void s5_scan_lds(const Args& a, unsigned char* ws, const LAS unsigned char* zl, int L, int tid) {
    if (tid < 256) {
        bf16* UX = (bf16*)(ws + WS_UX);
        const int g = L >> 4, bl = (tid >> 7) & 1, b = 2 * (L & 15) + bl, dir = (tid >> 6) & 1, p = tid & 63;
        const float lr = a.in[I_LRE][(dir * NG + g) * 64 + p], li = a.in[I_LIM][(dir * NG + g) * 64 + p], dt = expf(a.in[I_LDT][dir * NG + g]);
        const float mag = expf(lr * dt * 16.f); float sn, cs; sincosf(li * dt * 16.f, &sn, &cs);
        const float ar = mag * cs, ai = mag * sn;
        const LAS bf16* z = (const LAS bf16*)(zl + (size_t)(bl * S5NCH) * pg8::ZLP) + dir * 128 + p;
        bf16* o = UX + (size_t)(g * S5ROWS + b * S5NCH) * 512 + 256 + dir * 128 + p;
        float sr = 0.f, si = 0.f;
#pragma unroll 1
        for (int kb = 0; kb < S5NCH / 16; ++kb) {
            float zr[16], zi[16];
#pragma unroll
            for (int j = 0; j < 16; ++j) { const int kk = kb * 16 + j, k = dir ? (S5NCH - 1 - kk) : kk; zr[j] = bf2f(z[k * (pg8::ZLP / 2)]); zi[j] = bf2f(z[k * (pg8::ZLP / 2) + 64]); }
#pragma unroll
            for (int j = 0; j < 16; ++j) { const int kk = kb * 16 + j, k = dir ? (S5NCH - 1 - kk) : kk;
                o[(size_t)k * 512] = (bf16)(pk2(sr, 0.f) & 0xffffu); o[(size_t)k * 512 + 64] = (bf16)(pk2(si, 0.f) & 0xffffu);
                const float nr = ar * sr - ai * si + zr[j], ni = ar * si + ai * sr + zi[j]; sr = nr; si = ni; }
        }
    }
}

__device__ __forceinline__ void s5_scan(const Args& a, unsigned char* ws, int tid, int G) {
    const bf16* ZB = (const bf16*)(ws + WS_ZB); bf16* UX = (bf16*)(ws + WS_UX);
    for (int base = 0; base * G < NG * 16; base += 2) {
        const int L = (base + (tid >> 8)) * G + (int)blockIdx.x;
        if (L < NG * 16) {
            const int g = L >> 4, b = 2 * (L & 15) + ((tid >> 7) & 1), dir = (tid >> 6) & 1, p = tid & 63;
            const float lr = a.in[I_LRE][(dir * NG + g) * 64 + p], li = a.in[I_LIM][(dir * NG + g) * 64 + p], dt = expf(a.in[I_LDT][dir * NG + g]);
            const float mag = expf(lr * dt * 16.f); float sn, cs; sincosf(li * dt * 16.f, &sn, &cs);
            const float ar = mag * cs, ai = mag * sn;
            const bf16* z = ZB + (size_t)(g * S5ROWS + b * S5NCH) * 256 + dir * 128 + p;
            bf16* o = UX + (size_t)(g * S5ROWS + b * S5NCH) * 512 + 256 + dir * 128 + p;
            float sr = 0.f, si = 0.f;
#pragma unroll 1
            for (int kb = 0; kb < S5NCH / 16; ++kb) {
                float zr[16], zi[16];
#pragma unroll
                for (int j = 0; j < 16; ++j) { const int kk = kb * 16 + j, k = dir ? (S5NCH - 1 - kk) : kk; zr[j] = bf2f(z[(size_t)k * 256]); zi[j] = bf2f(z[(size_t)k * 256 + 64]); }
#pragma unroll
                for (int j = 0; j < 16; ++j) { const int kk = kb * 16 + j, k = dir ? (S5NCH - 1 - kk) : kk;
                    o[(size_t)k * 512] = (bf16)(pk2(sr, 0.f) & 0xffffu); o[(size_t)k * 512 + 64] = (bf16)(pk2(si, 0.f) & 0xffffu);
                    const float nr = ar * sr - ai * si + zr[j], ni = ar * si + ai * sr + zi[j]; sr = nr; si = ni; }
            }
        }
    }
}

__device__ __forceinline__ void ml_pre(const Args& a, unsigned char* ws, LAS unsigned char* lds, int gw, int NGW, int wave, int lane, int G) {
    const float* GT = (const float*)(ws + WS_GATES);
    LAS float* sm = (LAS float*)lds;
    u32x4 xpre[12];
    { const bf16* XM0 = (const bf16*)(ws + WS_XM); const int grp0 = gw < MTOK / 8 ? gw : 0, row0 = grp0 * 8, s0 = row0 & (SEQ - 1);
#pragma unroll
      for (int i = 0; i < 12; ++i) { const int sp = s0 + i - 2; xpre[i] = (u32x4){0u, 0u, 0u, 0u}; if (sp >= 0 && sp < SEQ) xpre[i] = *(const u32x4*)(XM0 + (size_t)(row0 + i - 2) * 512 + 8 * lane); } }
    const int w4 = __builtin_amdgcn_readfirstlane(wave) * 4;
    for (int cid = blockIdx.x; cid < BATCH * NH * 2; cid += G) {
        const int b = cid >> 3, h = (cid >> 1) & 3, dir = cid & 1;
        float* GS = (float*)(ws + WS_GS) + (size_t)cid * SEQ * 8;
        float gi[4], gf[4], rr[4], bs[4], Rm[4];
#pragma unroll
        for (int j = 0; j < 4; ++j) { const int lp = (w4 + j) * 64 + lane, pos = dir ? (SEQ - 1 - lp) : lp; const float* gp = GT + (size_t)(b * SEQ + pos) * 16;
            gi[j] = gp[(dir ? 4 : 0) + h]; gf[j] = gp[(dir ? 12 : 8) + h]; }
#pragma unroll
        for (int j = 0; j < 4; ++j) {
            const float lf = fminf(gf[j], 0.f) - log1pf(expf(-fabsf(gf[j])));
            float bsum = lf;
#pragma unroll
            for (int o = 1; o < 64; o <<= 1) { const float v = __shfl_up(bsum, o); if (lane >= o) bsum += v; }
            const float r = gi[j] - bsum; float R = r;
#pragma unroll
            for (int o = 1; o < 64; o <<= 1) { const float v = __shfl_up(R, o); if (lane >= o) R = fmaxf(R, v); }
            rr[j] = r; bs[j] = bsum; Rm[j] = R;
            if (lane == 63) *(LAS f32x2*)(sm + (w4 + j) * 2) = (f32x2){bsum, R};
        }
        __syncthreads();
        float ms = 0.f;
#pragma unroll
        for (int c = 0; c < 28; ++c) if (c < w4) { const f32x2 e = *(const LAS f32x2*)(sm + c * 2); ms = e[0] + fmaxf(ms, e[1]); }
#pragma unroll
        for (int j = 0; j < 4; ++j) { const int lp = (w4 + j) * 64 + lane;
            const float mu = fmaxf(ms, Rm[j]), mu_last = __shfl(mu, 63), b_last = __shfl(bs[j], 63);
            *(f32x4*)(GS + (size_t)lp * 8) = (f32x4){rr[j], mu, expf(ms - mu), expf(-(bs[j] + mu))};
            *(f32x2*)(GS + (size_t)lp * 8 + 4) = (f32x2){expf(rr[j] - mu_last), expf(ms - mu_last)};
            ms = b_last + mu_last; }
        __syncthreads();
    }
    const bf16* XMg = (const bf16*)(ws + WS_XM); bf16* XCg = (bf16*)(ws + WS_XC);
    const int col = 8 * lane;
    float cw[5][8], cb[8];
#pragma unroll
    for (int e = 0; e < 8; ++e) { cb[e] = a.in[I_CONVB][col + e];
#pragma unroll
        for (int j = 0; j < 5; ++j) cw[j][e] = a.in[I_CONVW][j * 512 + col + e]; }
    for (int grp = gw; grp < MTOK / 8; grp += NGW) {
        const int row0 = grp * 8, s0 = row0 & (SEQ - 1);
        u32x4 xv[12];
        if (grp == gw) {
#pragma unroll
            for (int i = 0; i < 12; ++i) xv[i] = xpre[i];
        } else {
#pragma unroll
            for (int i = 0; i < 12; ++i) { const int sp = s0 + i - 2; xv[i] = (u32x4){0u, 0u, 0u, 0u}; if (sp >= 0 && sp < SEQ) xv[i] = *(const u32x4*)(XMg + (size_t)(row0 + i - 2) * 512 + col); }
        }
#pragma unroll
        for (int r = 0; r < 8; ++r) { float z[8];
#pragma unroll
            for (int e = 0; e < 8; ++e) z[e] = cb[e];
#pragma unroll
            for (int j = 0; j < 5; ++j) { const u32x4 x = xv[r + j];
                z[0] += cw[j][0] * bflo(x.x); z[1] += cw[j][1] * bfhi(x.x); z[2] += cw[j][2] * bflo(x.y); z[3] += cw[j][3] * bfhi(x.y);
                z[4] += cw[j][4] * bflo(x.z); z[5] += cw[j][5] * bfhi(x.z); z[6] += cw[j][6] * bflo(x.w); z[7] += cw[j][7] * bfhi(x.w); }
            u32x4 o; o.x = pk2(siluf_(z[0]), siluf_(z[1])); o.y = pk2(siluf_(z[2]), siluf_(z[3])); o.z = pk2(siluf_(z[4]), siluf_(z[5])); o.w = pk2(siluf_(z[6]), siluf_(z[7]));
            *(u32x4*)(XCg + (size_t)(row0 + r) * 512 + col) = o; }
    }
}

constexpr int ML_XM = 0, ML_XC = 16384, ML_QS = 32768, ML_KS = 51200, ML_VT = 69632, ML_KT = 88064, ML_P = 108544, ML_CB = 118784, ML_SC = 153600;
constexpr int RPQ = 288, RQ = 160, RPC = 272, RQV = 144;
__device__ __forceinline__ int sw128(int row, int off) { return row * 256 + ((((off) >> 4) ^ (row & 15)) << 4) + (off & 15); }
__device__ __forceinline__ int sw64(int row, int off) { return row * 128 + ((((off) >> 4) ^ ((row >> 1) & 7)) << 4) + (off & 15); }
__device__ __forceinline__ int xsw(int row, int chunk) { return row * 256 + ((chunk ^ (row & 15)) << 4); }
constexpr int SC_R = 0, SC_MU = 64, SC_WI = 128, SC_ME = 192, SC_WS = 256, SC_DEN = 320, SC_NQ = 384, SC_DEC = 448, SC_BUF = 512, SC_N = 1024, SC_NB = 1152;
static_assert(ML_SC + (SC_NB + 64) * 4 <= MISC_OFF, "mLSTM LDS map");
typedef __bf16 bf16x2v __attribute__((ext_vector_type(2)));
__device__ __forceinline__ float dot2bf(unsigned a, unsigned b, float c) { return __builtin_amdgcn_fdot2_f32_bf16(__builtin_bit_cast(bf16x2v, a), __builtin_bit_cast(bf16x2v, b), c, false); }
#define MFMA16(a, b, c) __builtin_amdgcn_mfma_f32_16x16x32_bf16((a), (b), (c), 0, 0, 0)
__device__ __forceinline__ void mlstm_chain(const Args& a, unsigned char* ws, LAS unsigned char* lds, int cid, int tid, int wave, int lane) {
    const int b = cid >> 3, h = (cid >> 1) & 3, dir = cid & 1;
    const bf16* XMg = (const bf16*)(ws + WS_XM) + (size_t)b * SEQ * 512 + h * 128; const bf16* XCg = (const bf16*)(ws + WS_XC) + (size_t)b * SEQ * 512 + h * 128;
    const float* GS = (const float*)(ws + WS_GS) + (size_t)cid * SEQ * 8; bf16* HO = (bf16*)(ws + (dir ? WS_HB : WS_HF)) + (size_t)b * SEQ * 512 + h * 128;
    const bf16* WQ = (const bf16*)(ws + WS_WQKV) + (size_t)(0 * 4 + h) * 16384; const bf16* WK = (const bf16*)(ws + WS_WQKV) + (size_t)(1 * 4 + h) * 16384; const bf16* WV = (const bf16*)(ws + WS_WQKV) + (size_t)(2 * 4 + h) * 16384;
    LAS float* sc = (LAS float*)(lds + ML_SC);
    for (int i = tid; i < (ML_SC - ML_P) / 16; i += NTHREADS) *(LAS u32x4*)(lds + ML_P + i * 16) = (u32x4){0u, 0u, 0u, 0u};
    if (tid < 128) sc[SC_N + tid] = 0.f;
    if (tid < 64) sc[SC_NB + tid] = 0.f;
    for (int i = tid; i < 64 * 16; i += NTHREADS) { const int lr = i >> 4, cc = i & 15, pos = dir ? (SEQ - 1 - lr) : lr;
        *(LAS u32x4*)(lds + ML_XM + xsw(lr, cc)) = *(const u32x4*)(XMg + (size_t)pos * 512 + cc * 8);
        *(LAS u32x4*)(lds + ML_XC + xsw(lr, cc)) = *(const u32x4*)(XCg + (size_t)pos * 512 + cc * 8); }
    if (wave == 0) { const f32x4 g0 = *(const f32x4*)(GS + (size_t)lane * 8); const f32x2 g1 = *(const f32x2*)(GS + (size_t)lane * 8 + 4);
        sc[SC_R + lane] = g0[0]; sc[SC_MU + lane] = g0[1]; sc[SC_WI + lane] = g0[2]; sc[SC_ME + lane] = g0[3]; sc[SC_WS + lane] = g1[0]; sc[SC_DEN + lane] = 0.f; if (lane == 0) sc[SC_DEC] = g1[1]; }
    bf16x8 bq[4], bk[4], bv[4];
#pragma unroll
    for (int ks = 0; ks < 4; ++ks) { const size_t o = (size_t)(16 * wave + (lane & 15)) * 128 + 32 * ks + 8 * (lane >> 4); bq[ks] = *(const bf16x8*)(WQ + o); bk[ks] = *(const bf16x8*)(WK + o); bv[ks] = *(const bf16x8*)(WV + o); }
#pragma unroll
    for (int ks = 0; ks < 4; ++ks) asm volatile("" : "+v"(bq[ks]), "+v"(bk[ks]), "+v"(bv[ks]));
    f32x4 accC[8];
#pragma unroll
    for (int nt = 0; nt < 8; ++nt) accC[nt] = (f32x4){0.f, 0.f, 0.f, 0.f};
    __syncthreads();
#pragma unroll 1
    for (int ci = 0; ci < SEQ / 64; ++ci) {
        const int p0 = ci * 64;
        int tidv = tid; asm volatile("" : "+v"(tidv));
        const int lanev = tidv & 63, r16 = lanev & 15, q4 = lanev >> 4;
        LAS float* scc = sc + (ci & 1) * SC_BUF; LAS float* scn = sc + ((ci & 1) ^ 1) * SC_BUF;
        u32x4 pxm[2], pxc[2]; f32x4 pg0 = {0.f, 0.f, 0.f, 0.f}; f32x2 pg1 = {0.f, 0.f};
        const bool more = (ci + 1 < SEQ / 64);
#pragma unroll
        for (int i = 0; i < 2; ++i) { const int idx = tidv + NTHREADS * i, lr = idx >> 4, cc = idx & 15, lp = p0 + 64 + lr, pos = dir ? (SEQ - 1 - lp) : lp;
            pxm[i] = (u32x4){0u, 0u, 0u, 0u}; pxc[i] = pxm[i];
            if (more) { pxm[i] = *(const u32x4*)(XMg + (size_t)pos * 512 + cc * 8); pxc[i] = *(const u32x4*)(XCg + (size_t)pos * 512 + cc * 8); } }
        if (wave == 0 && more) { pg0 = *(const f32x4*)(GS + (size_t)(p0 + 64 + lanev) * 8); pg1 = *(const f32x2*)(GS + (size_t)(p0 + 64 + lanev) * 8 + 4); }
        {
            f32x4 aq[4], ak[4], av[4];
#pragma unroll
            for (int mt = 0; mt < 4; ++mt) { aq[mt] = (f32x4){0.f, 0.f, 0.f, 0.f}; ak[mt] = aq[mt]; av[mt] = aq[mt]; }
            bf16x8 xa0[4], xv0[4], xa1[4], xv1[4];
#define ML_LDX(XA, XV, MT) _Pragma("unroll") for (int ks = 0; ks < 4; ++ks) { XA[ks] = *(const LAS bf16x8*)(lds + ML_XC + xsw(16 * (MT) + r16, 4 * ks + q4)); XV[ks] = *(const LAS bf16x8*)(lds + ML_XM + xsw(16 * (MT) + r16, 4 * ks + q4)); }
#define ML_MMX(XA, XV, MT) _Pragma("unroll") for (int ks = 0; ks < 4; ++ks) { aq[MT] = MFMA16(bq[ks], XA[ks], aq[MT]); ak[MT] = MFMA16(XA[ks], bk[ks], ak[MT]); av[MT] = MFMA16(XV[ks], bv[ks], av[MT]); }
            ML_LDX(xa0, xv0, 0)
            ML_LDX(xa1, xv1, 1)
            __builtin_amdgcn_sched_barrier(0);
            ML_MMX(xa0, xv0, 0)
            ML_LDX(xa0, xv0, 2)
            __builtin_amdgcn_sched_barrier(0);
            ML_MMX(xa1, xv1, 1)
            ML_LDX(xa1, xv1, 3)
            __builtin_amdgcn_sched_barrier(0);
            ML_MMX(xa0, xv0, 2)
            __builtin_amdgcn_sched_barrier(0);
            ML_MMX(xa1, xv1, 3)
#undef ML_LDX
#undef ML_MMX
#pragma unroll
            for (int mt = 0; mt < 4; ++mt) {
                u32x2 w2; w2.x = pk2(aq[mt][0], aq[mt][1]); w2.y = pk2(aq[mt][2], aq[mt][3]);
                *(LAS u32x2*)(lds + ML_QS + sw128(16 * mt + r16, (16 * wave + 4 * q4) * 2)) = w2;
                const f32x4 ws4 = *(const LAS f32x4*)(scc + SC_WS + 16 * mt + 4 * q4);
                w2.x = pk2(ak[mt][0] * ws4[0], ak[mt][1] * ws4[1]); w2.y = pk2(ak[mt][2] * ws4[2], ak[mt][3] * ws4[3]);
                *(LAS u32x2*)(lds + ML_KT + sw64(16 * wave + r16, (16 * mt + 4 * q4) * 2)) = w2;
                {
                  float y0 = ak[mt][0], y1 = ak[mt][1], y2 = ak[mt][2], y3 = ak[mt][3]; const bool o1 = (r16 & 1) != 0, o2 = (r16 & 2) != 0;
#define ML_XCH(A, B, ODD, CTRL) { const float s_ = (ODD) ? A : B; const float r_ = __builtin_bit_cast(float, __builtin_amdgcn_mov_dpp(__builtin_bit_cast(int, s_), CTRL, 0xf, 0xf, true)); if (ODD) A = r_; else B = r_; }
                  ML_XCH(y0, y1, o1, 0xB1) ML_XCH(y2, y3, o1, 0xB1)
                  ML_XCH(y0, y2, o2, 0x4E) ML_XCH(y1, y3, o2, 0x4E)
#undef ML_XCH
                  u32x2 kw; kw.x = pk2(y0, y1); kw.y = pk2(y2, y3);
                  *(LAS u32x2*)(lds + ML_KS + (16 * mt + 4 * q4 + (r16 & 3)) * RPQ + (16 * wave + (r16 & ~3)) * 2) = kw; }
                w2.x = pk2(av[mt][0], av[mt][1]); w2.y = pk2(av[mt][2], av[mt][3]);
                *(LAS u32x2*)(lds + ML_VT + sw64(16 * wave + r16, (16 * mt + 4 * q4) * 2)) = w2;
            }
        }
        __syncthreads();
        f32x4 num[4];
        {
            bf16x8 cb[4], qa0[4], qa1[4], sa[4], sb[4];
            const int mt1 = wave >= 6 ? 3 : wave >= 3 ? 2 : wave >= 1 ? 1 : 0, nt1 = wave - (mt1 * (mt1 + 1)) / 2;
#define ML_LDQ(Q, MT) _Pragma("unroll") for (int ks = 0; ks < 4; ++ks) Q[ks] = *(const LAS bf16x8*)(lds + ML_QS + sw128(16 * (MT) + r16, (32 * ks + 8 * q4) * 2));
#define ML_MMQ(Q, MT) _Pragma("unroll") for (int ks = 0; ks < 4; ++ks) num[MT] = MFMA16(cb[ks], Q[ks], num[MT]);
#define ML_LDS_(MT, NT) _Pragma("unroll") for (int ks = 0; ks < 4; ++ks) { sa[ks] = *(const LAS bf16x8*)(lds + ML_QS + sw128(16 * (MT) + r16, (32 * ks + 8 * q4) * 2)); sb[ks] = *(const LAS bf16x8*)(lds + ML_KS + (16 * (NT) + r16) * RPQ + (32 * ks + 8 * q4) * 2); }
#define ML_STILE(MT, NT, MU, R4) { f32x4 s = {0.f, 0.f, 0.f, 0.f}; \
                _Pragma("unroll") for (int ks = 0; ks < 4; ++ks) s = MFMA16(sb[ks], sa[ks], s);     \
                const int t = 16 * (MT) + r16; float p[4], psum = 0.f; \
                _Pragma("unroll") for (int reg = 0; reg < 4; ++reg) { const int sidx = 16 * (NT) + 4 * q4 + reg; const float w = (sidx <= t) ? fexp(fminf(R4[reg] - MU, 0.f)) : 0.f; p[reg] = s[reg] * w; psum += p[reg]; } \
                u32x2 w2; w2.x = pk2(p[0], p[1]); w2.y = pk2(p[2], p[3]); \
                *(LAS u32x2*)(lds + ML_P + sw64(t, (16 * (NT) + 4 * q4) * 2)) = w2; \
                psum += __shfl_xor(psum, 16); psum += __shfl_xor(psum, 32); \
                if (q4 == 0) atomicAdd((float*)(scc + SC_DEN + t), psum); }
#pragma unroll
            for (int ks = 0; ks < 4; ++ks) cb[ks] = *(const LAS bf16x8*)(lds + ML_CB + sw128(16 * wave + r16, (32 * ks + 8 * q4) * 2));
            ML_LDQ(qa0, 0)
            ML_LDQ(qa1, 1)
            ML_LDS_(mt1, nt1)
            const float mu1 = scc[SC_MU + 16 * mt1 + r16]; const f32x4 r41 = *(const LAS f32x4*)(scc + SC_R + 16 * nt1 + 4 * q4);
#pragma unroll
            for (int mt = 0; mt < 4; ++mt) num[mt] = (f32x4){0.f, 0.f, 0.f, 0.f};
            __builtin_amdgcn_sched_barrier(0);
            ML_MMQ(qa0, 0)
            ML_LDQ(qa0, 2)
            __builtin_amdgcn_sched_barrier(0);
            ML_MMQ(qa1, 1)
            ML_LDQ(qa1, 3)
            __builtin_amdgcn_sched_barrier(0);
            ML_STILE(mt1, nt1, mu1, r41)
            ML_MMQ(qa0, 2)
            __builtin_amdgcn_sched_barrier(0);
            ML_MMQ(qa1, 3)
            if (wave < 2) {
                ML_LDS_(3, 2 + wave)
                const float mu2 = scc[SC_MU + 48 + r16]; const f32x4 r42 = *(const LAS f32x4*)(scc + SC_R + 16 * (2 + wave) + 4 * q4);
                ML_STILE(3, 2 + wave, mu2, r42)
            }
#undef ML_LDQ
#undef ML_MMQ
#undef ML_LDS_
#undef ML_STILE
            { const int t = tidv >> 3, part = tidv & 7; float s = 0.f;
              const u32x4 qa = *(const LAS u32x4*)(lds + ML_QS + sw128(t, part * 32)), qb = *(const LAS u32x4*)(lds + ML_QS + sw128(t, part * 32 + 16));
              const u32x4 na = *(const LAS u32x4*)((const LAS unsigned char*)(sc + SC_NB) + part * 32), nb = *(const LAS u32x4*)((const LAS unsigned char*)(sc + SC_NB) + part * 32 + 16);
              s = dot2bf(qa.x, na.x, s); s = dot2bf(qa.y, na.y, s); s = dot2bf(qa.z, na.z, s); s = dot2bf(qa.w, na.w, s);
              s = dot2bf(qb.x, nb.x, s); s = dot2bf(qb.y, nb.y, s); s = dot2bf(qb.z, nb.z, s); s = dot2bf(qb.w, nb.w, s);
              s += __shfl_xor(s, 1); s += __shfl_xor(s, 2); s += __shfl_xor(s, 4);
              if (part == 0) scc[SC_NQ + t] = s; }
        }
        __syncthreads();
        {
            bf16x8 vt[2], pf[4][2], kt0[4][2], kt1[4][2]; float wi[4], dn[4], nqv[4], me[4];
#pragma unroll
            for (int ks = 0; ks < 2; ++ks) vt[ks] = *(const LAS bf16x8*)(lds + ML_VT + sw64(16 * wave + r16, (32 * ks + 8 * q4) * 2));
#pragma unroll
            for (int mt = 0; mt < 4; ++mt) {
#pragma unroll
                for (int ks = 0; ks < 2; ++ks) pf[mt][ks] = *(const LAS bf16x8*)(lds + ML_P + sw64(16 * mt + r16, (32 * ks + 8 * q4) * 2));
                const int t = 16 * mt + r16; wi[mt] = scc[SC_WI + t]; dn[mt] = scc[SC_DEN + t]; nqv[mt] = scc[SC_NQ + t]; me[mt] = scc[SC_ME + t]; }
            const float decay = scc[SC_DEC];
#pragma unroll
            for (int nt = 0; nt < 4; ++nt)
#pragma unroll
                for (int ks = 0; ks < 2; ++ks) kt0[nt][ks] = *(const LAS bf16x8*)(lds + ML_KT + sw64(16 * nt + r16, (32 * ks + 8 * q4) * 2));
            __builtin_amdgcn_sched_barrier(0);
#pragma unroll
            for (int mt = 0; mt < 4; ++mt) {
                const int t = 16 * mt + r16;
                num[mt] = num[mt] * wi[mt];
#pragma unroll
                for (int ks = 0; ks < 2; ++ks) num[mt] = MFMA16(vt[ks], pf[mt][ks], num[mt]);
                const float den = dn[mt] + wi[mt] * nqv[mt], inv = frcp(fmaxf(fabsf(den), me[mt]));
                const int lp = p0 + t, pos = dir ? (SEQ - 1 - lp) : lp;
                u32x2 w2; w2.x = pk2(num[mt][0] * inv, num[mt][1] * inv); w2.y = pk2(num[mt][2] * inv, num[mt][3] * inv);
                *(u32x2*)(HO + (size_t)pos * 512 + 16 * wave + 4 * q4) = w2;
            }
#pragma unroll
            for (int nt = 0; nt < 4; ++nt)
#pragma unroll
                for (int ks = 0; ks < 2; ++ks) kt1[nt][ks] = *(const LAS bf16x8*)(lds + ML_KT + sw64(16 * (nt + 4) + r16, (32 * ks + 8 * q4) * 2));
            __builtin_amdgcn_sched_barrier(0);
#pragma unroll
            for (int nt = 0; nt < 4; ++nt) {
                accC[nt] = accC[nt] * decay;
#pragma unroll
                for (int ks = 0; ks < 2; ++ks) accC[nt] = MFMA16(kt0[nt][ks], vt[ks], accC[nt]);
                u32x2 w2; w2.x = pk2(accC[nt][0], accC[nt][1]); w2.y = pk2(accC[nt][2], accC[nt][3]);
                *(LAS u32x2*)(lds + ML_CB + sw128(16 * wave + r16, (16 * nt + 4 * q4) * 2)) = w2;
            }
            __builtin_amdgcn_sched_barrier(0);
#pragma unroll
            for (int nt = 4; nt < 8; ++nt) {
                accC[nt] = accC[nt] * decay;
#pragma unroll
                for (int ks = 0; ks < 2; ++ks) accC[nt] = MFMA16(kt1[nt - 4][ks], vt[ks], accC[nt]);
                u32x2 w2; w2.x = pk2(accC[nt][0], accC[nt][1]); w2.y = pk2(accC[nt][2], accC[nt][3]);
                *(LAS u32x2*)(lds + ML_CB + sw128(16 * wave + r16, (16 * nt + 4 * q4) * 2)) = w2;
            }
            if (tidv < 128) { float s = 0.f; const unsigned ones = 0x3f803f80u;
#pragma unroll
                for (int j = 0; j < 8; ++j) { const u32x4 kv = *(const LAS u32x4*)(lds + ML_KT + sw64(tidv, j * 16));
                    s = dot2bf(kv.x, ones, s); s = dot2bf(kv.y, ones, s); s = dot2bf(kv.z, ones, s); s = dot2bf(kv.w, ones, s); }
                const float nn = decay * sc[SC_N + tidv] + s; sc[SC_N + tidv] = nn;
                ((LAS bf16*)(sc + SC_NB))[tidv] = (bf16)(pk2(nn, 0.f) & 0xffffu); }
#pragma unroll
            for (int i = 0; i < 2; ++i) { const int idx = tidv + NTHREADS * i, lr = idx >> 4, cc = idx & 15;
                *(LAS u32x4*)(lds + ML_XM + xsw(lr, cc)) = pxm[i]; *(LAS u32x4*)(lds + ML_XC + xsw(lr, cc)) = pxc[i]; }
            if (wave == 0) { scn[SC_R + lanev] = pg0[0]; scn[SC_MU + lanev] = pg0[1]; scn[SC_WI + lanev] = pg0[2]; scn[SC_ME + lanev] = pg0[3]; scn[SC_WS + lanev] = pg1[0]; scn[SC_DEN + lanev] = 0.f;
                if (lanev == 0) scn[SC_DEC] = pg1[1]; }
        }
        __syncthreads();
    }
}

__device__ __forceinline__ void ml_combine(const Args& a, unsigned char* ws, int gw, int NGW, int lane) {
    const bf16* HF = (const bf16*)(ws + WS_HF); const bf16* HB = (const bf16*)(ws + WS_HB); const bf16* XCg = (const bf16*)(ws + WS_XC); const bf16* OP = (const bf16*)(ws + WS_OP);
    bf16* YC = (bf16*)(ws + WS_YCAT);
    const int col = 8 * lane;
    float hn[8], sk[8];
#pragma unroll
    for (int e = 0; e < 8; ++e) { hn[e] = a.in[I_HNORM][col + e]; sk[e] = a.in[I_SKIP][col + e]; }
    for (int grp = gw; grp < MTOK / 4; grp += NGW) {
        u32x4 hf[4], hb[4], ov[4], xc[4];
#pragma unroll
        for (int r = 0; r < 4; ++r) { const size_t o = (size_t)(grp * 4 + r) * 512 + col; hf[r] = *(const u32x4*)(HF + o); hb[r] = *(const u32x4*)(HB + o); ov[r] = *(const u32x4*)(OP + o); xc[r] = *(const u32x4*)(XCg + o); }
#pragma unroll
        for (int r = 0; r < 4; ++r) {
            float hv[8] = {bflo(hf[r].x) + bflo(hb[r].x), bfhi(hf[r].x) + bfhi(hb[r].x), bflo(hf[r].y) + bflo(hb[r].y), bfhi(hf[r].y) + bfhi(hb[r].y), bflo(hf[r].z) + bflo(hb[r].z), bfhi(hf[r].z) + bfhi(hb[r].z), bflo(hf[r].w) + bflo(hb[r].w), bfhi(hf[r].w) + bfhi(hb[r].w)};
            float sm = 0.f;
#pragma unroll
            for (int e = 0; e < 8; ++e) sm += hv[e];
            sm += __shfl_xor(sm, 1); sm += __shfl_xor(sm, 2); sm += __shfl_xor(sm, 4); sm += __shfl_xor(sm, 8);
            const float mean = sm * (1.f / DH); float vs = 0.f;
#pragma unroll
            for (int e = 0; e < 8; ++e) { hv[e] -= mean; vs += hv[e] * hv[e]; }
            vs += __shfl_xor(vs, 1); vs += __shfl_xor(vs, 2); vs += __shfl_xor(vs, 4); vs += __shfl_xor(vs, 8);
            const float rstd = __builtin_amdgcn_rsqf(vs * (1.f / DH) + EPS);
            const float og[8] = {bflo(ov[r].x), bfhi(ov[r].x), bflo(ov[r].y), bfhi(ov[r].y), bflo(ov[r].z), bfhi(ov[r].z), bflo(ov[r].w), bfhi(ov[r].w)};
            const float xg[8] = {bflo(xc[r].x), bfhi(xc[r].x), bflo(xc[r].y), bfhi(xc[r].y), bflo(xc[r].z), bfhi(xc[r].z), bflo(xc[r].w), bfhi(xc[r].w)};
            float o[8];
#pragma unroll
            for (int e = 0; e < 8; ++e) o[e] = sigmoidf_(og[e]) * (hv[e] * rstd * hn[e] + sk[e] * xg[e]);
            u32x4 w; w.x = pk2(o[0], o[1]); w.y = pk2(o[2], o[3]); w.z = pk2(o[4], o[5]); w.w = pk2(o[6], o[7]);
            *(u32x4*)(YC + (size_t)(grp * 4 + r) * 1024 + 512 + col) = w;
        }
    }
}

__global__ void __launch_bounds__(NTHREADS, 2) hyb_fwd(Args args) {
    extern __shared__ __attribute__((aligned(16))) unsigned char lds_raw[];
    LAS unsigned char* lds = (LAS unsigned char*)lds_raw;
    volatile LAS unsigned* MISC = (volatile LAS unsigned*)(lds + MISC_OFF);
    const int tid = threadIdx.x, lane = tid & 63, wave = __builtin_amdgcn_readfirstlane(tid >> 6);
    const int G = gridDim.x, bx = blockIdx.x, vcu = (G % 8 == 0) ? (bx % 8) * (G / 8) + bx / 8 : bx;
    const int gw = vcu * NWAVES + wave, NGW = G * NWAVES;
    unsigned char* ws = args.ws;
    for (int u = tid; u < (LDS_BYTES - MISC_OFF) / 4; u += NTHREADS) ((LAS unsigned*)(lds + MISC_OFF))[u] = 0u;
    __syncthreads();
    const int lo = args.ph_lo, hi = args.ph_hi;
    const bool one = (hi - lo) > 1;
    XcdBarrier bar; bar.bar = (unsigned*)(ws + WS_CTL) + CW_BAR; bar.x = 0; bar.st = nullptr;
    if (one) bar = xcd_barrier_post((unsigned*)(ws + WS_CTL) + CW_BAR, MISC + 8);
#define IN(k) (lo <= (k) && (k) < hi)
#define SEAM(k) do { if (one) xcd_barrier(bar); } while (0)

    if (IN(0)) { p0_prologue(args, ws, lds, tid, wave, lane, vcu, G); SEAM(0); }
    if (IN(1)) {
        pg8::Gemm g{(const bf16*)(ws + WS_XB), (const bf16*)(ws + WS_WIN), DM, DM, DM}; pg8::StaticOrder S; S.init(MTOK, NPROJ, G, bx);
        pg8::EpiP1 E{(const float*)(ws + WS_RS1), (bf16*)(ws + WS_UX), (bf16*)(ws + WS_XM), (bf16*)(ws + WS_OP)};
        pg8::gemm_phase<pg8::EpiP1, pg8::StaticOrder, true>(lds, g, S, E);
        SEAM(1);
    }
    if (IN(2)) {
        if (G == 256) {
            { pg8::Gemm g{(const bf16*)(ws + WS_UX), (const bf16*)(ws + WS_MZ), 512, 256, 256}; pg8::S5One S{bx}; pg8::EpiZL E{};
              pg8::gemm_phase<pg8::EpiZL, pg8::S5One, true, true>(lds, g, S, E); }
            __syncthreads();
            s5_scan_lds(args, ws, lds, bx, tid);
            __syncthreads();
            { pg8::Gemm g{(const bf16*)(ws + WS_UX), (const bf16*)(ws + WS_MZ), 512, 256, 256}; pg8::S5One S{G + bx}; pg8::EpiZL E{};
              pg8::gemm_phase<pg8::EpiZL, pg8::S5One, true, true>(lds, g, S, E); }
            __syncthreads();
            s5_scan_lds(args, ws, lds, G + bx, tid);
            VM_WAIT(); __syncthreads();
        } else {
            { pg8::Gemm g{(const bf16*)(ws + WS_UX), (const bf16*)(ws + WS_MZ), 512, 256, 256}; pg8::S5Order S{G, bx}; pg8::EpiZ E{(bf16*)(ws + WS_ZB)};
              pg8::gemm_phase<pg8::EpiZ, pg8::S5Order, true>(lds, g, S, E); }
            VM_WAIT(); __syncthreads();
            s5_scan(args, ws, tid, G);
            VM_WAIT(); __syncthreads();
        }
        { pg8::Gemm g{(const bf16*)(ws + WS_UX), (const bf16*)(ws + WS_TMY), 512, 512, 512}; pg8::S5Order S{G, bx}; pg8::EpiY E{(bf16*)(ws + WS_YACT)};
          pg8::gemm_phase<pg8::EpiY, pg8::S5Order, true>(lds, g, S, E); }
        ml_pre(args, ws, lds, gw, NGW, wave, lane, G);
        SEAM(2);
    }
    if (IN(3)) {
        { pg8::Gemm g{(const bf16*)(ws + WS_YACT), (const bf16*)(ws + WS_WGLU), 512, 512, 512}; pg8::StaticOrder S; S.init(MTOK, 512, G, bx);
          pg8::EpiGLU E{(const bf16*)(ws + WS_YACT), args.in[I_BGLU], (bf16*)(ws + WS_YCAT)};
          pg8::gemm_phase<pg8::EpiGLU, pg8::StaticOrder, true>(lds, g, S, E); }
        __syncthreads();
        for (int cid = bx; cid < BATCH * NH * 2; cid += G) mlstm_chain(args, ws, lds, cid, tid, wave, lane);
        SEAM(3);
    }
    if (IN(4)) { ml_combine(args, ws, gw, NGW, lane); SEAM(4); }
    if (IN(5)) { }
    unsigned* const ctlw = (unsigned*)(ws + WS_CTL);
    if (IN(6)) {
        pg8::Gemm g{(const bf16*)(ws + WS_YCAT), (const bf16*)(ws + WS_WOUT), DM, DM, DM}; pg8::StaticOrder S; S.init(MTOK, DM, G, bx);
        pg8::PanelSS s1{(unsigned long long*)(ws + WS_XS), ctlw + CW_TMO};
        pg8::EpiMid E{(bf16*)(ws + WS_XB), args.in[I_NMPOST], (float*)(ws + WS_RS2), s1};
        pg8::gemm_phase<pg8::EpiMid, pg8::StaticOrder, true>(lds, g, S, E);
        SEAM(6);
    }
    if (IN(8)) {
        { pg8::Gemm g{(const bf16*)(ws + WS_XB), (const bf16*)(ws + WS_WGU), DM, DM, DM}; pg8::PassOrder S; S.init(MTOK, G, bx);
          pg8::EpiGU E{(const float*)(ws + WS_RS2), (bf16*)(ws + WS_ACT), 0};
          pg8::gemm_phase<pg8::EpiGU, pg8::PassOrder, true>(lds, g, S, E); }
        SEAM(8);
    }
    if (IN(9)) {
        pg8::Gemm g{(const bf16*)(ws + WS_ACT), (const bf16*)(ws + WS_WDN), DFF, DFF, DFF}; pg8::StaticOrder S; S.init(MTOK, DM, G, bx);
        pg8::PanelSS s3{(unsigned long long*)(ws + WS_XS) + (size_t)MTOK * 8, ctlw + CW_TMO};
        pg8::EpiOut E{(const bf16*)(ws + WS_XB), args.in[I_NFPOST], args.out, s3};
        pg8::gemm_phase<pg8::EpiOut, pg8::StaticOrder, true>(lds, g, S, E);
    }
#undef IN
#undef SEAM
}

extern "C" void kernel_launch(void* const* d_in, const int* in_sizes, int n_in, void* d_out, int out_size, void* d_ws, size_t ws_size, hipStream_t stream) {
    static int grid = 0;
    if (grid == 0) {
        if (n_in != 28 || in_sizes[0] != MTOK * DM || out_size != MTOK * DM || ws_size < WS_END) { fprintf(stderr, "kernel_launch: unexpected shapes (n_in %d, in0 %d, out %d, ws %zu); nothing launched\n", n_in, n_in > 0 ? in_sizes[0] : -1, out_size, ws_size); grid = -1; return; }
        int dev = 0, cus = 0;
        if (hipGetDevice(&dev) != hipSuccess || hipDeviceGetAttribute(&cus, hipDeviceAttributeMultiprocessorCount, dev) != hipSuccess) { grid = -1; return; }
        if (hipFuncSetAttribute((const void*)hyb_fwd, hipFuncAttributeMaxDynamicSharedMemorySize, LDS_BYTES) != hipSuccess) { fprintf(stderr, "kernel_launch: hipFuncSetAttribute failed\n"); grid = -1; return; }
        int per_cu = 0;
        if (hipOccupancyMaxActiveBlocksPerMultiprocessor(&per_cu, (const void*)hyb_fwd, NTHREADS, LDS_BYTES) != hipSuccess || per_cu < 1) fprintf(stderr, "kernel_launch: occupancy query reports %d\n", per_cu);
        (void)hipGetLastError();
        if (cus < 256) { fprintf(stderr, "kernel_launch: built for a 256-CU device (got %d CUs); nothing launched\n", cus); grid = -1; return; }
        grid = 256;
    }
    if (grid < 0) return;
    (void)hipMemsetAsync((char*)d_ws + WS_CTL, 0, CTL_ZERO_BYTES, stream);
    Args a{};
    for (int i = 0; i < 28; ++i) a.in[i] = (const float*)d_in[i];
    a.out = (float*)d_out; a.ws = (unsigned char*)d_ws; a.pad0 = 0; a.pad1 = 0;
    a.ph_lo = 0; a.ph_hi = N_PHASES;
    hipLaunchKernelGGL(hyb_fwd, dim3(grid), dim3(NTHREADS), LDS_BYTES, stream, a);
}
```

```cpp
#include <hip/hip_runtime.h>
#include <cstdio>
#include <cstdint>


#define GAS __attribute__((address_space(1)))
#define LAS __attribute__((address_space(3)))
typedef unsigned short bf16;
typedef short bf16x8 __attribute__((ext_vector_type(8)));
typedef float f32x4 __attribute__((ext_vector_type(4)));
typedef float f32x2 __attribute__((ext_vector_type(2)));
typedef unsigned u32x4 __attribute__((ext_vector_type(4)));
typedef unsigned u32x2 __attribute__((ext_vector_type(2)));
typedef __bf16 bf16x2_t __attribute__((ext_vector_type(2)));
typedef GAS unsigned gu32;

constexpr int BATCH = 32, SEQ = 2048, DM = 1024, MTOK = BATCH * SEQ;
constexpr int D_S5 = 512, D_ML = 512, NG = 32, GC = 16, SP = 64, NH = 4, DH = 128, D_IN = 1552, DFF = 2816, NPROJ = 1536;
constexpr int S5L = 16, S5NCH = SEQ / S5L, S5ROWS = BATCH * S5NCH;
constexpr float EPS = 1e-6f;
constexpr int NWAVES = 8, NTHREADS = 512;
constexpr int N_PHASES = 11;

constexpr size_t MiB = 1u << 20;
constexpr size_t WS_CTL = 0, CTL_ZERO_BYTES = 32 * 1024;
constexpr size_t WS_WIN = 1 * MiB;
constexpr size_t WS_WGLU = 4 * MiB;
constexpr size_t WS_WQKV = 5 * MiB;
constexpr size_t WS_WOUT = 6 * MiB;
constexpr size_t WS_WGU = 8 * MiB;
constexpr size_t WS_WDN = 19 * MiB;
constexpr size_t WS_MZ = 25 * MiB;
constexpr size_t WS_TMY = 29 * MiB;
constexpr size_t WS_RS1 = 37 * MiB;
constexpr size_t WS_RS2 = 48 * MiB;
constexpr size_t WS_GATES = 38 * MiB;
constexpr size_t WS_XS = 42 * MiB;
constexpr size_t WS_XB = 64 * MiB;
constexpr size_t WS_UX = 192 * MiB;
constexpr size_t WS_XM = 320 * MiB;
constexpr size_t WS_OP = 384 * MiB;
constexpr size_t WS_ZB = 448 * MiB;
constexpr size_t WS_YACT = 512 * MiB;
constexpr size_t WS_HF = 576 * MiB;
constexpr size_t WS_HB = 640 * MiB;
constexpr size_t WS_YCAT = 704 * MiB;
constexpr size_t WS_ACT = 192 * MiB;
constexpr size_t WS_XC = 832 * MiB;
constexpr size_t WS_GS = 896 * MiB;
constexpr size_t WS_END = 960 * MiB;
constexpr int CW_TMO = 0, CW_BAR = 4096;
constexpr size_t WS_A16 = 512 * 1024;
constexpr int CW_PANEL = 16384, PANEL_BANK = 256 * 64;

constexpr int MISC_OFF = 162816;
constexpr int LDS_BYTES = 163840;

__device__ __forceinline__ unsigned pk2(float lo, float hi) { f32x2 v = {lo, hi}; bf16x2_t b = __builtin_convertvector(v, bf16x2_t); return __builtin_bit_cast(unsigned, b); }
__device__ __forceinline__ float bflo(unsigned u) { return __builtin_bit_cast(float, u << 16); }
__device__ __forceinline__ float bfhi(unsigned u) { return __builtin_bit_cast(float, u & 0xffff0000u); }
__device__ __forceinline__ float bf2f(bf16 h) { return __builtin_bit_cast(float, (unsigned)h << 16); }
__device__ __forceinline__ float fexp(float x) { return __expf(x); }
__device__ __forceinline__ float frcp(float x) { return __builtin_amdgcn_rcpf(x); }
__device__ __forceinline__ float sigmoidf_(float z) { return frcp(1.f + fexp(-z)); }
__device__ __forceinline__ float siluf_(float z) { return z * frcp(1.f + fexp(-z)); }
__device__ __forceinline__ float gelu_tanh(float y) { const float t = 1.5957691216057308f * (y + 0.044715f * y * y * y); return y * frcp(1.f + fexp(-t)); }
__device__ __forceinline__ float wave_sum(float v) {
#pragma unroll
    for (int o = 1; o < 64; o <<= 1) v += __shfl_xor(v, o);
    return v;
}
#define LDS_WAIT() asm volatile("s_waitcnt lgkmcnt(0)" ::: "memory")
#define VM_WAIT() asm volatile("s_waitcnt vmcnt(0)" ::: "memory")

namespace pg8 {
constexpr int BM = 256, BK = 64, HALF = 128, HTB = HALF * BK * 2, STAGE_BYTES = 8 * HTB, NXCD = 8, WGM = 4;
__host__ __device__ __forceinline__ int lds_byte(int r, int c) { const int st = (r >> 4) * 2 + (c >> 5), rr = r & 15, cc = c & 31, ob = rr * 64 + cc * 2; return st * 1024 + (ob ^ (((ob >> 9) & 1) << 5)); }
__host__ __device__ __forceinline__ void stage_rc(int b, int& R, int& C) { const int st = b / 1024, sb = b % 1024, swz = sb ^ (((sb >> 9) & 1) << 5); R = (st >> 1) * 16 + swz / 64; C = (st & 1) * 32 + (swz % 64) / 2; }
__host__ __device__ __forceinline__ int perm32(int rho) { const int n = rho >> 4, i = rho & 15; return 8 * (i >> 2) + 4 * n + (i & 3); }

struct Unit { int pm, pn; };
struct Gemm { const bf16* A; const bf16* Bt; int lda, ldb, K; };

struct StaticOrder {
    int nig, nwg, G, qq, rr; int gid, rem, L;
    __device__ void init(int M, int N, int G_, int c_) {
        const int nN = N / BM; nwg = (M / BM) * nN; G = G_; nig = WGM * nN;
        const int w0 = (c_ % NXCD) * (nwg / NXCD) + c_ / NXCD, st = G_ / NXCD; gid = w0 / nig; rem = w0 % nig; qq = st / nig; rr = st % nig; L = c_; }
    __device__ __forceinline__ bool next(int, Unit& u) {
        if (L >= nwg) return false;
        u.pm = gid * WGM + (rem & (WGM - 1)); u.pn = rem / WGM; L += G; gid += qq; rem += rr; if (rem >= nig) { rem -= nig; ++gid; } return true; }
    __device__ __forceinline__ void a_ready(const Unit&) const {}
    __device__ __forceinline__ void done(const Unit&) const {}
};
struct PassOrder {
    StaticOrder so; int M, G, c, p, pn0;
    __device__ static __forceinline__ int nn(int p) { return p < 2 ? 6 : 5; }
    __device__ void init(int M_, int G_, int c_) { M = M_; G = G_; c = c_; p = 0; pn0 = 0; so.init(M, nn(0) * BM, G, c); }
    __device__ __forceinline__ bool next(int i, Unit& u) {
        if (!so.next(i, u)) { if (p == 3) return false; pn0 += nn(p); ++p; so.init(M, nn(p) * BM, G, c); (void)so.next(0, u); }
        u.pn += pn0; return true; }
    __device__ __forceinline__ void a_ready(const Unit&) const {}
    __device__ __forceinline__ void done(const Unit&) const {}
};
struct S5Order {
    int G, c;
    __device__ __forceinline__ bool next(int i, Unit& u) const { const int L = i * G + c; if (L >= NG * 16) return false; u.pm = L; u.pn = L >> 4; return true; }
    __device__ __forceinline__ void a_ready(const Unit&) const {}
    __device__ __forceinline__ void done(const Unit&) const {}
};

__device__ __forceinline__ u32x4 pack8(f32x4 v0, f32x4 v1) { u32x4 w; w.x = pk2(v0[0], v0[1]); w.y = pk2(v0[2], v0[3]); w.z = pk2(v1[0], v1[1]); w.w = pk2(v1[2], v1[3]); return w; }

struct EpiP1 {
    static constexpr bool PEEL = true, PERM = true, AFTER_DRAIN = false; static constexpr int NS = 16;
    const float* rs1; bf16* UX; bf16* XM; bf16* OP;
    __device__ __forceinline__ void pre(const Unit& u, LAS unsigned char* xlds, int tid) const {
        if (tid < 64) __builtin_amdgcn_global_load_lds((const unsigned*)(rs1 + (size_t)u.pm * BM + tid * 4), (LAS unsigned*)xlds, 16, 0, 0); }
    __device__ __forceinline__ void operator()(const f32x4 (&acc)[2][2][4][2], const Unit& u, int wr, int wc, int fr, int fq, const LAS unsigned char* xlds) const {
#pragma unroll
        for (int ai = 0; ai < 2; ++ai)
#pragma unroll
            for (int m = 0; m < 4; ++m) {
                const int row = u.pm * BM + ai * HALF + wr * 64 + m * 16 + fr; const float s = ((const LAS float*)xlds)[ai * HALF + wr * 64 + m * 16 + fr];
#pragma unroll
                for (int bj = 0; bj < 2; ++bj) {
                    const int col = u.pn * BM + bj * HALF + wc * 32 + 8 * fq;
                    const u32x4 w = pack8(acc[ai][bj][m][0] * s, acc[ai][bj][m][1] * s);
                    bf16* dst;
                    if (u.pn < 2) { const int g = col >> 4, c0 = col & 15, b = row >> 11, si = row & 2047, k = si >> 4, t = si & 15;
                        dst = UX + ((size_t)(g * S5ROWS + b * S5NCH + k) * 512 + t * 16 + c0); }
                    else if (u.pn < 4) dst = XM + (size_t)row * 512 + (col - 512);
                    else dst = OP + (size_t)row * 512 + (col - 1024);
                    *(u32x4*)dst = w;
                }
            }
    }
};
struct EpiZ {
    __device__ __forceinline__ void pre(const Unit&, LAS unsigned char*, int) const {}
    static constexpr bool PEEL = false, PERM = true, AFTER_DRAIN = false; static constexpr int NS = 16;
    bf16* Z;
    __device__ __forceinline__ void operator()(const f32x4 (&acc)[2][2][4][2], const Unit& u, int wr, int wc, int fr, int fq, const LAS unsigned char* xlds) const {
#pragma unroll
        for (int ai = 0; ai < 2; ++ai)
#pragma unroll
            for (int m = 0; m < 4; ++m) {
                const size_t row = (size_t)u.pm * BM + ai * HALF + wr * 64 + m * 16 + fr;
#pragma unroll
                for (int bj = 0; bj < 2; ++bj) { const int col = bj * HALF + wc * 32 + 8 * fq; *(u32x4*)(Z + row * 256 + col) = pack8(acc[ai][bj][m][0], acc[ai][bj][m][1]); }
            }
    }
};
constexpr int ZLP = 528;
struct EpiZL {
    __device__ __forceinline__ void pre(const Unit&, LAS unsigned char*, int) const {}
    static constexpr bool PEEL = false, PERM = true, AFTER_DRAIN = false; static constexpr int NS = 0;
    __device__ __forceinline__ void operator()(const f32x4 (&acc)[2][2][4][2], const Unit& u, int wr, int wc, int fr, int fq, const LAS unsigned char* xlds) const {
        LAS unsigned char* zl = const_cast<LAS unsigned char*>(xlds) - STAGE_BYTES;
#pragma unroll
        for (int ai = 0; ai < 2; ++ai)
#pragma unroll
            for (int m = 0; m < 4; ++m) { const int row = ai * HALF + wr * 64 + m * 16 + fr;
#pragma unroll
                for (int bj = 0; bj < 2; ++bj) { const int col = bj * HALF + wc * 32 + 8 * fq; *(LAS u32x4*)(zl + row * ZLP + col * 2) = pack8(acc[ai][bj][m][0], acc[ai][bj][m][1]); } }
    }
};
struct S5One {
    int L;
    __device__ __forceinline__ bool next(int i, Unit& u) const { if (i != 0) return false; u.pm = L; u.pn = L >> 4; return true; }
    __device__ __forceinline__ void a_ready(const Unit&) const {}
    __device__ __forceinline__ void done(const Unit&) const {}
};
struct EpiY {
    __device__ __forceinline__ void pre(const Unit&, LAS unsigned char*, int) const {}
    static constexpr bool PEEL = true, PERM = true, AFTER_DRAIN = false; static constexpr int NS = 16;
    bf16* YACT;
    __device__ __forceinline__ void operator()(const f32x4 (&acc)[2][2][4][2], const Unit& u, int wr, int wc, int fr, int fq, const LAS unsigned char* xlds) const {
        const int g = u.pm >> 4;
#pragma unroll
        for (int ai = 0; ai < 2; ++ai)
#pragma unroll
            for (int m = 0; m < 4; ++m) {
                const int R = u.pm * BM + ai * HALF + wr * 64 + m * 16 + fr, rr = R & (S5ROWS - 1), b = rr >> 7, k = rr & 127;
#pragma unroll
                for (int bj = 0; bj < 2; ++bj) { const int colt = bj * HALF + wc * 32 + 8 * fq, t = colt >> 4, c0 = colt & 15;
                    const size_t token = (size_t)b * SEQ + k * S5L + t;
                    f32x4 v0 = acc[ai][bj][m][0], v1 = acc[ai][bj][m][1];
#pragma unroll
                    for (int e = 0; e < 4; ++e) { v0[e] = gelu_tanh(v0[e]); v1[e] = gelu_tanh(v1[e]); }
                    *(u32x4*)(YACT + token * 512 + g * 16 + c0) = pack8(v0, v1); }
            }
    }
};
struct EpiGLU {
    __device__ __forceinline__ void pre(const Unit&, LAS unsigned char*, int) const {}
    static constexpr bool PEEL = true, PERM = true, AFTER_DRAIN = false; static constexpr int NS = 16;
    const bf16* YACT; const float* bglu; bf16* YCAT;
    __device__ __forceinline__ void operator()(const f32x4 (&acc)[2][2][4][2], const Unit& u, int wr, int wc, int fr, int fq, const LAS unsigned char* xlds) const {
        u32x4 ya[2][2][4]; f32x4 bb[2][2];
        const size_t row0 = (size_t)u.pm * BM + wr * 64 + fr; const int col0 = u.pn * BM + wc * 32 + 8 * fq;
#pragma unroll
        for (int bj = 0; bj < 2; ++bj) { bb[bj][0] = *(const f32x4*)(bglu + col0 + bj * HALF); bb[bj][1] = *(const f32x4*)(bglu + col0 + bj * HALF + 4);
#pragma unroll
            for (int ai = 0; ai < 2; ++ai)
#pragma unroll
                for (int m = 0; m < 4; ++m) ya[bj][ai][m] = *(const u32x4*)(YACT + (row0 + ai * HALF + m * 16) * 512 + col0 + bj * HALF); }
#pragma unroll
        for (int bj = 0; bj < 2; ++bj)
#pragma unroll
            for (int ai = 0; ai < 2; ++ai)
#pragma unroll
                for (int m = 0; m < 4; ++m) {
                    const u32x4 y = ya[bj][ai][m];
                    const f32x4 z0 = acc[ai][bj][m][0] + bb[bj][0], z1 = acc[ai][bj][m][1] + bb[bj][1]; f32x4 o0, o1;
                    o0[0] = bflo(y.x) * sigmoidf_(z0[0]); o0[1] = bfhi(y.x) * sigmoidf_(z0[1]); o0[2] = bflo(y.y) * sigmoidf_(z0[2]); o0[3] = bfhi(y.y) * sigmoidf_(z0[3]);
                    o1[0] = bflo(y.z) * sigmoidf_(z1[0]); o1[1] = bfhi(y.z) * sigmoidf_(z1[1]); o1[2] = bflo(y.w) * sigmoidf_(z1[2]); o1[3] = bfhi(y.w) * sigmoidf_(z1[3]);
                    *(u32x4*)(YCAT + (row0 + ai * HALF + m * 16) * 1024 + col0 + bj * HALF) = pack8(o0, o1);
                }
    }
};
struct EpiPlain {
    __device__ __forceinline__ void pre(const Unit&, LAS unsigned char*, int) const {}
    static constexpr bool PEEL = false, PERM = true, AFTER_DRAIN = false; static constexpr int NS = 16;
    bf16* O; int ldc;
    __device__ __forceinline__ void operator()(const f32x4 (&acc)[2][2][4][2], const Unit& u, int wr, int wc, int fr, int fq, const LAS unsigned char* xlds) const {
#pragma unroll
        for (int ai = 0; ai < 2; ++ai)
#pragma unroll
            for (int m = 0; m < 4; ++m) {
                const size_t row = (size_t)u.pm * BM + ai * HALF + wr * 64 + m * 16 + fr;
#pragma unroll
                for (int bj = 0; bj < 2; ++bj) { const int col = u.pn * BM + bj * HALF + wc * 32 + 8 * fq; *(u32x4*)(O + row * ldc + col) = pack8(acc[ai][bj][m][0], acc[ai][bj][m][1]); }
            }
    }
};
struct EpiNull {
    __device__ __forceinline__ void pre(const Unit&, LAS unsigned char*, int) const {}
    static constexpr bool PEEL = false, PERM = true, AFTER_DRAIN = false; static constexpr int NS = 0;
    __device__ __forceinline__ void operator()(const f32x4 (&acc)[2][2][4][2], const Unit& u, int wr, int wc, int fr, int fq, const LAS unsigned char* xlds) const {
#pragma unroll
        for (int ai = 0; ai < 2; ++ai)
#pragma unroll
            for (int bj = 0; bj < 2; ++bj)
#pragma unroll
                for (int m = 0; m < 4; ++m)
#pragma unroll
                    for (int n = 0; n < 2; ++n) asm volatile("" :: "v"(acc[ai][bj][m][n]));
    }
};
struct PanelSS {
    unsigned long long* slots;
    unsigned* tmo;
    template <class F> __device__ __forceinline__ bool run(const f32x4 (&v)[2][2][4][2], const Unit& u, int wr, int wc, int fr, int fq, LAS unsigned char* xl, F mid) const {
        LAS float* P = (LAS float*)(xl + 4096); LAS float* S = (LAS float*)(xl + 8192);
        const int wid = wr * 4 + wc, lane = fq * 16 + fr;
#pragma unroll
        for (int ai = 0; ai < 2; ++ai)
#pragma unroll
            for (int m = 0; m < 4; ++m) {
                float q = 0.f;
#pragma unroll
                for (int bj = 0; bj < 2; ++bj)
#pragma unroll
                    for (int n = 0; n < 2; ++n) { const f32x4 x = v[ai][bj][m][n]; q += (x[0] * x[0] + x[1] * x[1]) + (x[2] * x[2] + x[3] * x[3]); }
                q += __shfl_xor(q, 16); q += __shfl_xor(q, 32);
                P[(ai * HALF + wr * 64 + m * 16 + fr) * 4 + wc] = q;
            }
        asm volatile("s_waitcnt lgkmcnt(0)" ::: "memory"); __builtin_amdgcn_s_barrier(); asm volatile("" ::: "memory");
        const int row = wid * 32 + (lane & 31);
        unsigned long long* sl = slots + (size_t)u.pm * BM + row;
        if (lane < 32) {
            const f32x4 p = *(const LAS f32x4*)(P + row * 4);
            __hip_atomic_store(sl + (size_t)u.pn * MTOK, (1ull << 32) | (unsigned long long)__builtin_bit_cast(unsigned, (p[0] + p[1]) + (p[2] + p[3])), __ATOMIC_RELAXED, __HIP_MEMORY_SCOPE_AGENT);
        }
        mid();
        float tot = 0.f; bool ok = true; unsigned spins = 0u;
        for (;;) {
            ok = true; tot = 0.f;
            if (lane < 32) {
#pragma unroll
                for (int t = 0; t < 4; ++t) { const unsigned long long x = __hip_atomic_load(sl + (size_t)t * MTOK, __ATOMIC_RELAXED, __HIP_MEMORY_SCOPE_AGENT); ok = ok && ((unsigned)(x >> 32) == 1u); tot += __builtin_bit_cast(float, (unsigned)x); }
            }
            if (__all(ok)) break;
            if (++spins > (1u << 15)) { if (lane == 0) __hip_atomic_store(tmo, 1u, __ATOMIC_RELAXED, __HIP_MEMORY_SCOPE_AGENT); break; }
            __builtin_amdgcn_s_sleep(1);
        }
        const bool good = __all(ok);
        if (lane < 32) S[row] = good ? __builtin_amdgcn_rsqf(tot * (1.f / 1024.f) + EPS) : __builtin_nanf("");
        asm volatile("s_waitcnt lgkmcnt(0)" ::: "memory"); __builtin_amdgcn_s_barrier(); asm volatile("" ::: "memory");
        return false;
    }
};
struct EpiMid {
    __device__ __forceinline__ void pre(const Unit&, LAS unsigned char*, int) const {}
    static constexpr bool PEEL = false, PERM = true, AFTER_DRAIN = false; static constexpr int NS = 0;
    bf16* XB; const float* gpost; float* RS2P; PanelSS st1;
    __device__ __forceinline__ void operator()(const f32x4 (&acc_)[2][2][4][2], const Unit& u, int wr, int wc, int fr, int fq, const LAS unsigned char* xlds) const {
        f32x4 (&acc)[2][2][4][2] = const_cast<f32x4 (&)[2][2][4][2]>(acc_);
        LAS unsigned char* xl = const_cast<LAS unsigned char*>(xlds);
        LAS float* P = (LAS float*)(xl + 4096); const LAS float* S = (const LAS float*)(xl + 8192);
        const bf16* xb0 = XB + (size_t)(u.pm * BM + wr * 64 + fr) * DM + u.pn * BM + wc * 32 + 8 * fq;
        u32x4 r0[4][2];
#pragma unroll
        for (int m = 0; m < 4; ++m)
#pragma unroll
            for (int bj = 0; bj < 2; ++bj) r0[m][bj] = *(const u32x4*)(xb0 + (size_t)(m * 16) * DM + bj * HALF);
        f32x4 g[2][2];
#pragma unroll
        for (int bj = 0; bj < 2; ++bj) { const int col = u.pn * BM + bj * HALF + wc * 32 + 8 * fq; g[bj][0] = *(const f32x4*)(gpost + col); g[bj][1] = *(const f32x4*)(gpost + col + 4); }
        u32x4 r1[4][2];
        (void)st1.run(acc, u, wr, wc, fr, fq, xl, [&]() {
#pragma unroll
            for (int m = 0; m < 4; ++m)
#pragma unroll
                for (int bj = 0; bj < 2; ++bj) r1[m][bj] = *(const u32x4*)(xb0 + (size_t)(HALF + m * 16) * DM + bj * HALF); });
#pragma unroll
        for (int ai = 0; ai < 2; ++ai)
#pragma unroll
            for (int m = 0; m < 4; ++m) { const int r = ai * HALF + wr * 64 + m * 16 + fr; const float rsy = S[r]; const size_t row = (size_t)u.pm * BM + r; float q = 0.f;
#pragma unroll
                for (int bj = 0; bj < 2; ++bj) { const int col = u.pn * BM + bj * HALF + wc * 32 + 8 * fq;
                    const u32x4 xv = ai == 0 ? r0[m][bj] : r1[m][bj];
                    const f32x4 a0 = acc[ai][bj][m][0], a1 = acc[ai][bj][m][1]; f32x4 o0, o1;
                    o0[0] = bflo(xv.x) + g[bj][0][0] * a0[0] * rsy; o0[1] = bfhi(xv.x) + g[bj][0][1] * a0[1] * rsy; o0[2] = bflo(xv.y) + g[bj][0][2] * a0[2] * rsy; o0[3] = bfhi(xv.y) + g[bj][0][3] * a0[3] * rsy;
                    o1[0] = bflo(xv.z) + g[bj][1][0] * a1[0] * rsy; o1[1] = bfhi(xv.z) + g[bj][1][1] * a1[1] * rsy; o1[2] = bflo(xv.w) + g[bj][1][2] * a1[2] * rsy; o1[3] = bfhi(xv.w) + g[bj][1][3] * a1[3] * rsy;
                    q += (o0[0] * o0[0] + o0[1] * o0[1]) + (o0[2] * o0[2] + o0[3] * o0[3]) + (o1[0] * o1[0] + o1[1] * o1[1]) + (o1[2] * o1[2] + o1[3] * o1[3]);
                    *(u32x4*)(XB + row * DM + col) = pack8(o0, o1); }
                q += __shfl_xor(q, 16); q += __shfl_xor(q, 32);
                P[r * 4 + wc] = q;
            }
        asm volatile("s_waitcnt lgkmcnt(0)" ::: "memory"); __builtin_amdgcn_s_barrier(); asm volatile("" ::: "memory");
        { const int wid = wr * 4 + wc, lane = fq * 16 + fr, row = wid * 32 + (lane & 31);
          if (lane < 32) { const f32x4 p = *(const LAS f32x4*)(P + row * 4); RS2P[((size_t)u.pm * BM + row) * 4 + u.pn] = (p[0] + p[1]) + (p[2] + p[3]); } }
        asm volatile("s_waitcnt lgkmcnt(0)" ::: "memory"); __builtin_amdgcn_s_barrier(); asm volatile("" ::: "memory");
    }
};
struct EpiOut {
    __device__ __forceinline__ void pre(const Unit&, LAS unsigned char*, int) const {}
    static constexpr bool PEEL = true, PERM = false, AFTER_DRAIN = false; static constexpr int NS = 0;
    const bf16* XB; const float* gpost; float* out; PanelSS st;
    __device__ __forceinline__ void operator()(const f32x4 (&acc)[2][2][4][2], const Unit& u, int wr, int wc, int fr, int fq, const LAS unsigned char* xlds) const {
        LAS unsigned char* xl = const_cast<LAS unsigned char*>(xlds);
        const LAS float* S = (const LAS float*)(xl + 8192);
        const size_t off0 = (size_t)(u.pm * BM + wr * 64 + fr) * DM + u.pn * BM + wc * 32 + 4 * fq;
        const bf16* xb0 = XB + off0; float* o0p = out + off0;
        u32x2 r0[4][2][2];
#pragma unroll
        for (int m = 0; m < 4; ++m)
#pragma unroll
            for (int bj = 0; bj < 2; ++bj)
#pragma unroll
                for (int n = 0; n < 2; ++n) r0[m][bj][n] = *(const u32x2*)(xb0 + (size_t)(m * 16) * DM + bj * HALF + 16 * n);
        f32x4 g[2][2];
#pragma unroll
        for (int bj = 0; bj < 2; ++bj)
#pragma unroll
            for (int n = 0; n < 2; ++n) g[bj][n] = *(const f32x4*)(gpost + u.pn * BM + bj * HALF + wc * 32 + 16 * n + 4 * fq);
        u32x2 r1[4][2][2];
        (void)st.run(acc, u, wr, wc, fr, fq, xl, [&]() {
#pragma unroll
            for (int m = 0; m < 4; ++m)
#pragma unroll
                for (int bj = 0; bj < 2; ++bj)
#pragma unroll
                    for (int n = 0; n < 2; ++n) r1[m][bj][n] = *(const u32x2*)(xb0 + (size_t)(HALF + m * 16) * DM + bj * HALF + 16 * n); });
#pragma unroll
        for (int ai = 0; ai < 2; ++ai)
#pragma unroll
            for (int m = 0; m < 4; ++m) { const int r = ai * HALF + wr * 64 + m * 16 + fr; const float rsf = S[r];
#pragma unroll
                for (int bj = 0; bj < 2; ++bj)
#pragma unroll
                    for (int n = 0; n < 2; ++n) {
                        const u32x2 xv = ai == 0 ? r0[m][bj][n] : r1[m][bj][n]; const f32x4 a0 = acc[ai][bj][m][n]; f32x4 o;
                        o[0] = bflo(xv.x) + g[bj][n][0] * a0[0] * rsf; o[1] = bfhi(xv.x) + g[bj][n][1] * a0[1] * rsf; o[2] = bflo(xv.y) + g[bj][n][2] * a0[2] * rsf; o[3] = bfhi(xv.y) + g[bj][n][3] * a0[3] * rsf;
                        *(f32x4*)(o0p + (size_t)(ai * HALF + m * 16) * DM + bj * HALF + 16 * n) = o; }
            }
    }
};
struct EpiGU {
    static constexpr bool PEEL = true, PERM = true, AFTER_DRAIN = false; static constexpr int NS = 8;
    const float* rs2p; bf16* ACT; int pn0;
    __device__ __forceinline__ void pre(const Unit& u, LAS unsigned char* xlds, int tid) const {
        if (tid < 64) {
#pragma unroll
            for (int i = 0; i < 4; ++i) __builtin_amdgcn_global_load_lds((const unsigned*)(rs2p + ((size_t)u.pm * BM + i * 64 + tid) * 4), (LAS unsigned*)(xlds + i * 1024), 16, 0, 0); }
    }
    __device__ __forceinline__ void operator()(const f32x4 (&acc)[2][2][4][2], const Unit& u, int wr, int wc, int fr, int fq, const LAS unsigned char* xlds) const {
        const int hid = (u.pn + pn0) * HALF + wc * 32 + 8 * fq;
        float vv[8], sll[8];
#pragma unroll
        for (int i = 0; i < 8; ++i) { const f32x4 pq = *(const LAS f32x4*)(xlds + ((i >> 2) * HALF + wr * 64 + (i & 3) * 16 + fr) * 16);
            vv[i] = ((pq[0] + pq[1]) + (pq[2] + pq[3])) * (1.f / 1024.f) + EPS; }
#pragma unroll
        for (int i = 0; i < 8; ++i) sll[i] = __builtin_amdgcn_rsqf(vv[i]) * -1.4426950408889634f;
#pragma unroll
        for (int ai = 0; ai < 2; ++ai)
#pragma unroll
            for (int m = 0; m < 4; ++m) {
                const size_t row = (size_t)u.pm * BM + ai * HALF + wr * 64 + m * 16 + fr; const float v = vv[ai * 4 + m], sl = sll[ai * 4 + m];
                const f32x2 v2 = {v, v}, sl2 = {sl, sl};
                f32x4 o[2];
#pragma unroll
                for (int n = 0; n < 2; ++n)
#pragma unroll
                    for (int p = 0; p < 2; ++p) {
                        const f32x2 g2 = {acc[ai][0][m][n][2 * p], acc[ai][0][m][n][2 * p + 1]}, u2 = {acc[ai][1][m][n][2 * p], acc[ai][1][m][n][2 * p + 1]};
                        const f32x2 t = g2 * sl2; f32x2 e = {__builtin_amdgcn_exp2f(t[0]), __builtin_amdgcn_exp2f(t[1])};
                        e = __builtin_elementwise_fma(e, v2, v2); const f32x2 r = {frcp(e[0]), frcp(e[1])}, q = (g2 * u2) * r;
                        o[n][2 * p] = q[0]; o[n][2 * p + 1] = q[1]; }
                *(u32x4*)(ACT + row * DFF + hid) = pack8(o[0], o[1]);
            }
    }
};

template <class Epi, class Sched, bool ALIGN_EPI = true, bool NOWRAP = false>
__device__ __forceinline__ void gemm_phase(LAS unsigned char* lds, const Gemm g, Sched S, const Epi& E) {
    int tid = threadIdx.x; asm volatile("" : "+v"(tid));
    const int wid = __builtin_amdgcn_readfirstlane(tid >> 6), lane = tid & 63, wr = wid >> 2, wc = wid & 3, fr = lane & 15, fq = lane >> 4;
    const int K = g.K, nt = K / BK;
    unsigned voffA[2], voffB[2];
#pragma unroll
    for (int i = 0; i < 2; ++i) { int R, C; stage_rc(tid * 16 + i * 8192, R, C); const int Rb = Epi::PERM ? ((R & ~31) + perm32(R & 31)) : R;
        voffA[i] = (unsigned)(R * g.lda + C) * 2u; voffB[i] = (unsigned)(Rb * g.ldb + C) * 2u; }
    const size_t kstep = (size_t)(BK * 2);
    const size_t hstepA = (size_t)HALF * g.lda * 2, hstepB = (size_t)HALF * g.ldb * 2;
    const size_t tstepA = 2 * hstepA, tstepB = 2 * hstepB;
    const unsigned ldsw = (unsigned)wid * 1024u;
    const int aoff = lds_byte(wr * 64 + fr, fq * 8), boff = lds_byte(wc * 32 + fr, fq * 8);
#define PG8_SA(b, h) (((b) * 2 + (h)) * HTB)
#define PG8_SB(b, h) ((4 + (b) * 2 + (h)) * HTB)
#define PG8_STAGE(bufoff, gbase, voff) do { _Pragma("unroll") for (int _i = 0; _i < 2; ++_i) \
        __builtin_amdgcn_global_load_lds((const unsigned*)((const char*)(gbase) + (voff)[_i]), (LAS unsigned*)(lds + (bufoff) + ldsw + _i * 8192), 16, 0, 0); } while (0)
#define PG8_LDA(dst, b, h) do { _Pragma("unroll") for (int m = 0; m < 4; ++m) _Pragma("unroll") for (int k = 0; k < 2; ++k) dst[m][k] = *(const LAS bf16x8*)(lds + PG8_SA(b, h) + aoff + m * 2048 + k * 1024); } while (0)
#define PG8_LDB(dst, b, h) do { _Pragma("unroll") for (int n = 0; n < 2; ++n) _Pragma("unroll") for (int k = 0; k < 2; ++k) dst[n][k] = *(const LAS bf16x8*)(lds + PG8_SB(b, h) + boff + n * 2048 + k * 1024); } while (0)
#define PG8_MMA(ai, bj, At, Bt) do { __builtin_amdgcn_s_setprio(1); _Pragma("unroll") for (int m = 0; m < 4; ++m) _Pragma("unroll") for (int n = 0; n < 2; ++n) _Pragma("unroll") for (int k = 0; k < 2; ++k) \
        acc[ai][bj][m][n] = __builtin_amdgcn_mfma_f32_16x16x32_bf16(Bt[n][k], At[m][k], acc[ai][bj][m][n], 0, 0, 0); __builtin_amdgcn_s_setprio(0); } while (0)
#define PG8_MMAZ(ai, bj, At, Bt) do { __builtin_amdgcn_s_setprio(1); _Pragma("unroll") for (int m = 0; m < 4; ++m) _Pragma("unroll") for (int n = 0; n < 2; ++n) { \
        acc[ai][bj][m][n] = __builtin_amdgcn_mfma_f32_16x16x32_bf16(Bt[n][0], At[m][0], (f32x4){0.f, 0.f, 0.f, 0.f}, 0, 0, 0); \
        acc[ai][bj][m][n] = __builtin_amdgcn_mfma_f32_16x16x32_bf16(Bt[n][1], At[m][1], acc[ai][bj][m][n], 0, 0, 0); } __builtin_amdgcn_s_setprio(0); } while (0)
#define PG8_WAIT_V(n) asm volatile("s_waitcnt vmcnt(" #n ")" ::: "memory")
#define PG8_WAIT_L(n) asm volatile("s_waitcnt lgkmcnt(" #n ")" ::: "memory")
#define PG8_WAIT_VF PG8_WAIT_V(8)
#define PG8_BAR __builtin_amdgcn_s_barrier()
#define PG8_SCHED __builtin_amdgcn_sched_barrier(0)
    Unit cur, nxt; int ui = 0;
    if (!S.next(0, cur)) return;
    f32x4 acc[2][2][4][2];
    bf16x8 At[4][2], B0[2][2], B1[2][2];
    const char* cA = (const char*)g.A + (size_t)cur.pm * tstepA; const char* cB = (const char*)g.Bt + (size_t)cur.pn * tstepB;
    S.a_ready(cur);
    PG8_STAGE(PG8_SB(0, 0), cB, voffB); PG8_STAGE(PG8_SB(0, 1), cB + hstepB, voffB); PG8_STAGE(PG8_SA(0, 0), cA, voffA); PG8_STAGE(PG8_SA(0, 1), cA + hstepA, voffA);
    if (wr == 1) PG8_BAR;
    PG8_WAIT_V(2); PG8_BAR;
    PG8_STAGE(PG8_SB(1, 0), cB + kstep, voffB); PG8_STAGE(PG8_SA(1, 0), cA + kstep, voffA); PG8_STAGE(PG8_SB(1, 1), cB + hstepB + kstep, voffB);
    PG8_WAIT_V(6); PG8_BAR;
    for (;;) {
        const bool has_next = S.next(ui + 1, nxt);
        const char* nA = has_next ? (const char*)g.A + (size_t)nxt.pm * tstepA : cA; const char* nB = has_next ? (const char*)g.Bt + (size_t)nxt.pn * tstepB : cB;
#define PG8_KBODY(MM, LAST) { \
            const bool last = (LAST); \
            const char* a1 = cA + (size_t)(t + 1) * kstep; \
            const char* a2 = last ? nA : cA + (size_t)(t + 2) * kstep; const char* b2 = last ? nB : cB + (size_t)(t + 2) * kstep; \
            const char* a3 = a2 + kstep; const char* b3 = b2 + kstep; \
            if (last && has_next) S.a_ready(nxt); \
            if (last) { int tp = tid; asm volatile("" : "+v"(tp)); E.pre(cur, lds + STAGE_BYTES, tp); }     \
              \
            PG8_LDB(B0, 0, 0); PG8_LDB(B1, 0, 1); PG8_SCHED; PG8_LDA(At, 0, 0); PG8_STAGE(PG8_SA(1, 1), a1 + hstepA, voffA); \
            PG8_WAIT_VF; PG8_WAIT_L(0); PG8_BAR; MM(0, 0, At, B0); MM(0, 1, At, B1); PG8_BAR; PG8_SCHED; \
            const bool nw = NOWRAP && last;     \
              \
            PG8_LDA(At, 0, 1); if (!nw) { PG8_STAGE(PG8_SB(0, 0), b2, voffB); PG8_STAGE(PG8_SB(0, 1), b2 + hstepB, voffB); PG8_STAGE(PG8_SA(0, 0), a2, voffA); } \
            if (nw) PG8_WAIT_V(2); else PG8_WAIT_VF; PG8_WAIT_L(0); PG8_BAR; MM(1, 0, At, B0); MM(1, 1, At, B1); PG8_BAR; PG8_SCHED; \
              \
            PG8_LDB(B0, 1, 0); PG8_LDB(B1, 1, 1); PG8_SCHED; PG8_LDA(At, 1, 0); if (!nw) PG8_STAGE(PG8_SA(0, 1), a2 + hstepA, voffA); \
            if (nw) PG8_WAIT_V(0); else PG8_WAIT_V(8); PG8_WAIT_L(0); PG8_BAR; PG8_MMA(0, 0, At, B0); PG8_MMA(0, 1, At, B1); PG8_BAR; PG8_SCHED; \
              \
            PG8_LDA(At, 1, 1); if (!nw) { PG8_STAGE(PG8_SB(1, 0), b3, voffB); PG8_STAGE(PG8_SB(1, 1), b3 + hstepB, voffB); PG8_STAGE(PG8_SA(1, 0), a3, voffA); } \
            if (nw) PG8_WAIT_V(0); else PG8_WAIT_V(8); PG8_WAIT_L(0); PG8_BAR; PG8_MMA(1, 0, At, B0); PG8_MMA(1, 1, At, B1); PG8_BAR; PG8_SCHED; }
        if constexpr (Epi::PEEL) { int t = 0; asm volatile("" : "+s"(t)); PG8_KBODY(PG8_MMAZ, false) } else { _Pragma("unroll") for (int a_ = 0; a_ < 2; ++a_) _Pragma("unroll") for (int b_ = 0; b_ < 2; ++b_) _Pragma("unroll") for (int m_ = 0; m_ < 4; ++m_) _Pragma("unroll") for (int n_ = 0; n_ < 2; ++n_) acc[a_][b_][m_][n_] = (f32x4){0.f, 0.f, 0.f, 0.f}; }
#pragma unroll 1
        for (int t = Epi::PEEL ? 2 : 0; t < nt; t += 2) PG8_KBODY(PG8_MMA, t == nt - 2)
#undef PG8_KBODY
        if constexpr (ALIGN_EPI) { if (wr == 0) PG8_BAR; }
        { int tv = tid; asm volatile("" : "+v"(tv)); const int frv = tv & 15, fqv = (tv >> 4) & 3;
          E(acc, cur, wr, wc, frv, fqv, lds + STAGE_BYTES); } S.done(cur);
        if (!has_next) break;
        cur = nxt; cA = nA; cB = nB; ++ui;
        if constexpr (ALIGN_EPI) { if (wr == 1) PG8_BAR; }
    }
    PG8_WAIT_V(0);
    if constexpr (!ALIGN_EPI) { if (wr == 0) PG8_BAR; }
    PG8_BAR;
#undef PG8_SA
#undef PG8_SB
#undef PG8_STAGE
#undef PG8_LDA
#undef PG8_LDB
#undef PG8_MMA
#undef PG8_MMAZ
#undef PG8_WAIT_V
#undef PG8_WAIT_L
#undef PG8_WAIT_VF
#undef PG8_BAR
#undef PG8_SCHED
}
}

#define XB_TMO      128
#define XB_XCNT(j)  (256  + 64 * (j))
#define XB_XSUB(j)  (1280 + 64 * (j))
#define XB_XGEN(j)  (2304 + 64 * (j))
#define XB_TOP      3328
#define XB_TOPGEN   3392
#define XCD_BAR_WORDS 3456
#define XB_SPIN_CAP (1u << 20)
__device__ __forceinline__ unsigned xb_ld(unsigned* p)              { return __hip_atomic_load(p, __ATOMIC_RELAXED, __HIP_MEMORY_SCOPE_AGENT); }
__device__ __forceinline__ unsigned xb_add(unsigned* p, unsigned v) { return __hip_atomic_fetch_add(p, v, __ATOMIC_RELAXED, __HIP_MEMORY_SCOPE_AGENT); }
__device__ __forceinline__ unsigned xb_xcc_id() { return (unsigned)__builtin_amdgcn_s_getreg((3 << 11) | 20) & 0xFu; }
#define XB_SPIN(cond, bar) do { unsigned _sp = 0; while (cond) { __builtin_amdgcn_s_sleep(1); \
    if ((++_sp & 255u) == 0u) { if (xb_ld(&(bar)[XB_TMO])) break; if (_sp > XB_SPIN_CAP) { atomicAdd(&(bar)[XB_TMO], 1u); break; } } } } while (0)
struct XcdBarrier { unsigned* bar; unsigned x; volatile LAS unsigned* st; };
__device__ __forceinline__ XcdBarrier xcd_barrier_post(unsigned* bar, volatile LAS unsigned* st) {
    XcdBarrier b; b.bar = bar; b.x = xb_xcc_id(); b.st = st;
    if (threadIdx.x == 0) (void)xb_add(&bar[XB_XCNT(b.x)], 1u);
    return b;
}
__device__ __forceinline__ void xcd_barrier_complete(unsigned* bar, unsigned x, unsigned& nloc, unsigned& nx) {
    const unsigned G = gridDim.x * gridDim.y * gridDim.z;
    unsigned sum, cnt, mine, sp = 0u;
    for (;;) {
        sum = 0u; cnt = 0u; mine = 0u;
#pragma unroll
        for (unsigned j = 0; j < 16; ++j) { const unsigned c = xb_ld(&bar[XB_XCNT(j)]); sum += c; cnt += (c > 0u) ? 1u : 0u; mine = (j == x) ? c : mine; }
        if (sum == G) break;
        __builtin_amdgcn_s_sleep(1);
        if ((++sp & 255u) == 0u) { if (xb_ld(&bar[XB_TMO])) break; if (sp > XB_SPIN_CAP) { atomicAdd(&bar[XB_TMO], 1u); break; } }
    }
    nloc = mine > 0u ? mine : 1u; nx = cnt > 0u ? cnt : 1u;
}
__device__ __forceinline__ void xcd_barrier(const XcdBarrier& b) {
    asm volatile("s_waitcnt vmcnt(0)" ::: "memory");
    __syncthreads();
    if (threadIdx.x == 0) {
        unsigned* bar = b.bar;
        __builtin_amdgcn_s_waitcnt(0);
        unsigned nloc = b.st[0], nx = b.st[1];
        if (nloc == 0u) { xcd_barrier_complete(bar, b.x, nloc, nx); b.st[0] = nloc; b.st[1] = nx; }
        const unsigned old = xb_add(&bar[XB_XSUB(b.x)], 1u);
        const unsigned gen = old / nloc;
        if (old + 1u == (gen + 1u) * nloc) {
            __builtin_amdgcn_fence(__ATOMIC_RELEASE, "agent");
            asm volatile("s_waitcnt vmcnt(0)" ::: "memory");
            const unsigned og = xb_add(&bar[XB_TOP], 1u);
            const unsigned tg = og / nx;
            if (og + 1u == (tg + 1u) * nx) xb_add(&bar[XB_TOPGEN], 1u);
            else XB_SPIN(xb_ld(&bar[XB_TOPGEN]) == tg, bar);
            __builtin_amdgcn_fence(__ATOMIC_ACQUIRE, "agent");
            xb_add(&bar[XB_XGEN(b.x)], 1u);
            asm volatile("s_waitcnt vmcnt(0)" ::: "memory");
        } else {
            XB_SPIN(xb_ld(&bar[XB_XGEN(b.x)]) == gen, bar);
            __builtin_amdgcn_fence(__ATOMIC_ACQUIRE, "agent");
            asm volatile("s_waitcnt vmcnt(0)" ::: "memory");
        }
    }
    __syncthreads();
}

struct Args {
    const float* in[28]; float* out; unsigned char* ws; int ph_lo, ph_hi, pad0, pad1;
};
enum { I_X = 0, I_NMPRE, I_NMPOST, I_NFPRE, I_NFPOST, I_WIN, I_GBIAS, I_LRE, I_LIM, I_LDT, I_BRE, I_BIM, I_CRE, I_CIM, I_S5D, I_WGLU, I_BGLU,
       I_CONVW, I_CONVB, I_WQ, I_WK, I_WV, I_HNORM, I_SKIP, I_WOUT, I_WGATE, I_WUP, I_WDOWN };


__device__ __forceinline__ void p0_s5_unit(const Args& a, unsigned char* ws, LAS unsigned char* lds, int u, int tid) {
    const int g = u >> 3, part = u & 7;
    LAS float* pwr = (LAS float*)lds; LAS float* pwi = pwr + 2176; LAS float* bbr = pwi + 2176; LAS float* bbi = bbr + 2048;
    LAS float* cr = bbi + 2048; LAS float* ci = cr + 1024; LAS float* kl = ci + 1024; LAS float* fac = kl + 8192;
    for (int idx = tid; idx < 2176; idx += NTHREADS) {
        const int dir = idx / 1088, rem = idx - dir * 1088, e = rem >> 6, p = rem & 63;
        const float lr = a.in[I_LRE][(dir * NG + g) * 64 + p], li = a.in[I_LIM][(dir * NG + g) * 64 + p], dt = expf(a.in[I_LDT][dir * NG + g]);
        const float mag = expf(lr * dt * (float)e); float sn, cs; sincosf(li * dt * (float)e, &sn, &cs);
        pwr[idx] = mag * cs; pwi[idx] = mag * sn;
        if (e == 16 && part == 0) *(f32x2*)(ws + WS_A16 + (size_t)((dir * NG + g) * 64 + p) * 8) = (f32x2){mag * cs, mag * sn};
        if (e == 1) { const float xr = expm1f(lr * dt) * cs - 2.f * sinf(0.5f * li * dt) * sinf(0.5f * li * dt), xi = mag * sn, den = lr * lr + li * li;
            fac[(dir * 64 + p) * 2] = (xr * lr + xi * li) / den; fac[(dir * 64 + p) * 2 + 1] = (xi * lr - xr * li) / den; }
    }
    for (int i = tid; i < 1024; i += NTHREADS) { const int c = i >> 6, p = i & 63; cr[p * 16 + c] = a.in[I_CRE][g * 1024 + i]; ci[p * 16 + c] = a.in[I_CIM][g * 1024 + i]; }
    __syncthreads();
    for (int idx = tid; idx < 2048; idx += NTHREADS) { const int dir = idx >> 10, p = (idx >> 4) & 63, c = idx & 15;
        const float fr = fac[(dir * 64 + p) * 2], fi = fac[(dir * 64 + p) * 2 + 1], b_r = a.in[I_BRE][(g * 64 + p) * 16 + c], b_i = a.in[I_BIM][(g * 64 + p) * 16 + c];
        bbr[idx] = fr * b_r - fi * b_i; bbi[idx] = fr * b_i + fi * b_r; }
    __syncthreads();
    {
        const int dir = tid >> 8, lsel = (tid >> 7) & 1, c = (tid >> 3) & 15, c2p = tid & 7, lag = 2 * part + lsel;
        float s0 = 0.f, s1 = 0.f;
        for (int p = 0; p < 64; ++p) {
            const float pr = pwr[(dir * 17 + lag) * 64 + p], pi = pwi[(dir * 17 + lag) * 64 + p], c_r = cr[p * 16 + c], c_i = ci[p * 16 + c];
            const float x_r = c_r * pr - c_i * pi, x_i = c_r * pi + c_i * pr;
            const f32x2 b_r = *(const LAS f32x2*)(bbr + (dir * 64 + p) * 16 + 2 * c2p), b_i = *(const LAS f32x2*)(bbi + (dir * 64 + p) * 16 + 2 * c2p);
            s0 += x_r * b_r[0] - x_i * b_i[0]; s1 += x_r * b_r[1] - x_i * b_i[1];
        }
        *(LAS f32x2*)(kl + ((dir * 2 + lsel) * 16 + c) * 16 + 2 * c2p) = (f32x2){s0, s1};
    }
    __syncthreads();
    bf16* MZ = (bf16*)(ws + WS_MZ) + (size_t)g * 256 * 256; bf16* TMY = (bf16*)(ws + WS_TMY) + (size_t)g * 256 * 512;
    for (int v = part * 1024 + tid; v < (part + 1) * 1024; v += NTHREADS) {
        const int n = v >> 5, k0 = (v & 31) * 8, dir = n >> 7, ri = (n >> 6) & 1, p = n & 63, j = k0 >> 4, c0 = k0 & 15, e = dir ? j : 15 - j;
        const float pr = pwr[(dir * 17 + e) * 64 + p], pi = pwi[(dir * 17 + e) * 64 + p]; float o[8];
#pragma unroll
        for (int cc = 0; cc < 8; ++cc) { const float b_r = bbr[(dir * 64 + p) * 16 + c0 + cc], b_i = bbi[(dir * 64 + p) * 16 + c0 + cc]; o[cc] = ri ? (pr * b_i + pi * b_r) : (pr * b_r - pi * b_i); }
        u32x4 w; w.x = pk2(o[0], o[1]); w.y = pk2(o[2], o[3]); w.z = pk2(o[4], o[5]); w.w = pk2(o[6], o[7]);
        *(u32x4*)(MZ + (size_t)n * 256 + k0) = w;
    }
    for (int v = tid; v < 2048; v += NTHREADS) {
        const int dir = v >> 10, lsel = (v >> 9) & 1, t = (v >> 5) & 15, c = (v >> 1) & 15, hf = v & 1, lag = 2 * part + lsel;
        const int j = dir ? t + lag : t - lag;
        if (j < 0 || j > 15 || (lag == 0 && dir == 1)) continue;
        float o[8];
#pragma unroll
        for (int cc = 0; cc < 8; ++cc) { const int c2 = 8 * hf + cc; float sv = kl[((dir * 2 + lsel) * 16 + c) * 16 + c2];
            if (lag == 0) { sv += kl[((1 * 2 + lsel) * 16 + c) * 16 + c2]; if (c2 == c) sv += a.in[I_S5D][g * 16 + c]; }
            o[cc] = sv; }
        u32x4 w; w.x = pk2(o[0], o[1]); w.y = pk2(o[2], o[3]); w.z = pk2(o[4], o[5]); w.w = pk2(o[6], o[7]);
        *(u32x4*)(TMY + (size_t)(t * 16 + c) * 512 + j * 16 + 8 * hf) = w;
    }
    for (int v = part * 1024 + tid; v < (part + 1) * 1024; v += NTHREADS) {
        const int n = v >> 5, k0 = 256 + (v & 31) * 8, t = n >> 4, c = n & 15; float o[8];
        const int s0 = k0 - 256, dir = s0 >> 7, ri = (s0 >> 6) & 1, e = dir ? 16 - t : t + 1;
#pragma unroll
        for (int cc = 0; cc < 8; ++cc) { const int p = (s0 & 63) + cc; const float pr = pwr[(dir * 17 + e) * 64 + p], pi = pwi[(dir * 17 + e) * 64 + p], c_r = cr[p * 16 + c], c_i = ci[p * 16 + c];
            o[cc] = ri ? -(c_r * pi + c_i * pr) : (c_r * pr - c_i * pi); }
        u32x4 w; w.x = pk2(o[0], o[1]); w.y = pk2(o[2], o[3]); w.z = pk2(o[4], o[5]); w.w = pk2(o[6], o[7]);
        *(u32x4*)(TMY + (size_t)n * 512 + k0) = w;
    }
    __syncthreads();
}
struct TrItem { const float* s0; const float* s1; const float* rs; bf16* dst; int ld, c0, c1, nh, k0, K; float cs; };
__device__ __forceinline__ void tr_load(const TrItem& t, f32x4 (&v)[2][4], float (&sc)[4], int tid) {
#pragma unroll
    for (int i = 0; i < 4; ++i) { const int idx = tid + NTHREADS * i, row = idx >> 5, c4 = idx & 31;
        sc[i] = t.rs ? t.rs[t.k0 + row] * t.cs : t.cs;
#pragma unroll
        for (int hf = 0; hf < 2; ++hf) { v[hf][i] = (f32x4){0.f, 0.f, 0.f, 0.f};
            if (hf < t.nh) v[hf][i] = *(const f32x4*)((hf ? t.s1 : t.s0) + (size_t)(t.k0 + row) * t.ld + (hf ? t.c1 : t.c0) + 4 * c4); } }
}
__device__ __forceinline__ void tr_finish(const TrItem& t, const f32x4 (&v)[2][4], const float (&sc)[4], LAS float* T, int tid) {
#pragma unroll
    for (int hf = 0; hf < 2; ++hf)
#pragma unroll
        for (int i = 0; i < 4; ++i) { const int idx = tid + NTHREADS * i, row = idx >> 5, c4 = idx & 31;
            LAS float* p = T + row * 257 + 128 * hf + 4 * c4; p[0] = v[hf][i][0] * sc[i]; p[1] = v[hf][i][1] * sc[i]; p[2] = v[hf][i][2] * sc[i]; p[3] = v[hf][i][3] * sc[i]; }
    __syncthreads();
#pragma unroll
    for (int i = 0; i < 4; ++i) { const int idx = tid + NTHREADS * i, n = idx >> 3, kc = idx & 7;
        if (n < 128 * t.nh) { const LAS float* p = T + (8 * kc) * 257 + n;
            u32x4 o; o.x = pk2(p[0], p[257]); o.y = pk2(p[2 * 257], p[3 * 257]); o.z = pk2(p[4 * 257], p[5 * 257]); o.w = pk2(p[6 * 257], p[7 * 257]);
            *(u32x4*)(t.dst + (size_t)n * t.K + t.k0 + 8 * kc) = o; } }
    __syncthreads();
}
constexpr int TR_J0 = 16 * 6, TR_J1 = 8 * 2, TR_J2 = 12 * 2, TR_J3 = 16 * 4, TR_J4 = 16 * 22, TR_J5 = 44 * 4, TR_NJ = TR_J0 + TR_J1 + TR_J2 + TR_J3 + TR_J4 + TR_J5;
__device__ __forceinline__ TrItem tr_decode(const Args& a, unsigned char* ws, int r) {
    if (r < TR_J0) { const int kb = r / 6, nb = r % 6; return TrItem{a.in[I_WIN], a.in[I_WIN], a.in[I_NMPRE], (bf16*)(ws + WS_WIN) + (size_t)(256 * nb) * 1024, D_IN, 256 * nb, 256 * nb + 128, 2, 64 * kb, 1024, 1.f}; } r -= TR_J0;
    if (r < TR_J1) { const int kb = r / 2, nb = r % 2; return TrItem{a.in[I_WGLU], a.in[I_WGLU], nullptr, (bf16*)(ws + WS_WGLU) + (size_t)(256 * nb) * 512, 512, 256 * nb, 256 * nb + 128, 2, 64 * kb, 512, 1.f}; } r -= TR_J1;
    if (r < TR_J2) { const int mh = r >> 1, kb = r & 1, mat = mh >> 2; const float* sp = (mat == 0 ? a.in[I_WQ] : mat == 1 ? a.in[I_WK] : a.in[I_WV]) + (size_t)(mh & 3) * 16384;
        return TrItem{sp, sp, nullptr, (bf16*)(ws + WS_WQKV) + (size_t)(mh * 128) * 128, 128, 0, 0, 1, 64 * kb, 128, mat == 1 ? 0.08838834764831845f : 1.f}; } r -= TR_J2;
    if (r < TR_J3) { const int kb = r / 4, nb = r % 4; return TrItem{a.in[I_WOUT], a.in[I_WOUT], nullptr, (bf16*)(ws + WS_WOUT) + (size_t)(256 * nb) * 1024, 1024, 256 * nb, 256 * nb + 128, 2, 64 * kb, 1024, 1.f}; } r -= TR_J3;
    if (r < TR_J4) { const int kb = r / 22, nb = r % 22; return TrItem{a.in[I_WGATE], a.in[I_WUP], a.in[I_NFPRE], (bf16*)(ws + WS_WGU) + (size_t)(256 * nb) * 1024, DFF, 128 * nb, 128 * nb, 2, 64 * kb, 1024, 1.f}; } r -= TR_J4;
    { const int kb = r / 4, nb = r % 4; return TrItem{a.in[I_WDOWN], a.in[I_WDOWN], nullptr, (bf16*)(ws + WS_WDN) + (size_t)(256 * nb) * DFF, 1024, 256 * nb, 256 * nb + 128, 2, 64 * kb, DFF, 1.f}; }
}
__device__ __forceinline__ void p0_prologue(const Args& a, unsigned char* ws, LAS unsigned char* lds, int tid, int wave, int lane, int vcu, int G) {
    for (int i = blockIdx.x * NTHREADS + tid; i < (int)(6 * MiB / 16); i += G * NTHREADS) *(u32x4*)(ws + WS_XS + (size_t)i * 16) = (u32x4){0u, 0u, 0u, 0u};
    const int gw = vcu * NWAVES + wave, NGW = G * NWAVES;
    {   LAS float* T = (LAS float*)lds;
        int it = vcu; bool have = it < TR_NJ; TrItem cur = tr_decode(a, ws, have ? it : 0); f32x4 v[2][4]; float sc[4];
        if (have) tr_load(cur, v, sc, tid);
        for (int u = blockIdx.x; u < NG * 8; u += G) p0_s5_unit(a, ws, lds, u, tid);
        while (have) {
            const int nx = it + G; const bool hn = nx < TR_NJ; const TrItem nxt = tr_decode(a, ws, hn ? nx : 0); f32x4 w[2][4]; float sn[4];
#pragma unroll
            for (int i = 0; i < 4; ++i) { sn[i] = 0.f; w[0][i] = (f32x4){0.f, 0.f, 0.f, 0.f}; w[1][i] = w[0][i]; }
            if (hn) tr_load(nxt, w, sn, tid);
            tr_finish(cur, v, sc, T, tid);
            cur = nxt; it = nx; have = hn;
#pragma unroll
            for (int i = 0; i < 4; ++i) { sc[i] = sn[i]; v[0][i] = w[0][i]; v[1][i] = w[1][i]; }
        }
    }
    __syncthreads();
    f32x4 vpre[4][4];
    { const float* xr0 = a.in[I_X] + (size_t)((gw < MTOK / 16 ? gw : 0) * 16 + (lane & 15)) * DM + 16 * (lane >> 4);
#pragma unroll
      for (int s8 = 0; s8 < 4; ++s8)
#pragma unroll
          for (int j = 0; j < 4; ++j) vpre[s8][j] = *(const f32x4*)(xr0 + 64 * s8 + 4 * j); }
#pragma unroll
    for (int idx = tid; idx < 32 * 64; idx += NTHREADS) {
        const int f = idx >> 6, l = idx & 63, n = l & 15, q = l >> 4, k0 = 64 * (f >> 1) + 16 * q + 8 * (f & 1); float o[8];
#pragma unroll
        for (int j = 0; j < 8; ++j) o[j] = a.in[I_NMPRE][k0 + j] * a.in[I_WIN][(size_t)(k0 + j) * D_IN + NPROJ + n];
        u32x4 w; w.x = pk2(o[0], o[1]); w.y = pk2(o[2], o[3]); w.z = pk2(o[4], o[5]); w.w = pk2(o[6], o[7]);
        *(LAS u32x4*)(lds + idx * 16) = w;
    }
    __syncthreads();
    const int r16 = lane & 15, q4 = lane >> 4;
    const float gbias = a.in[I_GBIAS][r16];
    float* RS1 = (float*)(ws + WS_RS1); float* GT = (float*)(ws + WS_GATES);
    for (int grp = gw; grp < MTOK / 16; grp += NGW) {
        const int row0 = grp * 16;
        const float* xr = a.in[I_X] + (size_t)(row0 + r16) * DM + 16 * q4;
        bf16* xo = (bf16*)(ws + WS_XB) + (size_t)(row0 + r16) * DM + 16 * q4;
        f32x4 acc = {0.f, 0.f, 0.f, 0.f}; float ss = 0.f;
#pragma unroll 1
        for (int half = 0; half < 4; ++half) {
            f32x4 v[4][4];
            if (grp == gw && half == 0) {
#pragma unroll
                for (int s8 = 0; s8 < 4; ++s8)
#pragma unroll
                    for (int j = 0; j < 4; ++j) v[s8][j] = vpre[s8][j];
            } else {
#pragma unroll
                for (int s8 = 0; s8 < 4; ++s8)
#pragma unroll
                    for (int j = 0; j < 4; ++j) v[s8][j] = *(const f32x4*)(xr + 64 * (4 * half + s8) + 4 * j);
            }
#pragma unroll
            for (int s8 = 0; s8 < 4; ++s8) {
                const int s = 4 * half + s8; const f32x4 v0 = v[s8][0], v1 = v[s8][1], v2 = v[s8][2], v3 = v[s8][3];
                ss += (v0[0] * v0[0] + v0[1] * v0[1]) + (v0[2] * v0[2] + v0[3] * v0[3]) + (v1[0] * v1[0] + v1[1] * v1[1]) + (v1[2] * v1[2] + v1[3] * v1[3])
                    + (v2[0] * v2[0] + v2[1] * v2[1]) + (v2[2] * v2[2] + v2[3] * v2[3]) + (v3[0] * v3[0] + v3[1] * v3[1]) + (v3[2] * v3[2] + v3[3] * v3[3]);
                u32x4 a0, a1; a0.x = pk2(v0[0], v0[1]); a0.y = pk2(v0[2], v0[3]); a0.z = pk2(v1[0], v1[1]); a0.w = pk2(v1[2], v1[3]);
                a1.x = pk2(v2[0], v2[1]); a1.y = pk2(v2[2], v2[3]); a1.z = pk2(v3[0], v3[1]); a1.w = pk2(v3[2], v3[3]);
                *(u32x4*)(xo + 64 * s) = a0; *(u32x4*)(xo + 64 * s + 8) = a1;
                const bf16x8 b0 = *(const LAS bf16x8*)(lds + ((2 * s) * 64 + lane) * 16), b1 = *(const LAS bf16x8*)(lds + ((2 * s + 1) * 64 + lane) * 16);
                acc = __builtin_amdgcn_mfma_f32_16x16x32_bf16(__builtin_bit_cast(bf16x8, a0), b0, acc, 0, 0, 0);
                acc = __builtin_amdgcn_mfma_f32_16x16x32_bf16(__builtin_bit_cast(bf16x8, a1), b1, acc, 0, 0, 0);
            }
        }
        ss += __shfl_xor(ss, 16); ss += __shfl_xor(ss, 32);
        const float rs = __builtin_amdgcn_rsqf(ss * (1.f / DM) + EPS);
        if (q4 == 0) RS1[row0 + r16] = rs;
#pragma unroll
        for (int reg = 0; reg < 4; ++reg) { const float rsr = __shfl(rs, 4 * q4 + reg); GT[(size_t)(row0 + 4 * q4 + reg) * 16 + r16] = acc[reg] * rsr + gbias; }
    }
    __syncthreads();
}

__device__ __forceinline__ void s5_scan_lds(const Args& a, unsigned char* ws, const LAS unsigned char* zl, int L, int tid) {
    if (tid < 256) {
        bf16* UX = (bf16*)(ws + WS_UX);
        const int g = L >> 4, bl = (tid >> 7) & 1, b = 2 * (L & 15) + bl, dir = (tid >> 6) & 1, p = tid & 63;
        const f32x2 a16 = *(const f32x2*)(ws + WS_A16 + (size_t)((dir * NG + g) * 64 + p) * 8);
        const float ar = a16[0], ai = a16[1];
        const LAS bf16* z = (const LAS bf16*)(zl + (size_t)(bl * S5NCH) * pg8::ZLP) + dir * 128 + p;
        bf16* o = UX + (size_t)(g * S5ROWS + b * S5NCH) * 512 + 256 + dir * 128 + p;
        float sr = 0.f, si = 0.f;
#pragma unroll 1
        for (int kb = 0; kb < S5NCH / 16; ++kb) {
            float zr[16], zi[16];
#pragma unroll
            for (int j = 0; j < 16; ++j) { const int kk = kb * 16 + j, k = dir ? (S5NCH - 1 - kk) : kk; zr[j] = bf2f(z[k * (pg8::ZLP / 2)]); zi[j] = bf2f(z[k * (pg8::ZLP / 2) + 64]); }
#pragma unroll
            for (int j = 0; j < 16; ++j) { const int kk = kb * 16 + j, k = dir ? (S5NCH - 1 - kk) : kk;
                o[(size_t)k * 512] = (bf16)(pk2(sr, 0.f) & 0xffffu); o[(size_t)k * 512 + 64] = (bf16)(pk2(si, 0.f) & 0xffffu);
                const float nr = ar * sr - ai * si + zr[j], ni = ar * si + ai * sr + zi[j]; sr = nr; si = ni; }
        }
    }
}

__device__ __forceinline__ void s5_scan(const Args& a, unsigned char* ws, int tid, int G) {
    const bf16* ZB = (const bf16*)(ws + WS_ZB); bf16* UX = (bf16*)(ws + WS_UX);
    for (int base = 0; base * G < NG * 16; base += 2) {
        const int L = (base + (tid >> 8)) * G + (int)blockIdx.x;
        if (L < NG * 16) {
            const int g = L >> 4, b = 2 * (L & 15) + ((tid >> 7) & 1), dir = (tid >> 6) & 1, p = tid & 63;
            const float lr = a.in[I_LRE][(dir * NG + g) * 64 + p], li = a.in[I_LIM][(dir * NG + g) * 64 + p], dt = expf(a.in[I_LDT][dir * NG + g]);
            const float mag = expf(lr * dt * 16.f); float sn, cs; sincosf(li * dt * 16.f, &sn, &cs);
            const float ar = mag * cs, ai = mag * sn;
            const bf16* z = ZB + (size_t)(g * S5ROWS + b * S5NCH) * 256 + dir * 128 + p;
            bf16* o = UX + (size_t)(g * S5ROWS + b * S5NCH) * 512 + 256 + dir * 128 + p;
            float sr = 0.f, si = 0.f;
#pragma unroll 1
            for (int kb = 0; kb < S5NCH / 16; ++kb) {
                float zr[16], zi[16];
#pragma unroll
                for (int j = 0; j < 16; ++j) { const int kk = kb * 16 + j, k = dir ? (S5NCH - 1 - kk) : kk; zr[j] = bf2f(z[(size_t)k * 256]); zi[j] = bf2f(z[(size_t)k * 256 + 64]); }
#pragma unroll
                for (int j = 0; j < 16; ++j) { const int kk = kb * 16 + j, k = dir ? (S5NCH - 1 - kk) : kk;
                    o[(size_t)k * 512] = (bf16)(pk2(sr, 0.f) & 0xffffu); o[(size_t)k * 512 + 64] = (bf16)(pk2(si, 0.f) & 0xffffu);
                    const float nr = ar * sr - ai * si + zr[j], ni = ar * si + ai * sr + zi[j]; sr = nr; si = ni; }
            }
        }
    }
}

__device__ __forceinline__ void ml_pre(const Args& a, unsigned char* ws, LAS unsigned char* lds, int gw, int NGW, int wave, int lane, int G) {
    const float* GT = (const float*)(ws + WS_GATES);
    LAS float* sm = (LAS float*)lds;
    u32x4 xpre[12];
    { const bf16* XM0 = (const bf16*)(ws + WS_XM); const int grp0 = gw < MTOK / 8 ? gw : 0, row0 = grp0 * 8, s0 = row0 & (SEQ - 1);
#pragma unroll
      for (int i = 0; i < 12; ++i) { const int sp = s0 + i - 2; xpre[i] = (u32x4){0u, 0u, 0u, 0u}; if (sp >= 0 && sp < SEQ) xpre[i] = *(const u32x4*)(XM0 + (size_t)(row0 + i - 2) * 512 + 8 * lane); } }
    const int w4 = __builtin_amdgcn_readfirstlane(wave) * 4;
    for (int cid = blockIdx.x; cid < BATCH * NH * 2; cid += G) {
        const int b = cid >> 3, h = (cid >> 1) & 3, dir = cid & 1;
        float* GS = (float*)(ws + WS_GS) + (size_t)cid * SEQ * 8;
        float gi[4], gf[4], rr[4], bs[4], Rm[4];
#pragma unroll
        for (int j = 0; j < 4; ++j) { const int lp = (w4 + j) * 64 + lane, pos = dir ? (SEQ - 1 - lp) : lp; const float* gp = GT + (size_t)(b * SEQ + pos) * 16;
            gi[j] = gp[(dir ? 4 : 0) + h]; gf[j] = gp[(dir ? 12 : 8) + h]; }
#pragma unroll
        for (int j = 0; j < 4; ++j) {
            const float lf = fminf(gf[j], 0.f) - log1pf(expf(-fabsf(gf[j])));
            float bsum = lf;
#pragma unroll
            for (int o = 1; o < 64; o <<= 1) { const float v = __shfl_up(bsum, o); if (lane >= o) bsum += v; }
            const float r = gi[j] - bsum; float R = r;
#pragma unroll
            for (int o = 1; o < 64; o <<= 1) { const float v = __shfl_up(R, o); if (lane >= o) R = fmaxf(R, v); }
            rr[j] = r; bs[j] = bsum; Rm[j] = R;
            if (lane == 63) *(LAS f32x2*)(sm + (w4 + j) * 2) = (f32x2){bsum, R};
        }
        __syncthreads();
        float ms = 0.f;
#pragma unroll
        for (int c = 0; c < 28; ++c) if (c < w4) { const f32x2 e = *(const LAS f32x2*)(sm + c * 2); ms = e[0] + fmaxf(ms, e[1]); }
#pragma unroll
        for (int j = 0; j < 4; ++j) { const int lp = (w4 + j) * 64 + lane;
            const float mu = fmaxf(ms, Rm[j]), mu_last = __shfl(mu, 63), b_last = __shfl(bs[j], 63);
            *(f32x4*)(GS + (size_t)lp * 8) = (f32x4){rr[j], mu, expf(ms - mu), expf(-(bs[j] + mu))};
            *(f32x2*)(GS + (size_t)lp * 8 + 4) = (f32x2){expf(rr[j] - mu_last), expf(ms - mu_last)};
            ms = b_last + mu_last; }
        __syncthreads();
    }
    const bf16* XMg = (const bf16*)(ws + WS_XM); bf16* XCg = (bf16*)(ws + WS_XC);
    const int col = 8 * lane;
    float cw[5][8], cb[8];
#pragma unroll
    for (int e = 0; e < 8; ++e) { cb[e] = a.in[I_CONVB][col + e];
#pragma unroll
        for (int j = 0; j < 5; ++j) cw[j][e] = a.in[I_CONVW][j * 512 + col + e]; }
    for (int grp = gw; grp < MTOK / 8; grp += NGW) {
        const int row0 = grp * 8, s0 = row0 & (SEQ - 1);
        u32x4 xv[12];
        if (grp == gw) {
#pragma unroll
            for (int i = 0; i < 12; ++i) xv[i] = xpre[i];
        } else {
#pragma unroll
            for (int i = 0; i < 12; ++i) { const int sp = s0 + i - 2; xv[i] = (u32x4){0u, 0u, 0u, 0u}; if (sp >= 0 && sp < SEQ) xv[i] = *(const u32x4*)(XMg + (size_t)(row0 + i - 2) * 512 + col); }
        }
#pragma unroll
        for (int r = 0; r < 8; ++r) { float z[8];
#pragma unroll
            for (int e = 0; e < 8; ++e) z[e] = cb[e];
#pragma unroll
            for (int j = 0; j < 5; ++j) { const u32x4 x = xv[r + j];
                z[0] += cw[j][0] * bflo(x.x); z[1] += cw[j][1] * bfhi(x.x); z[2] += cw[j][2] * bflo(x.y); z[3] += cw[j][3] * bfhi(x.y);
                z[4] += cw[j][4] * bflo(x.z); z[5] += cw[j][5] * bfhi(x.z); z[6] += cw[j][6] * bflo(x.w); z[7] += cw[j][7] * bfhi(x.w); }
            u32x4 o; o.x = pk2(siluf_(z[0]), siluf_(z[1])); o.y = pk2(siluf_(z[2]), siluf_(z[3])); o.z = pk2(siluf_(z[4]), siluf_(z[5])); o.w = pk2(siluf_(z[6]), siluf_(z[7]));
            *(u32x4*)(XCg + (size_t)(row0 + r) * 512 + col) = o; }
    }
}

constexpr int ML_XM = 0, ML_XC = 16384, ML_QS = 32768, ML_KS = 51200, ML_VT = 69632, ML_KT = 88064, ML_P = 108544, ML_CB = 118784, ML_SC = 153600;
constexpr int RPQ = 288, RQ = 160, RPC = 272, RQV = 144;
__device__ __forceinline__ int sw128(int row, int off) { return row * 256 + ((((off) >> 4) ^ (row & 15)) << 4) + (off & 15); }
__device__ __forceinline__ int sw64(int row, int off) { return row * 128 + ((((off) >> 4) ^ ((row >> 1) & 7)) << 4) + (off & 15); }
__device__ __forceinline__ int xsw(int row, int chunk) { return row * 256 + ((chunk ^ (row & 15)) << 4); }
constexpr int SC_R = 0, SC_MU = 64, SC_WI = 128, SC_ME = 192, SC_WS = 256, SC_DEN = 320, SC_NQ = 384, SC_DEC = 448, SC_BUF = 512, SC_N = 1024, SC_NB = 1152;
static_assert(ML_SC + (SC_NB + 64) * 4 <= MISC_OFF, "mLSTM LDS map");
typedef __bf16 bf16x2v __attribute__((ext_vector_type(2)));
__device__ __forceinline__ float dot2bf(unsigned a, unsigned b, float c) { return __builtin_amdgcn_fdot2_f32_bf16(__builtin_bit_cast(bf16x2v, a), __builtin_bit_cast(bf16x2v, b), c, false); }
#define MFMA16(a, b, c) __builtin_amdgcn_mfma_f32_16x16x32_bf16((a), (b), (c), 0, 0, 0)
__device__ __forceinline__ void mlstm_chain(const Args& a, unsigned char* ws, LAS unsigned char* lds, int cid, int tid, int wave, int lane) {
    const int b = cid >> 3, h = (cid >> 1) & 3, dir = cid & 1;
    const bf16* XMg = (const bf16*)(ws + WS_XM) + (size_t)b * SEQ * 512 + h * 128; const bf16* XCg = (const bf16*)(ws + WS_XC) + (size_t)b * SEQ * 512 + h * 128;
    const float* GS = (const float*)(ws + WS_GS) + (size_t)cid * SEQ * 8; bf16* HO = (bf16*)(ws + (dir ? WS_HB : WS_HF)) + (size_t)b * SEQ * 512 + h * 128;
    const bf16* WQ = (const bf16*)(ws + WS_WQKV) + (size_t)(0 * 4 + h) * 16384; const bf16* WK = (const bf16*)(ws + WS_WQKV) + (size_t)(1 * 4 + h) * 16384; const bf16* WV = (const bf16*)(ws + WS_WQKV) + (size_t)(2 * 4 + h) * 16384;
    LAS float* sc = (LAS float*)(lds + ML_SC);
    for (int i = tid; i < (ML_SC - ML_P) / 16; i += NTHREADS) *(LAS u32x4*)(lds + ML_P + i * 16) = (u32x4){0u, 0u, 0u, 0u};
    if (tid < 128) sc[SC_N + tid] = 0.f;
    if (tid < 64) sc[SC_NB + tid] = 0.f;
    for (int i = tid; i < 64 * 16; i += NTHREADS) { const int lr = i >> 4, cc = i & 15, pos = dir ? (SEQ - 1 - lr) : lr;
        *(LAS u32x4*)(lds + ML_XM + xsw(lr, cc)) = *(const u32x4*)(XMg + (size_t)pos * 512 + cc * 8);
        *(LAS u32x4*)(lds + ML_XC + xsw(lr, cc)) = *(const u32x4*)(XCg + (size_t)pos * 512 + cc * 8); }
    if (wave == 0) { const f32x4 g0 = *(const f32x4*)(GS + (size_t)lane * 8); const f32x2 g1 = *(const f32x2*)(GS + (size_t)lane * 8 + 4);
        sc[SC_R + lane] = g0[0]; sc[SC_MU + lane] = g0[1]; sc[SC_WI + lane] = g0[2]; sc[SC_ME + lane] = g0[3]; sc[SC_WS + lane] = g1[0]; sc[SC_DEN + lane] = 0.f; if (lane == 0) sc[SC_DEC] = g1[1]; }
    bf16x8 bq[4], bk[4], bv[4];
#pragma unroll
    for (int ks = 0; ks < 4; ++ks) { const size_t o = (size_t)(16 * wave + (lane & 15)) * 128 + 32 * ks + 8 * (lane >> 4); bq[ks] = *(const bf16x8*)(WQ + o); bk[ks] = *(const bf16x8*)(WK + o); bv[ks] = *(const bf16x8*)(WV + o); }
#pragma unroll
    for (int ks = 0; ks < 4; ++ks) asm volatile("" : "+v"(bq[ks]), "+v"(bk[ks]), "+v"(bv[ks]));
    f32x4 accC[8];
#pragma unroll
    for (int nt = 0; nt < 8; ++nt) accC[nt] = (f32x4){0.f, 0.f, 0.f, 0.f};
    __syncthreads();
#pragma unroll 1
    for (int ci = 0; ci < SEQ / 64; ++ci) {
        const int p0 = ci * 64;
        int tidv = tid; asm volatile("" : "+v"(tidv));
        const int lanev = tidv & 63, r16 = lanev & 15, q4 = lanev >> 4;
        LAS float* scc = sc + (ci & 1) * SC_BUF; LAS float* scn = sc + ((ci & 1) ^ 1) * SC_BUF;
        u32x4 pxm[2], pxc[2]; f32x4 pg0 = {0.f, 0.f, 0.f, 0.f}; f32x2 pg1 = {0.f, 0.f};
        const bool more = (ci + 1 < SEQ / 64);
#pragma unroll
        for (int i = 0; i < 2; ++i) { const int idx = tidv + NTHREADS * i, lr = idx >> 4, cc = idx & 15, lp = p0 + 64 + lr, pos = dir ? (SEQ - 1 - lp) : lp;
            pxm[i] = (u32x4){0u, 0u, 0u, 0u}; pxc[i] = pxm[i];
            if (more) { pxm[i] = *(const u32x4*)(XMg + (size_t)pos * 512 + cc * 8); pxc[i] = *(const u32x4*)(XCg + (size_t)pos * 512 + cc * 8); } }
        if (wave == 0 && more) { pg0 = *(const f32x4*)(GS + (size_t)(p0 + 64 + lanev) * 8); pg1 = *(const f32x2*)(GS + (size_t)(p0 + 64 + lanev) * 8 + 4); }
        {
            f32x4 aq[4], ak[4], av[4];
#pragma unroll
            for (int mt = 0; mt < 4; ++mt) { aq[mt] = (f32x4){0.f, 0.f, 0.f, 0.f}; ak[mt] = aq[mt]; av[mt] = aq[mt]; }
            bf16x8 xa0[4], xv0[4], xa1[4], xv1[4];
#define ML_LDX(XA, XV, MT) _Pragma("unroll") for (int ks = 0; ks < 4; ++ks) { XA[ks] = *(const LAS bf16x8*)(lds + ML_XC + xsw(16 * (MT) + r16, 4 * ks + q4)); XV[ks] = *(const LAS bf16x8*)(lds + ML_XM + xsw(16 * (MT) + r16, 4 * ks + q4)); }
#define ML_MMX(XA, XV, MT) _Pragma("unroll") for (int ks = 0; ks < 4; ++ks) { aq[MT] = MFMA16(bq[ks], XA[ks], aq[MT]); ak[MT] = MFMA16(XA[ks], bk[ks], ak[MT]); av[MT] = MFMA16(XV[ks], bv[ks], av[MT]); }
            ML_LDX(xa0, xv0, 0)
            ML_LDX(xa1, xv1, 1)
            __builtin_amdgcn_sched_barrier(0);
            ML_MMX(xa0, xv0, 0)
            ML_LDX(xa0, xv0, 2)
            __builtin_amdgcn_sched_barrier(0);
            ML_MMX(xa1, xv1, 1)
            ML_LDX(xa1, xv1, 3)
            __builtin_amdgcn_sched_barrier(0);
            ML_MMX(xa0, xv0, 2)
            __builtin_amdgcn_sched_barrier(0);
            ML_MMX(xa1, xv1, 3)
#undef ML_LDX
#undef ML_MMX
#pragma unroll
            for (int mt = 0; mt < 4; ++mt) {
                u32x2 w2; w2.x = pk2(aq[mt][0], aq[mt][1]); w2.y = pk2(aq[mt][2], aq[mt][3]);
                *(LAS u32x2*)(lds + ML_QS + sw128(16 * mt + r16, (16 * wave + 4 * q4) * 2)) = w2;
                const f32x4 ws4 = *(const LAS f32x4*)(scc + SC_WS + 16 * mt + 4 * q4);
                w2.x = pk2(ak[mt][0] * ws4[0], ak[mt][1] * ws4[1]); w2.y = pk2(ak[mt][2] * ws4[2], ak[mt][3] * ws4[3]);
                *(LAS u32x2*)(lds + ML_KT + sw64(16 * wave + r16, (16 * mt + 4 * q4) * 2)) = w2;
                {
                  float y0 = ak[mt][0], y1 = ak[mt][1], y2 = ak[mt][2], y3 = ak[mt][3]; const bool o1 = (r16 & 1) != 0, o2 = (r16 & 2) != 0;
#define ML_XCH(A, B, ODD, CTRL) { const float s_ = (ODD) ? A : B; const float r_ = __builtin_bit_cast(float, __builtin_amdgcn_mov_dpp(__builtin_bit_cast(int, s_), CTRL, 0xf, 0xf, true)); if (ODD) A = r_; else B = r_; }
                  ML_XCH(y0, y1, o1, 0xB1) ML_XCH(y2, y3, o1, 0xB1)
                  ML_XCH(y0, y2, o2, 0x4E) ML_XCH(y1, y3, o2, 0x4E)
#undef ML_XCH
                  u32x2 kw; kw.x = pk2(y0, y1); kw.y = pk2(y2, y3);
                  *(LAS u32x2*)(lds + ML_KS + (16 * mt + 4 * q4 + (r16 & 3)) * RPQ + (16 * wave + (r16 & ~3)) * 2) = kw; }
                w2.x = pk2(av[mt][0], av[mt][1]); w2.y = pk2(av[mt][2], av[mt][3]);
                *(LAS u32x2*)(lds + ML_VT + sw64(16 * wave + r16, (16 * mt + 4 * q4) * 2)) = w2;
            }
        }
        __syncthreads();
        f32x4 num[4];
        {
            bf16x8 cb[4], qa0[4], qa1[4], sa[4], sb[4];
            const int mt1 = wave >= 6 ? 3 : wave >= 3 ? 2 : wave >= 1 ? 1 : 0, nt1 = wave - (mt1 * (mt1 + 1)) / 2;
#define ML_LDQ(Q, MT) _Pragma("unroll") for (int ks = 0; ks < 4; ++ks) Q[ks] = *(const LAS bf16x8*)(lds + ML_QS + sw128(16 * (MT) + r16, (32 * ks + 8 * q4) * 2));
#define ML_MMQ(Q, MT) _Pragma("unroll") for (int ks = 0; ks < 4; ++ks) num[MT] = MFMA16(cb[ks], Q[ks], num[MT]);
#define ML_LDS_(MT, NT) _Pragma("unroll") for (int ks = 0; ks < 4; ++ks) { sa[ks] = *(const LAS bf16x8*)(lds + ML_QS + sw128(16 * (MT) + r16, (32 * ks + 8 * q4) * 2)); sb[ks] = *(const LAS bf16x8*)(lds + ML_KS + (16 * (NT) + r16) * RPQ + (32 * ks + 8 * q4) * 2); }
#define ML_STILE(MT, NT, MU, R4) { f32x4 s = {0.f, 0.f, 0.f, 0.f}; \
                _Pragma("unroll") for (int ks = 0; ks < 4; ++ks) s = MFMA16(sb[ks], sa[ks], s);     \
                const int t = 16 * (MT) + r16; float p[4], psum = 0.f; \
                _Pragma("unroll") for (int reg = 0; reg < 4; ++reg) { const int sidx = 16 * (NT) + 4 * q4 + reg; const float w = (sidx <= t) ? fexp(fminf(R4[reg] - MU, 0.f)) : 0.f; p[reg] = s[reg] * w; psum += p[reg]; } \
                u32x2 w2; w2.x = pk2(p[0], p[1]); w2.y = pk2(p[2], p[3]); \
                *(LAS u32x2*)(lds + ML_P + sw64(t, (16 * (NT) + 4 * q4) * 2)) = w2; \
                psum += __shfl_xor(psum, 16); psum += __shfl_xor(psum, 32); \
                if (q4 == 0) atomicAdd((float*)(scc + SC_DEN + t), psum); }
#pragma unroll
            for (int ks = 0; ks < 4; ++ks) cb[ks] = *(const LAS bf16x8*)(lds + ML_CB + sw128(16 * wave + r16, (32 * ks + 8 * q4) * 2));
            ML_LDQ(qa0, 0)
            ML_LDQ(qa1, 1)
            ML_LDS_(mt1, nt1)
            const float mu1 = scc[SC_MU + 16 * mt1 + r16]; const f32x4 r41 = *(const LAS f32x4*)(scc + SC_R + 16 * nt1 + 4 * q4);
#pragma unroll
            for (int mt = 0; mt < 4; ++mt) num[mt] = (f32x4){0.f, 0.f, 0.f, 0.f};
            __builtin_amdgcn_sched_barrier(0);
            ML_MMQ(qa0, 0)
            ML_LDQ(qa0, 2)
            __builtin_amdgcn_sched_barrier(0);
            ML_MMQ(qa1, 1)
            ML_LDQ(qa1, 3)
            __builtin_amdgcn_sched_barrier(0);
            ML_STILE(mt1, nt1, mu1, r41)
            ML_MMQ(qa0, 2)
            __builtin_amdgcn_sched_barrier(0);
            ML_MMQ(qa1, 3)
            if (wave < 2) {
                ML_LDS_(3, 2 + wave)
                const float mu2 = scc[SC_MU + 48 + r16]; const f32x4 r42 = *(const LAS f32x4*)(scc + SC_R + 16 * (2 + wave) + 4 * q4);
                ML_STILE(3, 2 + wave, mu2, r42)
            }
#undef ML_LDQ
#undef ML_MMQ
#undef ML_LDS_
#undef ML_STILE
            { const int t = tidv >> 3, part = tidv & 7; float s = 0.f;
              const u32x4 qa = *(const LAS u32x4*)(lds + ML_QS + sw128(t, part * 32)), qb = *(const LAS u32x4*)(lds + ML_QS + sw128(t, part * 32 + 16));
              const u32x4 na = *(const LAS u32x4*)((const LAS unsigned char*)(sc + SC_NB) + part * 32), nb = *(const LAS u32x4*)((const LAS unsigned char*)(sc + SC_NB) + part * 32 + 16);
              s = dot2bf(qa.x, na.x, s); s = dot2bf(qa.y, na.y, s); s = dot2bf(qa.z, na.z, s); s = dot2bf(qa.w, na.w, s);
              s = dot2bf(qb.x, nb.x, s); s = dot2bf(qb.y, nb.y, s); s = dot2bf(qb.z, nb.z, s); s = dot2bf(qb.w, nb.w, s);
              s += __shfl_xor(s, 1); s += __shfl_xor(s, 2); s += __shfl_xor(s, 4);
              if (part == 0) scc[SC_NQ + t] = s; }
        }
        __syncthreads();
        {
            bf16x8 vt[2], pf[4][2], kt0[4][2], kt1[4][2]; float wi[4], dn[4], nqv[4], me[4];
#pragma unroll
            for (int ks = 0; ks < 2; ++ks) vt[ks] = *(const LAS bf16x8*)(lds + ML_VT + sw64(16 * wave + r16, (32 * ks + 8 * q4) * 2));
#pragma unroll
            for (int mt = 0; mt < 4; ++mt) {
#pragma unroll
                for (int ks = 0; ks < 2; ++ks) pf[mt][ks] = *(const LAS bf16x8*)(lds + ML_P + sw64(16 * mt + r16, (32 * ks + 8 * q4) * 2));
                const int t = 16 * mt + r16; wi[mt] = scc[SC_WI + t]; dn[mt] = scc[SC_DEN + t]; nqv[mt] = scc[SC_NQ + t]; me[mt] = scc[SC_ME + t]; }
            const float decay = scc[SC_DEC];
#pragma unroll
            for (int nt = 0; nt < 4; ++nt)
#pragma unroll
                for (int ks = 0; ks < 2; ++ks) kt0[nt][ks] = *(const LAS bf16x8*)(lds + ML_KT + sw64(16 * nt + r16, (32 * ks + 8 * q4) * 2));
            __builtin_amdgcn_sched_barrier(0);
#pragma unroll
            for (int mt = 0; mt < 4; ++mt) {
                const int t = 16 * mt + r16;
                num[mt] = num[mt] * wi[mt];
#pragma unroll
                for (int ks = 0; ks < 2; ++ks) num[mt] = MFMA16(vt[ks], pf[mt][ks], num[mt]);
                const float den = dn[mt] + wi[mt] * nqv[mt], inv = frcp(fmaxf(fabsf(den), me[mt]));
                const int lp = p0 + t, pos = dir ? (SEQ - 1 - lp) : lp;
                u32x2 w2; w2.x = pk2(num[mt][0] * inv, num[mt][1] * inv); w2.y = pk2(num[mt][2] * inv, num[mt][3] * inv);
                *(u32x2*)(HO + (size_t)pos * 512 + 16 * wave + 4 * q4) = w2;
            }
#pragma unroll
            for (int nt = 0; nt < 4; ++nt)
#pragma unroll
                for (int ks = 0; ks < 2; ++ks) kt1[nt][ks] = *(const LAS bf16x8*)(lds + ML_KT + sw64(16 * (nt + 4) + r16, (32 * ks + 8 * q4) * 2));
            __builtin_amdgcn_sched_barrier(0);
#pragma unroll
            for (int nt = 0; nt < 4; ++nt) {
                accC[nt] = accC[nt] * decay;
#pragma unroll
                for (int ks = 0; ks < 2; ++ks) accC[nt] = MFMA16(kt0[nt][ks], vt[ks], accC[nt]);
                u32x2 w2; w2.x = pk2(accC[nt][0], accC[nt][1]); w2.y = pk2(accC[nt][2], accC[nt][3]);
                *(LAS u32x2*)(lds + ML_CB + sw128(16 * wave + r16, (16 * nt + 4 * q4) * 2)) = w2;
            }
            __builtin_amdgcn_sched_barrier(0);
#pragma unroll
            for (int nt = 4; nt < 8; ++nt) {
                accC[nt] = accC[nt] * decay;
#pragma unroll
                for (int ks = 0; ks < 2; ++ks) accC[nt] = MFMA16(kt1[nt - 4][ks], vt[ks], accC[nt]);
                u32x2 w2; w2.x = pk2(accC[nt][0], accC[nt][1]); w2.y = pk2(accC[nt][2], accC[nt][3]);
                *(LAS u32x2*)(lds + ML_CB + sw128(16 * wave + r16, (16 * nt + 4 * q4) * 2)) = w2;
            }
            if (tidv < 128) { float s = 0.f; const unsigned ones = 0x3f803f80u;
#pragma unroll
                for (int j = 0; j < 8; ++j) { const u32x4 kv = *(const LAS u32x4*)(lds + ML_KT + sw64(tidv, j * 16));
                    s = dot2bf(kv.x, ones, s); s = dot2bf(kv.y, ones, s); s = dot2bf(kv.z, ones, s); s = dot2bf(kv.w, ones, s); }
                const float nn = decay * sc[SC_N + tidv] + s; sc[SC_N + tidv] = nn;
                ((LAS bf16*)(sc + SC_NB))[tidv] = (bf16)(pk2(nn, 0.f) & 0xffffu); }
#pragma unroll
            for (int i = 0; i < 2; ++i) { const int idx = tidv + NTHREADS * i, lr = idx >> 4, cc = idx & 15;
                *(LAS u32x4*)(lds + ML_XM + xsw(lr, cc)) = pxm[i]; *(LAS u32x4*)(lds + ML_XC + xsw(lr, cc)) = pxc[i]; }
            if (wave == 0) { scn[SC_R + lanev] = pg0[0]; scn[SC_MU + lanev] = pg0[1]; scn[SC_WI + lanev] = pg0[2]; scn[SC_ME + lanev] = pg0[3]; scn[SC_WS + lanev] = pg1[0]; scn[SC_DEN + lanev] = 0.f;
                if (lanev == 0) scn[SC_DEC] = pg1[1]; }
        }
        __syncthreads();
    }
}

__device__ __forceinline__ void ml_combine(const Args& a, unsigned char* ws, int gw, int NGW, int lane) {
    const bf16* HF = (const bf16*)(ws + WS_HF); const bf16* HB = (const bf16*)(ws + WS_HB); const bf16* XCg = (const bf16*)(ws + WS_XC); const bf16* OP = (const bf16*)(ws + WS_OP);
    bf16* YC = (bf16*)(ws + WS_YCAT);
    const int col = 8 * lane;
    float hn[8], sk[8];
#pragma unroll
    for (int e = 0; e < 8; ++e) { hn[e] = a.in[I_HNORM][col + e]; sk[e] = a.in[I_SKIP][col + e]; }
    for (int grp = gw; grp < MTOK / 4; grp += NGW) {
        u32x4 hf[4], hb[4], ov[4], xc[4];
#pragma unroll
        for (int r = 0; r < 4; ++r) { const size_t o = (size_t)(grp * 4 + r) * 512 + col; hf[r] = *(const u32x4*)(HF + o); hb[r] = *(const u32x4*)(HB + o); ov[r] = *(const u32x4*)(OP + o); xc[r] = *(const u32x4*)(XCg + o); }
#pragma unroll
        for (int r = 0; r < 4; ++r) {
            float hv[8] = {bflo(hf[r].x) + bflo(hb[r].x), bfhi(hf[r].x) + bfhi(hb[r].x), bflo(hf[r].y) + bflo(hb[r].y), bfhi(hf[r].y) + bfhi(hb[r].y), bflo(hf[r].z) + bflo(hb[r].z), bfhi(hf[r].z) + bfhi(hb[r].z), bflo(hf[r].w) + bflo(hb[r].w), bfhi(hf[r].w) + bfhi(hb[r].w)};
            float sm = 0.f;
#pragma unroll
            for (int e = 0; e < 8; ++e) sm += hv[e];
            sm += __shfl_xor(sm, 1); sm += __shfl_xor(sm, 2); sm += __shfl_xor(sm, 4); sm += __shfl_xor(sm, 8);
            const float mean = sm * (1.f / DH); float vs = 0.f;
#pragma unroll
            for (int e = 0; e < 8; ++e) { hv[e] -= mean; vs += hv[e] * hv[e]; }
            vs += __shfl_xor(vs, 1); vs += __shfl_xor(vs, 2); vs += __shfl_xor(vs, 4); vs += __shfl_xor(vs, 8);
            const float rstd = __builtin_amdgcn_rsqf(vs * (1.f / DH) + EPS);
            const float og[8] = {bflo(ov[r].x), bfhi(ov[r].x), bflo(ov[r].y), bfhi(ov[r].y), bflo(ov[r].z), bfhi(ov[r].z), bflo(ov[r].w), bfhi(ov[r].w)};
            const float xg[8] = {bflo(xc[r].x), bfhi(xc[r].x), bflo(xc[r].y), bfhi(xc[r].y), bflo(xc[r].z), bfhi(xc[r].z), bflo(xc[r].w), bfhi(xc[r].w)};
            float o[8];
#pragma unroll
            for (int e = 0; e < 8; ++e) o[e] = sigmoidf_(og[e]) * (hv[e] * rstd * hn[e] + sk[e] * xg[e]);
            u32x4 w; w.x = pk2(o[0], o[1]); w.y = pk2(o[2], o[3]); w.z = pk2(o[4], o[5]); w.w = pk2(o[6], o[7]);
            *(u32x4*)(YC + (size_t)(grp * 4 + r) * 1024 + 512 + col) = w;
        }
    }
}

__global__ void __launch_bounds__(NTHREADS, 2) hyb_fwd(Args args) {
    extern __shared__ __attribute__((aligned(16))) unsigned char lds_raw[];
    LAS unsigned char* lds = (LAS unsigned char*)lds_raw;
    volatile LAS unsigned* MISC = (volatile LAS unsigned*)(lds + MISC_OFF);
    const int tid = threadIdx.x, lane = tid & 63, wave = __builtin_amdgcn_readfirstlane(tid >> 6);
    const int G = gridDim.x, bx = blockIdx.x, vcu = (G % 8 == 0) ? (bx % 8) * (G / 8) + bx / 8 : bx;
    const int gw = vcu * NWAVES + wave, NGW = G * NWAVES;
    unsigned char* ws = args.ws;
    for (int u = tid; u < (LDS_BYTES - MISC_OFF) / 4; u += NTHREADS) ((LAS unsigned*)(lds + MISC_OFF))[u] = 0u;
    __syncthreads();
    const int lo = args.ph_lo, hi = args.ph_hi;
    const bool one = (hi - lo) > 1;
    XcdBarrier bar; bar.bar = (unsigned*)(ws + WS_CTL) + CW_BAR; bar.x = 0; bar.st = nullptr;
    if (one) bar = xcd_barrier_post((unsigned*)(ws + WS_CTL) + CW_BAR, MISC + 8);
#define IN(k) (lo <= (k) && (k) < hi)
#define SEAM(k) do { if (one) xcd_barrier(bar); } while (0)

    if (IN(0)) { p0_prologue(args, ws, lds, tid, wave, lane, vcu, G); SEAM(0); }
    if (IN(1)) {
        pg8::Gemm g{(const bf16*)(ws + WS_XB), (const bf16*)(ws + WS_WIN), DM, DM, DM}; pg8::StaticOrder S; S.init(MTOK, NPROJ, G, bx);
        pg8::EpiP1 E{(const float*)(ws + WS_RS1), (bf16*)(ws + WS_UX), (bf16*)(ws + WS_XM), (bf16*)(ws + WS_OP)};
        pg8::gemm_phase<pg8::EpiP1, pg8::StaticOrder, true>(lds, g, S, E);
        SEAM(1);
    }
    if (IN(2)) {
        if (G == 256) {
            { pg8::Gemm g{(const bf16*)(ws + WS_UX), (const bf16*)(ws + WS_MZ), 512, 256, 256}; pg8::S5One S{bx}; pg8::EpiZL E{};
              pg8::gemm_phase<pg8::EpiZL, pg8::S5One, true, true>(lds, g, S, E); }
            __syncthreads();
            s5_scan_lds(args, ws, lds, bx, tid);
            __syncthreads();
            { pg8::Gemm g{(const bf16*)(ws + WS_UX), (const bf16*)(ws + WS_MZ), 512, 256, 256}; pg8::S5One S{G + bx}; pg8::EpiZL E{};
              pg8::gemm_phase<pg8::EpiZL, pg8::S5One, true, true>(lds, g, S, E); }
            __syncthreads();
            s5_scan_lds(args, ws, lds, G + bx, tid);
            VM_WAIT(); __syncthreads();
        } else {
            { pg8::Gemm g{(const bf16*)(ws + WS_UX), (const bf16*)(ws + WS_MZ), 512, 256, 256}; pg8::S5Order S{G, bx}; pg8::EpiZ E{(bf16*)(ws + WS_ZB)};
              pg8::gemm_phase<pg8::EpiZ, pg8::S5Order, true>(lds, g, S, E); }
            VM_WAIT(); __syncthreads();
            s5_scan(args, ws, tid, G);
            VM_WAIT(); __syncthreads();
        }
        { pg8::Gemm g{(const bf16*)(ws + WS_UX), (const bf16*)(ws + WS_TMY), 512, 512, 512}; pg8::S5Order S{G, bx}; pg8::EpiY E{(bf16*)(ws + WS_YACT)};
          pg8::gemm_phase<pg8::EpiY, pg8::S5Order, true>(lds, g, S, E); }
        ml_pre(args, ws, lds, gw, NGW, wave, lane, G);
        SEAM(2);
    }
    if (IN(3)) {
        { pg8::Gemm g{(const bf16*)(ws + WS_YACT), (const bf16*)(ws + WS_WGLU), 512, 512, 512}; pg8::StaticOrder S; S.init(MTOK, 512, G, bx);
          pg8::EpiGLU E{(const bf16*)(ws + WS_YACT), args.in[I_BGLU], (bf16*)(ws + WS_YCAT)};
          pg8::gemm_phase<pg8::EpiGLU, pg8::StaticOrder, true>(lds, g, S, E); }
        __syncthreads();
        for (int cid = bx; cid < BATCH * NH * 2; cid += G) mlstm_chain(args, ws, lds, cid, tid, wave, lane);
        SEAM(3);
    }
    if (IN(4)) { ml_combine(args, ws, gw, NGW, lane); SEAM(4); }
    if (IN(5)) { }
    unsigned* const ctlw = (unsigned*)(ws + WS_CTL);
    if (IN(6)) {
        pg8::Gemm g{(const bf16*)(ws + WS_YCAT), (const bf16*)(ws + WS_WOUT), DM, DM, DM}; pg8::StaticOrder S; S.init(MTOK, DM, G, bx);
        pg8::PanelSS s1{(unsigned long long*)(ws + WS_XS), ctlw + CW_TMO};
        pg8::EpiMid E{(bf16*)(ws + WS_XB), args.in[I_NMPOST], (float*)(ws + WS_RS2), s1};
        pg8::gemm_phase<pg8::EpiMid, pg8::StaticOrder, true>(lds, g, S, E);
        SEAM(6);
    }
    if (IN(8)) {
        { pg8::Gemm g{(const bf16*)(ws + WS_XB), (const bf16*)(ws + WS_WGU), DM, DM, DM}; pg8::PassOrder S; S.init(MTOK, G, bx);
          pg8::EpiGU E{(const float*)(ws + WS_RS2), (bf16*)(ws + WS_ACT), 0};
          pg8::gemm_phase<pg8::EpiGU, pg8::PassOrder, true>(lds, g, S, E); }
        SEAM(8);
    }
    if (IN(9)) {
        pg8::Gemm g{(const bf16*)(ws + WS_ACT), (const bf16*)(ws + WS_WDN), DFF, DFF, DFF}; pg8::StaticOrder S; S.init(MTOK, DM, G, bx);
        pg8::PanelSS s3{(unsigned long long*)(ws + WS_XS) + (size_t)MTOK * 8, ctlw + CW_TMO};
        pg8::EpiOut E{(const bf16*)(ws + WS_XB), args.in[I_NFPOST], args.out, s3};
        pg8::gemm_phase<pg8::EpiOut, pg8::StaticOrder, true>(lds, g, S, E);
    }
#undef IN
#undef SEAM
}

extern "C" void kernel_launch(void* const* d_in, const int* in_sizes, int n_in, void* d_out, int out_size, void* d_ws, size_t ws_size, hipStream_t stream) {
    static int grid = 0;
    if (grid == 0) {
        if (n_in != 28 || in_sizes[0] != MTOK * DM || out_size != MTOK * DM || ws_size < WS_END) { fprintf(stderr, "kernel_launch: unexpected shapes (n_in %d, in0 %d, out %d, ws %zu); nothing launched\n", n_in, n_in > 0 ? in_sizes[0] : -1, out_size, ws_size); grid = -1; return; }
        int dev = 0, cus = 0;
        if (hipGetDevice(&dev) != hipSuccess || hipDeviceGetAttribute(&cus, hipDeviceAttributeMultiprocessorCount, dev) != hipSuccess) { grid = -1; return; }
        if (hipFuncSetAttribute((const void*)hyb_fwd, hipFuncAttributeMaxDynamicSharedMemorySize, LDS_BYTES) != hipSuccess) { fprintf(stderr, "kernel_launch: hipFuncSetAttribute failed\n"); grid = -1; return; }
        int per_cu = 0;
        if (hipOccupancyMaxActiveBlocksPerMultiprocessor(&per_cu, (const void*)hyb_fwd, NTHREADS, LDS_BYTES) != hipSuccess || per_cu < 1) fprintf(stderr, "kernel_launch: occupancy query reports %d\n", per_cu);
        (void)hipGetLastError();
        if (cus < 256) { fprintf(stderr, "kernel_launch: built for a 256-CU device (got %d CUs); nothing launched\n", cus); grid = -1; return; }
        grid = 256;
    }
    if (grid < 0) return;
    (void)hipMemsetAsync((char*)d_ws + WS_CTL, 0, CTL_ZERO_BYTES, stream);
    Args a{};
    for (int i = 0; i < 28; ++i) a.in[i] = (const float*)d_in[i];
    a.out = (float*)d_out; a.ws = (unsigned char*)d_ws; a.pad0 = 0; a.pad1 = 0;
    a.ph_lo = 0; a.ph_hi = N_PHASES;
    hipLaunchKernelGGL(hyb_fwd, dim3(grid), dim3(NTHREADS), LDS_BYTES, stream, a);
}
```
